# Optimizing an MI355X kernel written in HIP

```python
import numpy as np
import jax, jax.numpy as jnp
from jax import lax

D_MODEL = 1024
BATCH = 8
SEQ = 4096
DEPTH = 1

N_HEADS = 8
N_KV = 2
GQA = N_HEADS // N_KV
HEAD_DIM = 64
ATTN_WIDTH = N_HEADS * HEAD_DIM
KV_COLS = N_KV * HEAD_DIM
N_GATE = 3 * N_HEADS
CMP_LEN = 32
CMP_STRIDE = 16
CMP_HIDDEN = 4 * HEAD_DIM
SEL_BLOCK = 64
SEL_TOPK = 16
WINDOW = 512
Q_BLOCK = 128
FORCE_SCORE = 1.0e4
CONV_GROUPS = 8
CONV_WIDTH = D_MODEL - ATTN_WIDTH
CONV_K = 3
MIX_WIDTH = ATTN_WIDTH + CONV_WIDTH
N_IN = ATTN_WIDTH + 6 * KV_COLS + N_GATE + 3 * CONV_WIDTH
D_FF = 2816
EPS = 1e-6

kernel_name = 'hymba_nsa_shortconv_convffn_adaln'


def rms_norm(x, g):
    xf = x.astype(jnp.float32)
    y = xf * lax.rsqrt(jnp.mean(xf * xf, axis=-1, keepdims=True) + EPS)
    return (y * g.astype(jnp.float32)).astype(x.dtype)


def group_rms_norm(y, g, n_groups):
    shp = y.shape
    yg = y.reshape(shp[:-1] + (n_groups, shp[-1] // n_groups))
    return rms_norm(yg, g.reshape(n_groups, -1)).reshape(shp)


def causal_dwconv(u, w):
    k_taps, s_len = w.shape[0], u.shape[1]
    up = jnp.pad(u, ((0, 0), (k_taps - 1, 0), (0, 0)))
    return sum(up[:, j:j + s_len] * w[j] for j in range(k_taps))


def masked_softmax(s, mask):
    s = jnp.where(mask, s.astype(jnp.float32), -jnp.inf)
    m = jnp.max(s, axis=-1, keepdims=True)
    m = jnp.where(jnp.isfinite(m), m, 0.0)
    e = jnp.where(mask, jnp.exp(s - m), 0.0)
    return e / jnp.maximum(jnp.sum(e, axis=-1, keepdims=True), jnp.finfo(jnp.float32).tiny)


def alibi_slopes(n):
    return np.array([2.0 ** (-8.0 * (h + 1) / n) for h in range(n)], dtype=np.float32)


def compress(k, pos, w1, w2):
    s_len = k.shape[2]
    n_cmp = (s_len - CMP_LEN) // CMP_STRIDE + 1
    idx = np.arange(n_cmp)[:, None] * CMP_STRIDE + np.arange(CMP_LEN)[None, :]
    blocks = k[:, :, idx] + pos
    flat = blocks.reshape(blocks.shape[:3] + (CMP_LEN * HEAD_DIM,))
    return jax.nn.gelu(flat @ w1) @ w2


def nsa_mixer(q, kc, vc, ks, vs, kw, vw, gates):
    b_sz, s_len = q.shape[0], q.shape[1]
    n_cmp = kc.shape[2]
    n_blk = s_len // SEL_BLOCK
    n_sel = min(SEL_TOPK, n_blk)
    scale = HEAD_DIM ** -0.5
    slopes = jnp.asarray(alibi_slopes(N_HEADS).reshape(N_KV, GQA))
    c_end = jnp.arange(n_cmp) * CMP_STRIDE + CMP_LEN - 1
    cs = np.arange(n_cmp) * CMP_STRIDE
    bs = np.arange(n_blk) * SEL_BLOCK
    overlap = jnp.asarray(((cs[None, :] < bs[:, None] + SEL_BLOCK) &
                           (cs[None, :] + CMP_LEN > bs[:, None])).astype(np.float32))
    ks_blk = ks.reshape(b_sz, N_KV, n_blk, SEL_BLOCK, HEAD_DIM)
    vs_blk = vs.reshape(b_sz, N_KV, n_blk, SEL_BLOCK, HEAD_DIM)
    kw_pad = jnp.pad(kw, ((0, 0), (0, 0), (WINDOW, 0), (0, 0)))
    vw_pad = jnp.pad(vw, ((0, 0), (0, 0), (WINDOW, 0), (0, 0)))
    bi = jnp.arange(b_sz)[:, None, None, None]
    gi = jnp.arange(N_KV)[None, :, None, None]
    blk_ids = jnp.arange(n_blk)

    def block(i):
        t0 = i * Q_BLOCK
        tpos = t0 + jnp.arange(Q_BLOCK)
        qb = lax.dynamic_slice_in_dim(q, t0, Q_BLOCK, axis=1)
        gb = lax.dynamic_slice_in_dim(gates, t0, Q_BLOCK, axis=1)
        s = jnp.einsum('btghd,bgnd->bgthn', qb, kc).astype(jnp.float32) * scale
        dist = (tpos[:, None] - c_end[None, :]).astype(jnp.float32)
        s = s - slopes[None, :, None, :, None] * dist[None, None, :, None, :]
        p_c = masked_softmax(s, (c_end[None, :] <= tpos[:, None])[None, None, :, None, :])
        o_c = jnp.einsum('bgthn,bgnd->btghd', p_c.astype(vc.dtype), vc)
        imp = jnp.einsum('bgtn,jn->bgtj', p_c.sum(axis=3), overlap)
        cur = tpos // SEL_BLOCK
        valid = blk_ids[None, :] <= cur[:, None]
        forced = ((blk_ids[None, :] == 0) | (blk_ids[None, :] == cur[:, None]) |
                  (blk_ids[None, :] == cur[:, None] - 1))
        score = jnp.where(valid, imp, -1.0)
        score = jnp.where(forced, FORCE_SCORE, score)
        _, idx = lax.top_k(score, n_sel)
        k_sel = ks_blk[bi, gi, idx]
        v_sel = vs_blk[bi, gi, idx]
        kpos = idx[..., None] * SEL_BLOCK + jnp.arange(SEL_BLOCK)
        s = jnp.einsum('btghd,bgtnkd->bgthnk', qb, k_sel).astype(jnp.float32) * scale
        dist = (tpos[None, None, :, None, None] - kpos).astype(jnp.float32)
        s = s - slopes[None, :, None, :, None, None] * dist[:, :, :, None]
        sh = s.shape
        mask_s = (dist >= 0).reshape(sh[:3] + (-1,))[:, :, :, None, :]
        p_s = masked_softmax(s.reshape(sh[:4] + (-1,)), mask_s).reshape(sh)
        o_s = jnp.einsum('bgthnk,bgtnkd->btghd', p_s.astype(v_sel.dtype), v_sel)
        kwb = lax.dynamic_slice_in_dim(kw_pad, t0, WINDOW + Q_BLOCK, axis=2)
        vwb = lax.dynamic_slice_in_dim(vw_pad, t0, WINDOW + Q_BLOCK, axis=2)
        kpos_w = t0 - WINDOW + jnp.arange(WINDOW + Q_BLOCK)
        dist_w = tpos[:, None] - kpos_w[None, :]
        mask_w = (dist_w >= 0) & (dist_w < WINDOW) & (kpos_w[None, :] >= 0)
        s = jnp.einsum('btghd,bgkd->bgthk', qb, kwb).astype(jnp.float32) * scale
        s = s - slopes[None, :, None, :, None] * dist_w.astype(jnp.float32)[None, None, :, None, :]
        p_w = masked_softmax(s, mask_w[None, None, :, None, :])
        o_w = jnp.einsum('bgthk,bgkd->btghd', p_w.astype(vwb.dtype), vwb)
        return gb[..., 0:1] * o_c + gb[..., 1:2] * o_s + gb[..., 2:3] * o_w

    out = lax.map(block, jnp.arange(s_len // Q_BLOCK))
    return jnp.moveaxis(out, 0, 1).reshape(b_sz, s_len, ATTN_WIDTH)


def setup_inputs(seed: int = 0) -> dict:
    key = jax.random.key(seed)
    k = jax.random.split(key, 32)
    L = DEPTH

    def nrm(kk, shape, std):
        return jax.random.normal(kk, shape, jnp.float32) * std

    return {
        'x': nrm(k[0], (BATCH, SEQ, D_MODEL), 1.0),
        'c': nrm(k[1], (BATCH, D_MODEL), 1.0),
        'w_ada': nrm(k[2], (L, D_MODEL, 6 * D_MODEL), 0.5 * D_MODEL ** -0.5),
        'b_ada': nrm(k[3], (L, 6 * D_MODEL), 0.01),
        'norm1_g': 1.0 + nrm(k[4], (L, D_MODEL), 0.02),
        'w_in': nrm(k[5], (L, D_MODEL, N_IN), D_MODEL ** -0.5),
        'b_gate': nrm(k[6], (L, N_GATE), 0.01),
        'q_norm_g': 1.0 + nrm(k[7], (L, HEAD_DIM), 0.02),
        'k_norm_cmp_g': 1.0 + nrm(k[8], (L, HEAD_DIM), 0.02),
        'k_norm_slc_g': 1.0 + nrm(k[9], (L, HEAD_DIM), 0.02),
        'k_norm_win_g': 1.0 + nrm(k[10], (L, HEAD_DIM), 0.02),
        'pos_cmp_k': nrm(k[11], (L, CMP_LEN, HEAD_DIM), 0.1),
        'pos_cmp_v': nrm(k[12], (L, CMP_LEN, HEAD_DIM), 0.1),
        'w_cmp_k1': nrm(k[13], (L, CMP_LEN * HEAD_DIM, CMP_HIDDEN), (CMP_LEN * HEAD_DIM) ** -0.5),
        'w_cmp_k2': nrm(k[14], (L, CMP_HIDDEN, HEAD_DIM), CMP_HIDDEN ** -0.5),
        'w_cmp_v1': nrm(k[15], (L, CMP_LEN * HEAD_DIM, CMP_HIDDEN), (CMP_LEN * HEAD_DIM) ** -0.5),
        'w_cmp_v2': nrm(k[16], (L, CMP_HIDDEN, HEAD_DIM), CMP_HIDDEN ** -0.5),
        'conv_mix_w': nrm(k[17], (L, CONV_K, CONV_WIDTH), CONV_K ** -0.5),
        'attn_out_g': 1.0 + nrm(k[18], (L, ATTN_WIDTH), 0.02),
        'conv_out_g': 1.0 + nrm(k[19], (L, CONV_WIDTH), 0.02),
        'w_out': nrm(k[20], (L, MIX_WIDTH, D_MODEL), MIX_WIDTH ** -0.5),
        'norm2_g': 1.0 + nrm(k[21], (L, D_MODEL), 0.02),
        'w_ffn_gate': nrm(k[22], (L, D_MODEL, D_FF), D_MODEL ** -0.5),
        'w_ffn_up': nrm(k[23], (L, D_MODEL, D_FF), D_MODEL ** -0.5),
        'conv_ffn_w': nrm(k[24], (L, CONV_K, D_FF), CONV_K ** -0.5),
        'w_ffn_down': nrm(k[25], (L, D_FF, D_MODEL), D_FF ** -0.5),
    }


def reference(x, c, w_ada, b_ada, norm1_g, w_in, b_gate, q_norm_g, k_norm_cmp_g, k_norm_slc_g,
              k_norm_win_g, pos_cmp_k, pos_cmp_v, w_cmp_k1, w_cmp_k2, w_cmp_v1, w_cmp_v2,
              conv_mix_w, attn_out_g, conv_out_g, w_out, norm2_g, w_ffn_gate, w_ffn_up,
              conv_ffn_w, w_ffn_down):
    b_sz, s_len, _ = x.shape
    split_at = list(np.cumsum([ATTN_WIDTH] + [KV_COLS] * 6 + [N_GATE, CONV_WIDTH, CONV_WIDTH]))

    def to_kv(t):
        return t.reshape(b_sz, s_len, N_KV, HEAD_DIM).transpose(0, 2, 1, 3)

    for l in range(DEPTH):
        mod = jax.nn.silu(c) @ w_ada[l] + b_ada[l]
        sh1, sc1, g1, sh2, sc2, g2 = jnp.split(mod[:, None, :], 6, axis=-1)
        h = rms_norm(x, norm1_g[l]) * (1.0 + sc1) + sh1
        proj = h @ w_in[l]
        q, kc_raw, vc_raw, ks, vs, kw, vw, g_logit, gate_b, gate_c, xin = jnp.split(proj, split_at, axis=-1)
        q = rms_norm(q.reshape(b_sz, s_len, N_KV, GQA, HEAD_DIM), q_norm_g[l])
        kc = rms_norm(compress(to_kv(kc_raw), pos_cmp_k[l], w_cmp_k1[l], w_cmp_k2[l]), k_norm_cmp_g[l])
        vc = compress(to_kv(vc_raw), pos_cmp_v[l], w_cmp_v1[l], w_cmp_v2[l])
        ks = rms_norm(to_kv(ks), k_norm_slc_g[l])
        kw = rms_norm(to_kv(kw), k_norm_win_g[l])
        gates = jax.nn.sigmoid(g_logit + b_gate[l]).reshape(b_sz, s_len, N_KV, GQA, 3)
        attn = nsa_mixer(q, kc, vc, ks, to_kv(vs), kw, to_kv(vw), gates)
        conv = gate_b * causal_dwconv(gate_c * xin, conv_mix_w[l])
        mixed = jnp.concatenate([group_rms_norm(attn, attn_out_g[l], N_HEADS),
                                 group_rms_norm(conv, conv_out_g[l], CONV_GROUPS)], axis=-1)
        x = x + g1 * (mixed @ w_out[l])
        h2 = rms_norm(x, norm2_g[l]) * (1.0 + sc2) + sh2
        g_pre = causal_dwconv(h2 @ w_ffn_gate[l], conv_ffn_w[l])
        x = x + g2 * ((jax.nn.silu(g_pre) * (h2 @ w_ffn_up[l])) @ w_ffn_down[l])
    return x
```

```cpp
#include <hip/hip_runtime.h>
#include <hip/hip_cooperative_groups.h>
#include <cstdio>
#include <cstdint>
namespace cg = cooperative_groups;

namespace pg8 {
#define PG8_LAS __attribute__((address_space(3)))
typedef unsigned short bf16_t;
typedef short bf16x8 __attribute__((ext_vector_type(8)));
typedef float f32x4 __attribute__((ext_vector_type(4)));
typedef unsigned u32x4 __attribute__((ext_vector_type(4)));
constexpr int BM = 256, BK = 64, HALF = 128, HTB = HALF * BK * 2, STAGE_BYTES = 8 * HTB, NXCD = 8, WGM = 8;

__host__ __device__ __forceinline__ int lds_byte(int r, int c) { const int st = (r >> 4) * 2 + (c >> 5), rr = r & 15, cc = c & 31, ob = rr * 64 + cc * 2; return st * 1024 + (ob ^ (((ob >> 9) & 1) << 5)); }
__host__ __device__ __forceinline__ void stage_rc(int b, int& R, int& C) { const int st = b / 1024, sb = b % 1024, swz = sb ^ (((sb >> 9) & 1) << 5); R = (st >> 1) * 16 + swz / 64; C = (st & 1) * 32 + (swz % 64) / 2; }
__host__ __device__ __forceinline__ int perm32(int rho) { const int n = rho >> 4, i = rho & 15; return 8 * (i >> 2) + 4 * n + (i & 3); }

struct Unit { int pm, pn; };
struct Gemm { const bf16_t* A; const bf16_t* Bt; int M, N, K, lda; };

struct StaticOrder {
    int nM, nN, nwg, G, c;
    __device__ void init(int M, int N, int G_, int c_) { nM = M / BM; nN = N / BM; nwg = nM * nN; G = G_; c = c_; }
    __device__ bool next(int i, Unit& u) const {
        const long L = (long)i * G + c; if (L >= nwg) return false;
        int wgid = (int)L; { const int q = nwg / NXCD, r = nwg % NXCD, xcd = wgid % NXCD, off = wgid / NXCD; wgid = (xcd < r ? xcd * (q + 1) : r * (q + 1) + (xcd - r) * q) + off; }
        const int nig = WGM * nN, gid = wgid / nig, fm = gid * WGM, gsz = (nM - fm) < WGM ? (nM - fm) : WGM;
        u.pm = fm + ((wgid % nig) % gsz); u.pn = (wgid % nig) / gsz; return true;
    }
    __device__ __forceinline__ const char* a_ptr(const Gemm& g, const Unit& u) const { return (const char*)g.A + (size_t)u.pm * (size_t)(BM * 2) * (size_t)g.lda; }
    __device__ __forceinline__ const char* b_ptr(const Gemm& g, const Unit& u) const { return (const char*)g.Bt + (size_t)u.pn * (size_t)(BM * 2) * (size_t)g.K; }
    __device__ __forceinline__ void a_ready(const Unit&) const {}
    __device__ __forceinline__ void done(const Unit&) const {}
};

template <class Epi, class Sched, bool ALIGN_EPI = false, bool SP2 = false>
__device__ __forceinline__ void gemm_phase(PG8_LAS unsigned char* lds, const Gemm g, const Sched& S, const Epi& E) {
    int tid_ = threadIdx.x; asm volatile("" : "+v"(tid_));
    const int tid = tid_, wid = __builtin_amdgcn_readfirstlane(tid >> 6), lane = tid & 63, wr = wid >> 2, wc = wid & 3, fr = lane & 15, fq = lane >> 4;
    const int K = g.K, nt = K / BK;
    unsigned voffA[2], voffB[2];
#pragma unroll
    for (int i = 0; i < 2; ++i) { int R, C; stage_rc(tid * 16 + i * 8192, R, C); const int Rb = Epi::PERM2 ? (64 * (R >> 5) + perm32(R & 31)) : (Epi::PERM ? ((R & ~31) + perm32(R & 31)) : R);
        voffA[i] = (unsigned)(R * g.lda + C) * 2u; voffB[i] = (unsigned)(Rb * K + C) * 2u; }
    const size_t kstep = (size_t)(BK * 2);
    const size_t hsA = (size_t)HALF * g.lda * 2, hsB = (size_t)(Epi::PERM2 ? 32 : HALF) * K * 2;
    const unsigned ldsw = (unsigned)wid * 1024u;
    const int aoff = lds_byte(wr * 64 + fr, fq * 8), boff = lds_byte(wc * 32 + fr, fq * 8);
#define PG8_SA(b, h) (((b) * 2 + (h)) * HTB)
#define PG8_SB(b, h) ((4 + (b) * 2 + (h)) * HTB)
#define PG8_STAGE(bufoff, gbase, voff) do { _Pragma("unroll") for (int _i = 0; _i < 2; ++_i) \
        __builtin_amdgcn_global_load_lds((const unsigned*)((const char*)(gbase) + (voff)[_i]), (PG8_LAS unsigned*)(lds + (bufoff) + ldsw + _i * 8192), 16, 0, 0); } while (0)
#define PG8_LDA(dst, b, h) do { _Pragma("unroll") for (int m = 0; m < 4; ++m) _Pragma("unroll") for (int k = 0; k < 2; ++k) dst[m][k] = *(const PG8_LAS bf16x8*)(lds + PG8_SA(b, h) + aoff + m * 2048 + k * 1024); } while (0)
#define PG8_LDB(dst, b, h) do { _Pragma("unroll") for (int n = 0; n < 2; ++n) _Pragma("unroll") for (int k = 0; k < 2; ++k) dst[n][k] = *(const PG8_LAS bf16x8*)(lds + PG8_SB(b, h) + boff + n * 2048 + k * 1024); } while (0)
#define PG8_MMA(ai, bj, At, Bt) do { __builtin_amdgcn_s_setprio(1); _Pragma("unroll") for (int m = 0; m < 4; ++m) _Pragma("unroll") for (int n = 0; n < 2; ++n) _Pragma("unroll") for (int k = 0; k < 2; ++k) \
        acc[ai][bj][m][n] = __builtin_amdgcn_mfma_f32_16x16x32_bf16(Bt[n][k], At[m][k], acc[ai][bj][m][n], 0, 0, 0); __builtin_amdgcn_s_setprio(0); } while (0)
#define PG8_WAIT_V(n) asm volatile("s_waitcnt vmcnt(" #n ")" ::: "memory")
#define PG8_WAIT_L(n) asm volatile("s_waitcnt lgkmcnt(" #n ")" ::: "memory")
#define PG8_BAR __builtin_amdgcn_s_barrier()
#define PG8_SCHED __builtin_amdgcn_sched_barrier(0)
    Unit cur, nxt; int ui = 0;
    if (!S.next(0, cur)) return;
    f32x4 acc[2][2][4][2];
#pragma unroll
    for (int a = 0; a < 2; ++a)
#pragma unroll
        for (int b = 0; b < 2; ++b)
#pragma unroll
            for (int m = 0; m < 4; ++m)
#pragma unroll
                for (int n = 0; n < 2; ++n) acc[a][b][m][n] = (f32x4){0.f, 0.f, 0.f, 0.f};
    bf16x8 At[4][2], B0[2][2], B1[2][2];
    const char* cA = S.a_ptr(g, cur); const char* cB = S.b_ptr(g, cur);
    S.a_ready(cur);
    if constexpr (SP2) {
        PG8_STAGE(PG8_SB(0, 0), cB, voffB); PG8_STAGE(PG8_SB(0, 1), cB + hsB, voffB); PG8_STAGE(PG8_SA(0, 0), cA, voffA); PG8_STAGE(PG8_SA(0, 1), cA + hsA, voffA);
        if (wr == 1) PG8_BAR;
        PG8_WAIT_V(2); PG8_BAR;
        PG8_STAGE(PG8_SB(1, 0), cB + kstep, voffB); PG8_STAGE(PG8_SA(1, 0), cA + kstep, voffA); PG8_STAGE(PG8_SB(1, 1), cB + hsB + kstep, voffB);
        PG8_WAIT_V(6); PG8_BAR;
    } else {
        PG8_STAGE(PG8_SB(0, 0), cB, voffB); PG8_STAGE(PG8_SA(0, 0), cA, voffA); PG8_STAGE(PG8_SB(0, 1), cB + hsB, voffB); PG8_STAGE(PG8_SA(0, 1), cA + hsA, voffA);
        if (wr == 1) PG8_BAR;
        PG8_WAIT_V(4); PG8_BAR;
        PG8_STAGE(PG8_SB(1, 0), cB + kstep, voffB); PG8_STAGE(PG8_SA(1, 0), cA + kstep, voffA); PG8_STAGE(PG8_SB(1, 1), cB + hsB + kstep, voffB);
        PG8_WAIT_V(6); PG8_BAR;
    }
    for (;;) {
        const bool has_next = S.next(ui + 1, nxt);
        const char* nA = has_next ? S.a_ptr(g, nxt) : cA; const char* nB = has_next ? S.b_ptr(g, nxt) : cB;
        for (int t = 0; t < nt; t += 2) {
            const bool last = (t == nt - 2);
            const char* a1 = cA + (size_t)(t + 1) * kstep;
            const char* a2 = last ? nA : cA + (size_t)(t + 2) * kstep; const char* b2 = last ? nB : cB + (size_t)(t + 2) * kstep;
            const char* a3 = a2 + kstep; const char* b3 = b2 + kstep;
            if (last && has_next) S.a_ready(nxt);
            if constexpr (SP2) {
            PG8_LDB(B0, 0, 0); PG8_LDB(B1, 0, 1); PG8_SCHED; PG8_LDA(At, 0, 0); PG8_STAGE(PG8_SA(1, 1), a1 + hsA, voffA);
            PG8_WAIT_V(8); PG8_WAIT_L(0); PG8_BAR; PG8_MMA(0, 0, At, B0); PG8_MMA(0, 1, At, B1); PG8_BAR; PG8_SCHED;
            PG8_LDA(At, 0, 1); PG8_STAGE(PG8_SB(0, 0), b2, voffB); PG8_STAGE(PG8_SB(0, 1), b2 + hsB, voffB); PG8_STAGE(PG8_SA(0, 0), a2, voffA);
            PG8_WAIT_V(8); PG8_WAIT_L(0); PG8_BAR; PG8_MMA(1, 0, At, B0); PG8_MMA(1, 1, At, B1); PG8_BAR; PG8_SCHED;
            PG8_LDB(B0, 1, 0); PG8_LDB(B1, 1, 1); PG8_SCHED; PG8_LDA(At, 1, 0); PG8_STAGE(PG8_SA(0, 1), a2 + hsA, voffA);
            PG8_WAIT_V(8); PG8_WAIT_L(0); PG8_BAR; PG8_MMA(0, 0, At, B0); PG8_MMA(0, 1, At, B1); PG8_BAR; PG8_SCHED;
            PG8_LDA(At, 1, 1); PG8_STAGE(PG8_SB(1, 0), b3, voffB); PG8_STAGE(PG8_SB(1, 1), b3 + hsB, voffB); PG8_STAGE(PG8_SA(1, 0), a3, voffA);
            PG8_WAIT_V(8); PG8_WAIT_L(0); PG8_BAR; PG8_MMA(1, 0, At, B0); PG8_MMA(1, 1, At, B1); PG8_BAR; PG8_SCHED;
            } else {
            PG8_LDB(B0, 0, 0); PG8_SCHED; PG8_LDA(At, 0, 0); PG8_STAGE(PG8_SA(1, 1), a1 + hsA, voffA);
            PG8_WAIT_L(8); PG8_BAR; PG8_WAIT_L(0); PG8_MMA(0, 0, At, B0); PG8_BAR; PG8_SCHED;
            PG8_LDB(B1, 0, 1); PG8_STAGE(PG8_SB(0, 0), b2, voffB);
            PG8_BAR; PG8_WAIT_L(0); PG8_MMA(0, 1, At, B1); PG8_BAR;
            PG8_LDA(At, 0, 1); PG8_STAGE(PG8_SA(0, 0), a2, voffA);
            PG8_BAR; PG8_WAIT_L(0); PG8_MMA(1, 0, At, B0); PG8_BAR; PG8_SCHED;
            PG8_STAGE(PG8_SB(0, 1), b2 + hsB, voffB);
            PG8_WAIT_V(6); PG8_BAR; PG8_MMA(1, 1, At, B1); PG8_BAR;
            PG8_LDB(B0, 1, 0); PG8_SCHED; PG8_LDA(At, 1, 0); PG8_STAGE(PG8_SA(0, 1), a2 + hsA, voffA);
            PG8_WAIT_L(8); PG8_BAR; PG8_WAIT_L(0); PG8_MMA(0, 0, At, B0); PG8_BAR; PG8_SCHED;
            PG8_LDB(B1, 1, 1); PG8_STAGE(PG8_SB(1, 0), b3, voffB);
            PG8_BAR; PG8_WAIT_L(0); PG8_MMA(0, 1, At, B1); PG8_BAR;
            PG8_LDA(At, 1, 1); PG8_STAGE(PG8_SA(1, 0), a3, voffA);
            PG8_BAR; PG8_WAIT_L(0); PG8_MMA(1, 0, At, B0); PG8_BAR; PG8_SCHED;
            PG8_STAGE(PG8_SB(1, 1), b3 + hsB, voffB);
            PG8_WAIT_V(6); PG8_BAR; PG8_MMA(1, 1, At, B1); PG8_BAR;
            }
        }
        if constexpr (ALIGN_EPI) { if (wr == 0) PG8_BAR; }
        if constexpr (!Epi::AFTER_DRAIN) { E(acc, cur, wr, wc, fr, fq); S.done(cur); }
        if (!has_next) break;
#pragma unroll
        for (int a = 0; a < 2; ++a)
#pragma unroll
            for (int b = 0; b < 2; ++b)
#pragma unroll
                for (int m = 0; m < 4; ++m)
#pragma unroll
                    for (int n = 0; n < 2; ++n) acc[a][b][m][n] = (f32x4){0.f, 0.f, 0.f, 0.f};
        cur = nxt; cA = nA; cB = nB; ++ui;
        if constexpr (ALIGN_EPI) { if (wr == 1) PG8_BAR; }
    }
    PG8_WAIT_V(0);
    if constexpr (!ALIGN_EPI) { if (wr == 0) PG8_BAR; }
    PG8_BAR;
    if constexpr (Epi::AFTER_DRAIN) { E.fused(acc, cur, wr, wc, fr, fq, lds, wid, lane); S.done(cur); }
#undef PG8_SA
#undef PG8_SB
#undef PG8_STAGE
#undef PG8_LDA
#undef PG8_LDB
#undef PG8_MMA
#undef PG8_WAIT_V
#undef PG8_WAIT_L
#undef PG8_BAR
#undef PG8_SCHED
}
}


#define LAS __attribute__((address_space(3)))
typedef unsigned short bf16;
typedef unsigned v4u __attribute__((ext_vector_type(4)));
typedef unsigned v2u __attribute__((ext_vector_type(2)));
typedef float f32x4 __attribute__((ext_vector_type(4)));
typedef float f32x2 __attribute__((ext_vector_type(2)));
typedef float f32x16 __attribute__((ext_vector_type(16)));
typedef short bf16x8 __attribute__((ext_vector_type(8)));
typedef short s16x4 __attribute__((ext_vector_type(4)));
typedef __bf16 bf16x2_t __attribute__((ext_vector_type(2)));

constexpr int NB = 8, SEQ = 4096, DM = 1024, MTOK = NB * SEQ;
constexpr int NIN = 2840, NINP = 3072, NSEG = NINP / 64, DFF = 2816, NGU = 2 * DFF;
constexpr float EPS = 1e-6f;
constexpr float LOG2E = 1.4426950408889634f;
constexpr int NTHREADS = 512, NWAVES = 8;
constexpr int LDS_BYTES = 147456 + 256;
constexpr int XB_LDS_OFF = 147456;
constexpr int HB_OFF = 131072;

constexpr size_t MiB = 1u << 20;
constexpr size_t WS_MOD = 0, WS_BIAS1 = 256 * 1024, WS_BAR = 512 * 1024, BAR_BYTES = 16384;
constexpr size_t WS_BT_IN = 1 * MiB, WS_BT_OUT = 7 * MiB, WS_BT_GU = 9 * MiB, WS_BT_DN = 20 * MiB, WS_BT_C1 = 26 * MiB;
constexpr size_t WS_HID = 28 * MiB, WS_KCN = 36 * MiB, WS_VCT = 36 * MiB + 512 * 1024, WS_GATES = 37 * MiB;
constexpr size_t WS_GTAIL = 40 * MiB, WS_GHEAD = 43 * MiB, WS_UHEAD = 46 * MiB;
constexpr size_t WS_KSN = 50 * MiB, WS_KWN = 58 * MiB, WS_VST = 66 * MiB, WS_VWT = 74 * MiB, WS_QN = 82 * MiB;
constexpr size_t WS_X1B = 50 * MiB;
constexpr size_t WS_XN = 114 * MiB, WS_MIXED = 178 * MiB, WS_PROJ = 242 * MiB, WS_H = WS_PROJ, WS_END = 434 * MiB;

struct Args { const float* in[26]; float* out; unsigned char* ws; };

#define LDS_WAIT() asm volatile("s_waitcnt lgkmcnt(0)" ::: "memory")
__device__ __forceinline__ unsigned f2bf(float f) { unsigned u = __builtin_bit_cast(unsigned, f); return (u + 0x7fffu + ((u >> 16) & 1u)) >> 16; }
__device__ __forceinline__ unsigned pk2(float lo, float hi) { f32x2 v = {lo, hi}; bf16x2_t b = __builtin_convertvector(v, bf16x2_t); return __builtin_bit_cast(unsigned, b); }
__device__ __forceinline__ float bf2f(unsigned short h) { return __builtin_bit_cast(float, (unsigned)h << 16); }
__device__ __forceinline__ float bflo(unsigned w) { return __builtin_bit_cast(float, w << 16); }
__device__ __forceinline__ float bfhi(unsigned w) { return __builtin_bit_cast(float, w & 0xffff0000u); }
__device__ __forceinline__ float wave_sum(float v) {
#pragma unroll
    for (int o = 1; o < 64; o <<= 1) v += __shfl_xor(v, o);
    return v;
}
__device__ __forceinline__ float silu_f(float x) { return x * __builtin_amdgcn_rcpf(1.0f + __builtin_amdgcn_exp2f(-LOG2E * x)); }
__device__ __forceinline__ float gelu_tanh_f(float x) { const float y = 0.7978845608028654f * (x + 0.044715f * x * x * x); const float t = 1.0f - 2.0f * __builtin_amdgcn_rcpf(__builtin_amdgcn_exp2f(2.0f * LOG2E * y) + 1.0f); return 0.5f * x * (1.0f + t); }

#define XB_TMO      128
#define XB_XCNT(j)  (256  + 64 * (j))
#define XB_XSUB(j)  (1280 + 64 * (j))
#define XB_XGEN(j)  (2304 + 64 * (j))
#define XB_TOP      3328
#define XB_TOPGEN   3392
#define XCD_BAR_WORDS 3456
#define XB_SPIN_CAP (1u << 18)

__device__ __forceinline__ unsigned xb_ld(unsigned* p)              { return __hip_atomic_load(p, __ATOMIC_RELAXED, __HIP_MEMORY_SCOPE_AGENT); }
__device__ __forceinline__ unsigned xb_add(unsigned* p, unsigned v) { return __hip_atomic_fetch_add(p, v, __ATOMIC_RELAXED, __HIP_MEMORY_SCOPE_AGENT); }
__device__ __forceinline__ unsigned xb_xcc_id() { return (unsigned)__builtin_amdgcn_s_getreg((3 << 11) | 20) & 0xFu; }
#define XB_SPIN(cond, bar) do { unsigned _sp = 0; while (cond) { __builtin_amdgcn_s_sleep(1); \
    if ((++_sp & 255u) == 0u) { if (xb_ld(&(bar)[XB_TMO])) break; if (_sp > XB_SPIN_CAP) { atomicAdd(&(bar)[XB_TMO], 1u); break; } } } } while (0)

struct XcdBarrier {
    unsigned* bar; unsigned x;
    volatile LAS unsigned* st;
};

__device__ __forceinline__ XcdBarrier xcd_barrier_post(unsigned* bar, volatile LAS unsigned* st) {
    XcdBarrier b; b.bar = bar; b.x = xb_xcc_id(); b.st = st;
    if (threadIdx.x == 0) (void)xb_add(&bar[XB_XCNT(b.x)], 1u);
    return b;
}
__device__ __forceinline__ void xcd_barrier_complete(unsigned* bar, unsigned x, unsigned& nloc, unsigned& nx) {
    const unsigned G = gridDim.x * gridDim.y * gridDim.z;
    unsigned sum, cnt, mine, sp = 0u;
    for (;;) {
        sum = 0u; cnt = 0u; mine = 0u;
#pragma unroll
        for (unsigned j = 0; j < 16; ++j) { const unsigned c = xb_ld(&bar[XB_XCNT(j)]); sum += c; cnt += (c > 0u) ? 1u : 0u; mine = (j == x) ? c : mine; }
        if (sum == G) break;
        __builtin_amdgcn_s_sleep(1);
        if ((++sp & 255u) == 0u) { if (xb_ld(&bar[XB_TMO])) break; if (sp > XB_SPIN_CAP) { atomicAdd(&bar[XB_TMO], 1u); break; } }
    }
    nloc = mine > 0u ? mine : 1u; nx = cnt > 0u ? cnt : 1u;
}

__device__ __forceinline__ void xcd_barrier(const XcdBarrier& b) {
    asm volatile("s_waitcnt vmcnt(0)" ::: "memory");
    __syncthreads();
    if (threadIdx.x == 0) {
        unsigned* bar = b.bar;
        __builtin_amdgcn_s_waitcnt(0);
        unsigned nloc = b.st[0], nx = b.st[1];
        if (nloc == 0u) { xcd_barrier_complete(bar, b.x, nloc, nx); b.st[0] = nloc; b.st[1] = nx; }
        const unsigned old = xb_add(&bar[XB_XSUB(b.x)], 1u);
        const unsigned gen = old / nloc;
        if (old + 1u == (gen + 1u) * nloc) {
            __builtin_amdgcn_fence(__ATOMIC_RELEASE, "agent");
            asm volatile("s_waitcnt vmcnt(0)" ::: "memory");
            const unsigned og = xb_add(&bar[XB_TOP], 1u);
            const unsigned tg = og / nx;
            if (og + 1u == (tg + 1u) * nx) xb_add(&bar[XB_TOPGEN], 1u);
            else XB_SPIN(xb_ld(&bar[XB_TOPGEN]) == tg, bar);
            __builtin_amdgcn_fence(__ATOMIC_ACQUIRE, "agent");
            xb_add(&bar[XB_XGEN(b.x)], 1u);
            asm volatile("s_waitcnt vmcnt(0)" ::: "memory");
        } else {
            XB_SPIN(xb_ld(&bar[XB_XGEN(b.x)]) == gen, bar);
            __builtin_amdgcn_fence(__ATOMIC_ACQUIRE, "agent");
            asm volatile("s_waitcnt vmcnt(0)" ::: "memory");
        }
    }
    __syncthreads();
}


__device__ __forceinline__ void transpose_item(const float* __restrict__ W, int K, int N, bf16* WT, int k0, int n0, int drow0, LAS float* scr, int lane) {
    const int nn = n0 + (lane & 31);
#pragma unroll 8
    for (int i = 0; i < 32; ++i) { const int kk = 2 * i + (lane >> 5); scr[kk * 33 + (lane & 31)] = (nn < N) ? W[(size_t)(k0 + kk) * N + nn] : 0.0f; }
    LDS_WAIT(); asm volatile("" ::: "memory");
    const int c = lane & 7;
#pragma unroll
    for (int j = 0; j < 4; ++j) { const int n = (lane >> 3) + 8 * j; const LAS float* s = scr + (8 * c) * 33 + n;
        v4u o; o.x = pk2(s[0 * 33], s[1 * 33]); o.y = pk2(s[2 * 33], s[3 * 33]); o.z = pk2(s[4 * 33], s[5 * 33]); o.w = pk2(s[6 * 33], s[7 * 33]);
        *(v4u*)(WT + (size_t)(drow0 + n) * K + k0 + 8 * c) = o; }
    LDS_WAIT(); asm volatile("" ::: "memory");
}

__device__ __forceinline__ void phase0(const Args& a, LAS unsigned char* lds) {
    int tid_ = threadIdx.x; asm volatile("" : "+v"(tid_)); const int tid = tid_, lane = tid & 63, wave = tid >> 6, G = gridDim.x;
    unsigned char* ws = a.ws;
    LAS float* SC = (LAS float*)lds;
    LAS float* RED = (LAS float*)(lds + 32768);
    float* mod = (float*)(ws + WS_MOD);
    float* bias1 = (float*)(ws + WS_BIAS1);
    for (int it = blockIdx.x; it < 208; it += G) {
        const int cl = tid & 31, sl = tid >> 5;
        if (it < 192) {
            const float* c = a.in[1]; const float* w_ada = a.in[2]; const float* b_ada = a.in[3];
            for (int i = tid; i < 8192; i += NTHREADS) { const float v = c[i]; SC[i] = silu_f(v); }
            __syncthreads();
            float acc[8];
#pragma unroll
            for (int b = 0; b < 8; ++b) acc[b] = 0.f;
            const int col = it * 32 + cl;
#pragma unroll 8
            for (int k = sl * 64; k < sl * 64 + 64; ++k) {
                const float w = w_ada[(size_t)k * 6144 + col];
#pragma unroll
                for (int b = 0; b < 8; ++b) acc[b] += SC[b * 1024 + k] * w;
            }
#pragma unroll
            for (int b = 0; b < 8; ++b) RED[(sl * 8 + b) * 32 + cl] = acc[b];
            __syncthreads();
            if (tid < 256) { const int b = tid >> 5; float s = 0.f;
#pragma unroll
              for (int w = 0; w < 16; ++w) s += RED[(w * 8 + b) * 32 + cl];
              mod[b * 6144 + it * 32 + cl] = s + b_ada[it * 32 + cl]; }
            __syncthreads();
        } else {
            const int q = it - 192, kv = q >> 3, cgp = q & 7;
            const float* pos = a.in[11 + kv]; const float* w1 = a.in[13 + 2 * kv];
            float acc = 0.f;
#pragma unroll 8
            for (int k = sl * 128; k < sl * 128 + 128; ++k) acc += pos[k] * w1[(size_t)k * 256 + cgp * 32 + cl];
            RED[sl * 32 + cl] = acc;
            __syncthreads();
            if (tid < 32) { float s = 0.f;
#pragma unroll
                for (int w = 0; w < 16; ++w) s += RED[w * 32 + tid];
                bias1[kv * 256 + cgp * 32 + tid] = s; }
            __syncthreads();
        }
    }
}

__device__ __forceinline__ void weight_copies(const Args& a, LAS unsigned char* lds) {
    int tid_ = threadIdx.x; asm volatile("" : "+v"(tid_)); const int tid = tid_, lane = tid & 63, wave = tid >> 6, G = gridDim.x;
    unsigned char* ws = a.ws;
    LAS float* scr = (LAS float*)(lds + 49152 + wave * 8448);
    const int gw = blockIdx.x * NWAVES + wave, NGW = G * NWAVES;
    constexpr int I_IN = 16 * 96, I_OUT = 16 * 32, I_G = 16 * 88, I_D = 44 * 32, I_C = 32 * 8;
    constexpr int TOT = I_IN + I_OUT + 2 * I_G + I_D + 2 * I_C;
    for (int it = gw; it < TOT; it += NGW) {
        int r = it;
        if (r < I_IN) { const int kb = r / 96, nb = r % 96; transpose_item(a.in[5], 1024, NIN, (bf16*)(ws + WS_BT_IN), 64 * kb, 32 * nb, 32 * nb, scr, lane); continue; } r -= I_IN;
        if (r < I_OUT) { const int kb = r / 32, nb = r % 32; transpose_item(a.in[20], 1024, 1024, (bf16*)(ws + WS_BT_OUT), 64 * kb, 32 * nb, 32 * nb, scr, lane); continue; } r -= I_OUT;
        if (r < I_G) { const int kb = r / 88, nb = r % 88, n0 = 32 * nb; transpose_item(a.in[22], 1024, DFF, (bf16*)(ws + WS_BT_GU), 64 * kb, n0, 256 * (n0 >> 7) + (n0 & 127), scr, lane); continue; } r -= I_G;
        if (r < I_G) { const int kb = r / 88, nb = r % 88, n0 = 32 * nb; transpose_item(a.in[23], 1024, DFF, (bf16*)(ws + WS_BT_GU), 64 * kb, n0, 256 * (n0 >> 7) + (n0 & 127) + 128, scr, lane); continue; } r -= I_G;
        if (r < I_D) { const int kb = r / 32, nb = r % 32; transpose_item(a.in[25], DFF, 1024, (bf16*)(ws + WS_BT_DN), 64 * kb, 32 * nb, 32 * nb, scr, lane); continue; } r -= I_D;
        if (r < I_C) { const int kb = r / 8, nb = r % 8; transpose_item(a.in[13], 2048, 256, (bf16*)(ws + WS_BT_C1), 64 * kb, 32 * nb, 32 * nb, scr, lane); continue; } r -= I_C;
        { const int kb = r / 8, nb = r % 8; transpose_item(a.in[15], 2048, 256, (bf16*)(ws + WS_BT_C1) + 256 * 2048, 64 * kb, 32 * nb, 32 * nb, scr, lane); }
    }
}

__device__ __forceinline__ void norm_rows(const float* __restrict__ src, const float* __restrict__ gamma, const float* __restrict__ mod, int sh_off, int sc_off, bf16* dst) {
    int tid_ = threadIdx.x; asm volatile("" : "+v"(tid_)); const int tid = tid_, lane = tid & 63, wave = tid >> 6;
    const int gw = blockIdx.x * NWAVES + wave, NGW = gridDim.x * NWAVES;
    const int per = (MTOK + NGW - 1) / NGW;
    const int r0 = gw * per, r1 = (r0 + per) < MTOK ? (r0 + per) : MTOK;
    if (r0 >= r1) return;
    f32x4 ga[4], sh[4];
    int bcur = -1;
    f32x4 va[4], vb[4];
    { const f32x4* xr = (const f32x4*)(src + (size_t)r0 * DM) + lane;
#pragma unroll
      for (int j = 0; j < 4; ++j) va[j] = xr[64 * j]; }
    { const int rr = (r0 + 1 < r1) ? r0 + 1 : r0; const f32x4* xr = (const f32x4*)(src + (size_t)rr * DM) + lane;
#pragma unroll
      for (int j = 0; j < 4; ++j) vb[j] = xr[64 * j]; }
    for (int row = r0; row < r1; ++row) {
        f32x4 v[4];
#pragma unroll
        for (int j = 0; j < 4; ++j) { v[j] = va[j]; va[j] = vb[j]; }
        { const int rr = (row + 2 < r1) ? row + 2 : row; const f32x4* xr = (const f32x4*)(src + (size_t)rr * DM) + lane;
#pragma unroll
          for (int j = 0; j < 4; ++j) vb[j] = xr[64 * j]; }
        const int b = row >> 12;
        if (b != bcur) { bcur = b; const float* mb = mod + b * 6144;
#pragma unroll
            for (int j = 0; j < 4; ++j) { const int col = 4 * lane + 256 * j; const f32x4 gv = *(const f32x4*)(gamma + col), sc = *(const f32x4*)(mb + sc_off + col);
                sh[j] = *(const f32x4*)(mb + sh_off + col); ga[j] = gv * (1.0f + sc); } }
        float ss = 0.f;
#pragma unroll
        for (int j = 0; j < 4; ++j) ss += v[j][0] * v[j][0] + v[j][1] * v[j][1] + v[j][2] * v[j][2] + v[j][3] * v[j][3];
        ss = wave_sum(ss);
        const float rstd = rsqrtf(ss * (1.0f / DM) + EPS);
#pragma unroll
        for (int j = 0; j < 4; ++j) {
            const int col = 4 * lane + 256 * j;
            f32x4 y;
#pragma unroll
            for (int e = 0; e < 4; ++e) y[e] = (v[j][e] * rstd) * ga[j][e] + sh[j][e];
            v2u o; o.x = pk2(y[0], y[1]); o.y = pk2(y[2], y[3]);
            *(v2u*)(dst + (size_t)row * DM + col) = o;
        }
    }
}

__device__ __forceinline__ void norm_rows_b(const bf16* __restrict__ src, const float* __restrict__ gamma, const float* __restrict__ mod, int sh_off, int sc_off, bf16* dst) {
    int tid_ = threadIdx.x; asm volatile("" : "+v"(tid_)); const int tid = tid_, lane = tid & 63, wave = tid >> 6;
    const int gw = blockIdx.x * NWAVES + wave, NGW = gridDim.x * NWAVES;
    const int per = (MTOK + NGW - 1) / NGW;
    const int r0 = gw * per, r1 = (r0 + per) < MTOK ? (r0 + per) : MTOK;
    if (r0 >= r1) return;
    f32x4 ga[4], sh[4];
    int bcur = -1;
    v4u va[2], vb[2];
    { const v4u* xr = (const v4u*)(src + (size_t)r0 * DM) + lane; va[0] = xr[0]; va[1] = xr[64]; }
    { const int rr = (r0 + 1 < r1) ? r0 + 1 : r0; const v4u* xr = (const v4u*)(src + (size_t)rr * DM) + lane; vb[0] = xr[0]; vb[1] = xr[64]; }
    for (int row = r0; row < r1; ++row) {
        v4u raw[2]; raw[0] = va[0]; raw[1] = va[1]; va[0] = vb[0]; va[1] = vb[1];
        { const int rr = (row + 2 < r1) ? row + 2 : row; const v4u* xr = (const v4u*)(src + (size_t)rr * DM) + lane; vb[0] = xr[0]; vb[1] = xr[64]; }
        const int b = row >> 12;
        if (b != bcur) { bcur = b; const float* mb = mod + b * 6144;
#pragma unroll
            for (int j = 0; j < 4; ++j) { const int col = 512 * (j >> 1) + 8 * lane + 4 * (j & 1); const f32x4 gv = *(const f32x4*)(gamma + col), sc = *(const f32x4*)(mb + sc_off + col);
                sh[j] = *(const f32x4*)(mb + sh_off + col); ga[j] = gv * (1.0f + sc); } }
        f32x4 v[4];
#pragma unroll
        for (int h = 0; h < 2; ++h) { v[2 * h] = (f32x4){bflo(raw[h].x), bfhi(raw[h].x), bflo(raw[h].y), bfhi(raw[h].y)}; v[2 * h + 1] = (f32x4){bflo(raw[h].z), bfhi(raw[h].z), bflo(raw[h].w), bfhi(raw[h].w)}; }
        float ss = 0.f;
#pragma unroll
        for (int j = 0; j < 4; ++j) ss += v[j][0] * v[j][0] + v[j][1] * v[j][1] + v[j][2] * v[j][2] + v[j][3] * v[j][3];
        ss = wave_sum(ss);
        const float rstd = rsqrtf(ss * (1.0f / DM) + EPS);
#pragma unroll
        for (int h = 0; h < 2; ++h) {
            f32x4 y0, y1;
#pragma unroll
            for (int e = 0; e < 4; ++e) { y0[e] = (v[2 * h][e] * rstd) * ga[2 * h][e] + sh[2 * h][e]; y1[e] = (v[2 * h + 1][e] * rstd) * ga[2 * h + 1][e] + sh[2 * h + 1][e]; }
            v4u o; o.x = pk2(y0[0], y0[1]); o.y = pk2(y0[2], y0[3]); o.z = pk2(y1[0], y1[1]); o.w = pk2(y1[2], y1[3]);
            *(v4u*)(dst + (size_t)row * DM + 512 * h + 8 * lane) = o;
        }
    }
}

__device__ __forceinline__ float dpp_shr1(float v) { return __builtin_bit_cast(float, __builtin_amdgcn_update_dpp(0, __builtin_bit_cast(int, v), 0x111, 0xf, 0xf, true)); }
__device__ __forceinline__ float dpp_shr2(float v) { return __builtin_bit_cast(float, __builtin_amdgcn_update_dpp(0, __builtin_bit_cast(int, v), 0x112, 0xf, 0xf, true)); }
__device__ __forceinline__ unsigned dpp_ror8(unsigned v) { return (unsigned)__builtin_amdgcn_update_dpp(0, (int)v, 0x128, 0xf, 0xf, false); }
struct EpiProj {
    static constexpr bool PERM = true, PERM2 = true, AFTER_DRAIN = false;
    bf16* P; bf16* QN; bf16* KSN; bf16* KWN; float* gates; const float* gq; const float* gs; const float* gw; const float* bgate;
    __device__ __forceinline__ void operator()(const f32x4 (&acc)[2][2][4][2], const pg8::Unit& u, int wr, int wc, int fr, int fq) const {
        const bool lo = fr < 8;
        const int colb = u.pn * 256 + wc * 64, seg = colb >> 6, d = (lo ? 0 : 32) + 8 * fq;
        const bool keep = (colb + d) < NIN;
        const int rowb = u.pm * 256 + wr * 64 + (fr & 7);
        bf16* base = P; int ns = NSEG, sidx = seg; const float* gm = nullptr; float mult = 1.0f;
        if (seg < 8) { base = QN; ns = 8; gm = gq; mult = 0.125f * LOG2E; }
        else if (seg == 12 || seg == 13) { base = KSN; ns = 2; sidx = seg - 12; gm = gs; }
        else if (seg == 16 || seg == 17) { base = KWN; ns = 2; sidx = seg - 16; gm = gw; }
        f32x4 g00 = {1.f, 1.f, 1.f, 1.f}, g01 = g00, g10 = g00, g11 = g00;
        if (gm) { g00 = *(const f32x4*)(gm + 8 * fq); g01 = *(const f32x4*)(gm + 8 * fq + 4); g10 = *(const f32x4*)(gm + 32 + 8 * fq); g11 = *(const f32x4*)(gm + 32 + 8 * fq + 4); }
#pragma unroll
        for (int ai = 0; ai < 2; ++ai)
#pragma unroll
            for (int m = 0; m < 4; ++m) {
                f32x4 a0 = acc[ai][0][m][0], a1 = acc[ai][0][m][1], b0 = acc[ai][1][m][0], b1 = acc[ai][1][m][1];
                const int rown = u.pm * 256 + wr * 64 + ai * 128 + m * 16 + fr;
                if (gm) {
                    float ss = 0.f;
#pragma unroll
                    for (int e = 0; e < 4; ++e) ss += a0[e] * a0[e] + a1[e] * a1[e] + b0[e] * b0[e] + b1[e] * b1[e];
                    ss += __shfl_xor(ss, 16); ss += __shfl_xor(ss, 32);
                    const float rs = rsqrtf(ss * (1.0f / 64.0f) + EPS) * mult;
                    a0 = a0 * rs * g00; a1 = a1 * rs * g01; b0 = b0 * rs * g10; b1 = b1 * rs * g11;
                } else if (seg == 20 && fq < 3) {
                    const f32x4 bg0 = *(const f32x4*)(bgate + 8 * fq), bg1 = *(const f32x4*)(bgate + 8 * fq + 4);
                    f32x4 s0, s1;
#pragma unroll
                    for (int e = 0; e < 4; ++e) { s0[e] = __builtin_amdgcn_rcpf(1.0f + __builtin_amdgcn_exp2f(-LOG2E * (a0[e] + bg0[e]))); s1[e] = __builtin_amdgcn_rcpf(1.0f + __builtin_amdgcn_exp2f(-LOG2E * (a1[e] + bg1[e]))); }
                    *(f32x4*)(gates + (size_t)rown * 24 + 8 * fq) = s0; *(f32x4*)(gates + (size_t)rown * 24 + 8 * fq + 4) = s1;
                }
                v4u p0, p1; p0.x = pk2(a0[0], a0[1]); p0.y = pk2(a0[2], a0[3]); p0.z = pk2(a1[0], a1[1]); p0.w = pk2(a1[2], a1[3]);
                p1.x = pk2(b0[0], b0[1]); p1.y = pk2(b0[2], b0[3]); p1.z = pk2(b1[0], b1[1]); p1.w = pk2(b1[2], b1[3]);
                const unsigned sx = lo ? p1.x : p0.x, sy = lo ? p1.y : p0.y, sz = lo ? p1.z : p0.z, sw = lo ? p1.w : p0.w;
                v4u rc; rc.x = dpp_ror8(sx); rc.y = dpp_ror8(sy); rc.z = dpp_ror8(sz); rc.w = dpp_ror8(sw);
                v4u s1, s2;
                s1.x = lo ? p0.x : rc.x; s1.y = lo ? p0.y : rc.y; s1.z = lo ? p0.z : rc.z; s1.w = lo ? p0.w : rc.w;
                s2.x = lo ? rc.x : p1.x; s2.y = lo ? rc.y : p1.y; s2.z = lo ? rc.z : p1.z; s2.w = lo ? rc.w : p1.w;
                const int r = rowb + ai * 128 + m * 16, b = r >> 12, t = r & 4095;
                bf16* dst = base + ((size_t)(b * ns + sidx) * SEQ + t) * 64 + d;
                if (keep) { __builtin_nontemporal_store(s1, (v4u*)dst); __builtin_nontemporal_store(s2, (v4u*)(dst + 8 * 64)); }
            }
    }
};
struct EpiRes {
    static constexpr bool PERM = true, PERM2 = false, AFTER_DRAIN = false;
    const float* base; float* out; const float* mod; int goff;
    __device__ __forceinline__ void operator()(const f32x4 (&acc)[2][2][4][2], const pg8::Unit& u, int wr, int wc, int fr, int fq) const {
        const int row0 = u.pm * 256 + wr * 64 + fr, col0 = u.pn * 256 + wc * 32 + 8 * fq;
        const int b = (u.pm * 256) >> 12;
        f32x4 gv[2][2];
#pragma unroll
        for (int bj = 0; bj < 2; ++bj)
#pragma unroll
            for (int n = 0; n < 2; ++n) gv[bj][n] = *(const f32x4*)(mod + b * 6144 + goff + col0 + bj * 128 + n * 4);
#pragma unroll
        for (int ai = 0; ai < 2; ++ai) {
            f32x4 xv[4][2][2];
#pragma unroll
            for (int m = 0; m < 4; ++m) { const size_t r = (size_t)(row0 + ai * 128 + m * 16);
#pragma unroll
                for (int bj = 0; bj < 2; ++bj)
#pragma unroll
                    for (int n = 0; n < 2; ++n) xv[m][bj][n] = *(const f32x4*)(base + r * DM + col0 + bj * 128 + n * 4); }
#pragma unroll
            for (int m = 0; m < 4; ++m) { const size_t r = (size_t)(row0 + ai * 128 + m * 16);
#pragma unroll
                for (int bj = 0; bj < 2; ++bj)
#pragma unroll
                    for (int n = 0; n < 2; ++n) *(f32x4*)(out + r * DM + col0 + bj * 128 + n * 4) = xv[m][bj][n] + gv[bj][n] * acc[ai][bj][m][n]; }
        }
    }
};
struct EpiResB {
    static constexpr bool PERM = true, PERM2 = false, AFTER_DRAIN = false;
    const float* base; bf16* out; const float* mod; int goff;
    __device__ __forceinline__ void operator()(const f32x4 (&acc)[2][2][4][2], const pg8::Unit& u, int wr, int wc, int fr, int fq) const {
        const int row0 = u.pm * 256 + wr * 64 + fr, col0 = u.pn * 256 + wc * 32 + 8 * fq;
        const int b = (u.pm * 256) >> 12;
        f32x4 gv[2][2];
#pragma unroll
        for (int bj = 0; bj < 2; ++bj)
#pragma unroll
            for (int n = 0; n < 2; ++n) gv[bj][n] = *(const f32x4*)(mod + b * 6144 + goff + col0 + bj * 128 + n * 4);
#pragma unroll
        for (int ai = 0; ai < 2; ++ai) {
            f32x4 xv[4][2][2];
#pragma unroll
            for (int m = 0; m < 4; ++m) { const size_t r = (size_t)(row0 + ai * 128 + m * 16);
#pragma unroll
                for (int bj = 0; bj < 2; ++bj)
#pragma unroll
                    for (int n = 0; n < 2; ++n) xv[m][bj][n] = *(const f32x4*)(base + r * DM + col0 + bj * 128 + n * 4); }
#pragma unroll
            for (int m = 0; m < 4; ++m) { const size_t r = (size_t)(row0 + ai * 128 + m * 16);
#pragma unroll
                for (int bj = 0; bj < 2; ++bj) { const f32x4 v0 = xv[m][bj][0] + gv[bj][0] * acc[ai][bj][m][0], v1 = xv[m][bj][1] + gv[bj][1] * acc[ai][bj][m][1];
                    v4u w; w.x = pk2(v0[0], v0[1]); w.y = pk2(v0[2], v0[3]); w.z = pk2(v1[0], v1[1]); w.w = pk2(v1[2], v1[3]);
                    *(v4u*)(out + r * DM + col0 + bj * 128) = w; } }
        }
    }
};
struct EpiResF {
    static constexpr bool PERM = true, PERM2 = false, AFTER_DRAIN = false;
    const bf16* base; float* out; const float* mod; int goff;
    __device__ __forceinline__ void operator()(const f32x4 (&acc)[2][2][4][2], const pg8::Unit& u, int wr, int wc, int fr, int fq) const {
        const int row0 = u.pm * 256 + wr * 64 + fr, col0 = u.pn * 256 + wc * 32 + 8 * fq;
        const int b = (u.pm * 256) >> 12;
        f32x4 gv[2][2];
#pragma unroll
        for (int bj = 0; bj < 2; ++bj)
#pragma unroll
            for (int n = 0; n < 2; ++n) gv[bj][n] = *(const f32x4*)(mod + b * 6144 + goff + col0 + bj * 128 + n * 4);
#pragma unroll
        for (int ai = 0; ai < 2; ++ai) {
            v4u xv[4][2];
#pragma unroll
            for (int m = 0; m < 4; ++m) { const size_t r = (size_t)(row0 + ai * 128 + m * 16);
#pragma unroll
                for (int bj = 0; bj < 2; ++bj) xv[m][bj] = *(const v4u*)(base + r * DM + col0 + bj * 128); }
#pragma unroll
            for (int m = 0; m < 4; ++m) { const size_t r = (size_t)(row0 + ai * 128 + m * 16);
#pragma unroll
                for (int bj = 0; bj < 2; ++bj) { const v4u x = xv[m][bj];
                    const f32x4 x0 = {bflo(x.x), bfhi(x.x), bflo(x.y), bfhi(x.y)}, x1 = {bflo(x.z), bfhi(x.z), bflo(x.w), bfhi(x.w)};
                    *(f32x4*)(out + r * DM + col0 + bj * 128) = x0 + gv[bj][0] * acc[ai][bj][m][0];
                    *(f32x4*)(out + r * DM + col0 + bj * 128 + 4) = x1 + gv[bj][1] * acc[ai][bj][m][1]; } }
        }
    }
};
struct EpiCmp {
    static constexpr bool PERM = false, PERM2 = false, AFTER_DRAIN = false;
    float* hid; const float* bias1;
    __device__ __forceinline__ void operator()(const f32x4 (&acc)[2][2][4][2], const pg8::Unit& u, int wr, int wc, int fr, int fq) const {
        const int row0 = wr * 64 + fr, col0 = wc * 32 + 4 * fq;
        float* hb = hid + ((size_t)u.pn * 4096 + (size_t)u.pm * 256) * 256;
#pragma unroll
        for (int ai = 0; ai < 2; ++ai)
#pragma unroll
            for (int m = 0; m < 4; ++m) { const int r = row0 + ai * 128 + m * 16;
#pragma unroll
                for (int bj = 0; bj < 2; ++bj)
#pragma unroll
                    for (int n = 0; n < 2; ++n) { const int c = col0 + bj * 128 + n * 16;
                        const f32x4 bv = *(const f32x4*)(bias1 + u.pn * 256 + c); f32x4 v = acc[ai][bj][m][n] + bv;
#pragma unroll
                        for (int e = 0; e < 4; ++e) v[e] = gelu_tanh_f(v[e]);
                        *(f32x4*)(hb + (size_t)r * 256 + c) = v; } }
    }
};
struct CmpOrder {
    int c; const bf16* proj; const bf16* btc1;
    __device__ bool next(int i, pg8::Unit& u) const { if (i > 0 || c >= 32) return false; u.pm = c & 15; u.pn = c >> 4; return true; }
    __device__ __forceinline__ const char* a_ptr(const pg8::Gemm&, const pg8::Unit& u) const { const int b = u.pm >> 1, g = u.pm & 1; return (const char*)(proj + ((size_t)(b * NSEG + 8 + 2 * u.pn + g) * SEQ) * 64); }
    __device__ __forceinline__ const char* b_ptr(const pg8::Gemm&, const pg8::Unit& u) const { return (const char*)(btc1 + (size_t)u.pn * 256 * 2048); }
    __device__ __forceinline__ void a_ready(const pg8::Unit&) const {}
    __device__ __forceinline__ void done(const pg8::Unit&) const {}
};
struct EpiFfn {
    static constexpr bool PERM = true, PERM2 = false, AFTER_DRAIN = false;
    bf16* H; const float* cw; float* gtail; float* ghead; float* uhead; LAS float* hb;
    __device__ __forceinline__ void operator()(const f32x4 (&acc)[2][2][4][2], const pg8::Unit& u, int wr, int wc, int fr, int fq) const {
        int cl_ = wc * 32 + 8 * fq; asm volatile("" : "+v"(cl_));
        const int cl = cl_, ch0 = u.pn * 128 + cl;
        if (fr >= 14) {
#pragma unroll
            for (int ai = 0; ai < 2; ++ai)
#pragma unroll
                for (int m = 0; m < 4; ++m) { const int kk = 8 * ai + 4 * wr + m;
#pragma unroll
                    for (int n = 0; n < 2; ++n) *(LAS f32x4*)(hb + ((kk * 2 + (fr - 14)) * 128 + cl + 4 * n)) = acc[ai][0][m][n]; }
        }
        asm volatile("s_waitcnt lgkmcnt(0)" ::: "memory"); __builtin_amdgcn_s_barrier(); asm volatile("" ::: "memory");
        f32x4 w0[2], w1[2], w2[2];
#pragma unroll
        for (int n = 0; n < 2; ++n) { w0[n] = *(const f32x4*)(cw + ch0 + 4 * n); w1[n] = *(const f32x4*)(cw + DFF + ch0 + 4 * n); w2[n] = *(const f32x4*)(cw + 2 * DFF + ch0 + 4 * n); }
#pragma unroll
        for (int ai = 0; ai < 2; ++ai)
#pragma unroll
            for (int m = 0; m < 4; ++m) { const int kk = 8 * ai + 4 * wr + m; const int rl = 128 * ai + 64 * wr + 16 * m + fr; const size_t r = (size_t)u.pm * 256 + rl;
                f32x4 hv[2];
#pragma unroll
                for (int n = 0; n < 2; ++n) { const f32x4 g0 = acc[ai][0][m][n]; f32x4 g1, g2;
                    g1[0] = dpp_shr1(g0[0]); g1[1] = dpp_shr1(g0[1]); g1[2] = dpp_shr1(g0[2]); g1[3] = dpp_shr1(g0[3]);
                    g2[0] = dpp_shr2(g0[0]); g2[1] = dpp_shr2(g0[1]); g2[2] = dpp_shr2(g0[2]); g2[3] = dpp_shr2(g0[3]);
                    if (fr < 2) { const f32x4 z = {0.f, 0.f, 0.f, 0.f};
                        const f32x4 p15 = kk > 0 ? *(const LAS f32x4*)(hb + (((kk - 1) * 2 + 1) * 128 + cl + 4 * n)) : z;
                        const f32x4 p14 = kk > 0 ? *(const LAS f32x4*)(hb + (((kk - 1) * 2 + 0) * 128 + cl + 4 * n)) : z;
                        if (fr == 0) { g1 = p15; g2 = p14; } else { g2 = p15; } }
                    const f32x4 pre = w0[n] * g2 + w1[n] * g1 + w2[n] * g0; const f32x4 up = acc[ai][1][m][n];
#pragma unroll
                    for (int e = 0; e < 4; ++e) hv[n][e] = silu_f(pre[e]) * up[e];
                    if (kk == 0 && fr < 2) { *(f32x4*)(ghead + ((size_t)u.pm * 2 + fr) * DFF + ch0 + 4 * n) = g0; *(f32x4*)(uhead + ((size_t)u.pm * 2 + fr) * DFF + ch0 + 4 * n) = up; }
                    if (kk == 15 && fr >= 14) *(f32x4*)(gtail + ((size_t)u.pm * 2 + (fr - 14)) * DFF + ch0 + 4 * n) = g0;
                }
                v4u w; w.x = pk2(hv[0][0], hv[0][1]); w.y = pk2(hv[0][2], hv[0][3]); w.z = pk2(hv[1][0], hv[1][1]); w.w = pk2(hv[1][2], hv[1][3]);
                __builtin_nontemporal_store(w, (v4u*)(H + r * DFF + ch0)); }
    }
};

__device__ __forceinline__ void phase3_prep(const Args& a, LAS unsigned char* lds, int pw, int PW) {
    int tid_ = threadIdx.x; asm volatile("" : "+v"(tid_)); const int tid = tid_, lane = tid & 63, wave = tid >> 6;
    unsigned char* ws = a.ws;
    const bf16* __restrict__ proj = (const bf16*)(ws + WS_PROJ);
    {
        bf16* mixed = (bf16*)(ws + WS_MIXED);
        const float* cw = a.in[17]; const float* cg_g = a.in[19];
        const int sub = lane & 7;
        constexpr int NST = NB * 8 * SEQ / 8;
        for (int st0 = pw; st0 < NST; st0 += 2 * PW) {
            v4u rb[2], rc0[2], rx0[2], rc1[2], rx1[2], rc2[2], rx2[2];
#pragma unroll
            for (int u = 0; u < 2; ++u) { const int st1 = st0 + u * PW, st = st1 < NST ? st1 : NST - 1;
                {
                    const int b = st >> 12, cgp = (st >> 9) & 7, t = (st & 511) * 8 + (lane >> 3);
                    const int c = cgp * 64 + sub * 8;
                    const int colB = 1304 + c, colC = 1816 + c, colX = 2328 + c;
                    const bf16* pB = proj + ((size_t)(b * NSEG + (colB >> 6)) * SEQ + t) * 64 + (colB & 63);
                    const bf16* pC = proj + ((size_t)(b * NSEG + (colC >> 6)) * SEQ + t) * 64 + (colC & 63);
                    const bf16* pX = proj + ((size_t)(b * NSEG + (colX >> 6)) * SEQ + t) * 64 + (colX & 63);
                    const v4u z = {0u, 0u, 0u, 0u};
                    rb[u] = *(const v4u*)pB; rc0[u] = *(const v4u*)pC; rx0[u] = *(const v4u*)pX;
                    rc1[u] = t >= 1 ? *(const v4u*)(pC - 64) : z; rx1[u] = t >= 1 ? *(const v4u*)(pX - 64) : z;
                    rc2[u] = t >= 2 ? *(const v4u*)(pC - 128) : z; rx2[u] = t >= 2 ? *(const v4u*)(pX - 128) : z; } }
#pragma unroll
            for (int u = 0; u < 2; ++u) { const int st1 = st0 + u * PW, st = st1 < NST ? st1 : NST - 1;
                {
                    const int b = st >> 12, cgp = (st >> 9) & 7, t = (st & 511) * 8 + (lane >> 3);
                    const int c = cgp * 64 + sub * 8;
                    const f32x4 w0a = *(const f32x4*)(cw + c), w0b = *(const f32x4*)(cw + c + 4), w1a = *(const f32x4*)(cw + 512 + c), w1b = *(const f32x4*)(cw + 512 + c + 4);
                    const f32x4 w2a = *(const f32x4*)(cw + 1024 + c), w2b = *(const f32x4*)(cw + 1024 + c + 4), ga = *(const f32x4*)(cg_g + c), gb = *(const f32x4*)(cg_g + c + 4);
                    float v[8];
#define CONV_E(e, RW, W0, W1, W2, LOHI) v[e] = LOHI(rb[u].RW) * (W0 * (LOHI(rc2[u].RW) * LOHI(rx2[u].RW)) + W1 * (LOHI(rc1[u].RW) * LOHI(rx1[u].RW)) + W2 * (LOHI(rc0[u].RW) * LOHI(rx0[u].RW)))
                    CONV_E(0, x, w0a[0], w1a[0], w2a[0], bflo); CONV_E(1, x, w0a[1], w1a[1], w2a[1], bfhi); CONV_E(2, y, w0a[2], w1a[2], w2a[2], bflo); CONV_E(3, y, w0a[3], w1a[3], w2a[3], bfhi);
                    CONV_E(4, z, w0b[0], w1b[0], w2b[0], bflo); CONV_E(5, z, w0b[1], w1b[1], w2b[1], bfhi); CONV_E(6, w, w0b[2], w1b[2], w2b[2], bflo); CONV_E(7, w, w0b[3], w1b[3], w2b[3], bfhi);
#undef CONV_E
                    float ss = 0.f;
#pragma unroll
                    for (int e = 0; e < 8; ++e) ss += v[e] * v[e];
                    ss += __shfl_xor(ss, 1); ss += __shfl_xor(ss, 2); ss += __shfl_xor(ss, 4);
                    const float rs = rsqrtf(ss * (1.0f / 64.0f) + EPS);
                    v4u o; o.x = pk2(v[0] * rs * ga[0], v[1] * rs * ga[1]); o.y = pk2(v[2] * rs * ga[2], v[3] * rs * ga[3]);
                    o.z = pk2(v[4] * rs * gb[0], v[5] * rs * gb[1]); o.w = pk2(v[6] * rs * gb[2], v[7] * rs * gb[3]);
                    if (st1 < NST) *(v4u*)(mixed + ((size_t)b * SEQ + t) * DM + 512 + c) = o;
                } }
        }
    }
}

__device__ __forceinline__ void phase4(const Args& a, LAS unsigned char* lds) {
    int tid_ = threadIdx.x; asm volatile("" : "+v"(tid_)); const int tid = tid_, lane = tid & 63, wave = tid >> 6;
    unsigned char* ws = a.ws;
    const float* hid = (const float*)(ws + WS_HID);
    const int G = gridDim.x, half = G >> 1;
    const int kv = (int)blockIdx.x >= half ? 1 : 0;
    const int bl = (int)blockIdx.x - kv * half, nb = kv ? (G - half) : half;
    LAS float* W2 = (LAS float*)lds;
    LAS float* scr = (LAS float*)(lds + 65536 + wave * 4096);
    { const float* w2 = a.in[14 + 2 * kv];
#pragma unroll
      for (int q = 0; q < 8; ++q) { const int idx = q * 512 + tid; *(LAS f32x4*)(W2 + idx * 4) = *(const f32x4*)(w2 + idx * 4); } }
    __syncthreads();
    for (int it = bl * NWAVES + wave; it < 1024; it += nb * NWAVES) {
        const int r4 = it * 4;
#pragma unroll
        for (int j = 0; j < 4; ++j)
#pragma unroll
            for (int q = 0; q < 4; ++q) scr[(q * 64 + lane) * 4 + j] = hid[((size_t)kv * 4096 + r4 + j) * 256 + q * 64 + lane];
        LDS_WAIT(); asm volatile("" ::: "memory");
        f32x4 acc = {0.f, 0.f, 0.f, 0.f};
#pragma unroll 16
        for (int k = 0; k < 256; ++k) { const float w = W2[k * 64 + lane]; const f32x4 h = *(const LAS f32x4*)(scr + k * 4); acc += h * w; }
        LDS_WAIT(); asm volatile("" ::: "memory");
#pragma unroll
        for (int j = 0; j < 4; ++j) {
            const int row = r4 + j, pair = row >> 8, n = row & 255;
            if (kv == 0) {
                const float ss = wave_sum(acc[j] * acc[j]);
                const float y = acc[j] * rsqrtf(ss * (1.0f / 64.0f) + EPS) * a.in[8][lane];
                ((bf16*)(ws + WS_KCN))[((size_t)pair * 256 + n) * 64 + lane] = (n < 255) ? (bf16)f2bf(y) : (bf16)0;
            } else {
                ((bf16*)(ws + WS_VCT))[((size_t)pair * 64 + lane) * 256 + n] = (n < 255) ? (bf16)f2bf(acc[j]) : (bf16)0;
            }
        }
    }
}

#ifndef PROBE_CMP
#define PROBE_CMP 0
#endif
#ifndef PROBE_TOPK
#define PROBE_TOPK 0
#endif
#ifndef PROBE_SEL
#define PROBE_SEL 0
#endif
#ifndef PROBE_WIN
#define PROBE_WIN 0
#endif
#define MFMA32(a, b, c) __builtin_amdgcn_mfma_f32_32x32x16_bf16((a), (b), (c), 0, 0, 0)
constexpr int AT_CK = 0, AT_CV = 36864, AT_PS = 70656, AT_SLOT = 0, AT_OF = 73728, AT_WU = 139264, AT_KEYS = 139392, PS_PITCH = 260;
constexpr int QCTR_WORD = 3584;
constexpr int AT_KB0 = 0, AT_KB1 = 9216, AT_VB0 = 18432, AT_VB1 = 27648;
constexpr float NEG_BIG = -1.0e30f;

__device__ __forceinline__ float quad_sum(float t) {
    t += __builtin_bit_cast(float, __builtin_amdgcn_mov_dpp(__builtin_bit_cast(int, t), 0xB1, 0xf, 0xf, true));
    t += __builtin_bit_cast(float, __builtin_amdgcn_mov_dpp(__builtin_bit_cast(int, t), 0x4E, 0xf, 0xf, true));
    return t;
}
__device__ __forceinline__ s16x4 vtr(const LAS unsigned char* p) { return __builtin_amdgcn_ds_read_tr16_b64_v4i16((LAS s16x4*)p); }
template <int MODE, bool DIAG, bool VTR = false>
__device__ __forceinline__ void attn_tile(const LAS unsigned char* Kt, const LAS unsigned char* Vt, int vpitch, int vkoff, const bf16x8 (&qf)[4], int r, int h2,
                                          float cs, float A, int lo, int hi, float& m, float& l, f32x16 (&o)[2], float inv_l, LAS float* psrow) {
    float rowsum = 0.f;
#pragma unroll
    for (int sub = 0; sub < 2; ++sub) {
        f32x16 s;
#pragma unroll
        for (int i = 0; i < 16; ++i) s[i] = __builtin_fmaf(cs, (float)(32 * sub + (i & 3) + 8 * (i >> 2)), A);
#pragma unroll
        for (int ks = 0; ks < 4; ++ks) { const bf16x8 kf = *(const LAS bf16x8*)(Kt + (32 * sub + r) * 144 + (16 * ks + 8 * h2) * 2); s = MFMA32(kf, qf[ks], s); }
        if (DIAG) {
#pragma unroll
            for (int i = 0; i < 16; ++i) { const int ci = 32 * sub + (i & 3) + 8 * (i >> 2); s[i] = (ci >= lo && ci <= hi) ? s[i] : -INFINITY; }
        }
        if (MODE == 0) {
            float mx = s[0];
#pragma unroll
            for (int i = 1; i < 16; ++i) mx = fmaxf(mx, s[i]);
            mx = fmaxf(mx, __shfl_xor(mx, 32));
            const float mn = fmaxf(m, mx); l *= __builtin_amdgcn_exp2f(m - mn); m = mn;
            float rs = 0.f;
#pragma unroll
            for (int i = 0; i < 16; ++i) rs += __builtin_amdgcn_exp2f(s[i] - mn);
            l += rs;
            continue;
        }
#pragma unroll
        for (int i = 0; i < 16; ++i) {
            float p;
            if (MODE == 1) p = __builtin_amdgcn_exp2f(s[i] - m) * inv_l; else p = __builtin_amdgcn_exp2f(s[i]);
            rowsum += p; s[i] = p;
        }
        if (MODE == 1) {
#pragma unroll
            for (int i = 0; i < 16; ++i) { const float t = quad_sum(s[i]);
                if ((r & 3) == 0) psrow[32 * sub + (i & 3) + 8 * (i >> 2) + 4 * h2] = t; }
        }
#pragma unroll
        for (int st = 0; st < 2; ++st) {
            v4u pw; pw.x = pk2(s[8 * st + 0], s[8 * st + 1]); pw.y = pk2(s[8 * st + 2], s[8 * st + 3]);
            pw.z = pk2(s[8 * st + 4], s[8 * st + 5]); pw.w = pk2(s[8 * st + 6], s[8 * st + 7]);
            const bf16x8 pf = __builtin_bit_cast(bf16x8, pw);
#pragma unroll
            for (int dt = 0; dt < 2; ++dt) {
                s16x4 lo4, hi4;
                if (VTR) {
                    const LAS unsigned char* vp = Vt + (32 * sub + 16 * st + 4 * h2 + ((r & 15) >> 2)) * vpitch + (32 * dt + 16 * (r >> 4)) * 2 + 8 * (r & 3);
                    lo4 = vtr(vp); hi4 = vtr(vp + 8 * vpitch);
                } else {
                    const LAS unsigned char* vp = Vt + (32 * dt + r) * vpitch + vkoff + (32 * sub + 16 * st + 4 * h2) * 2;
                    lo4 = *(const LAS s16x4*)(vp); hi4 = *(const LAS s16x4*)(vp + 16);
                }
                const bf16x8 vf = __builtin_shufflevector(lo4, hi4, 0, 1, 2, 3, 4, 5, 6, 7);
                o[dt] = MFMA32(vf, pf, o[dt]);
            }
        }
    }
    if (MODE >= 2) l += rowsum;
}

template <int MODE>
__device__ __forceinline__ void attn_blocks(LAS unsigned char* lds, unsigned long long blocks, unsigned long long wmask, int iq, const bf16* Kg, const bf16* Vtg, const bf16x8 (&qf)[4], int r, int h2,
                                            float slope2, float smax2, int tpos, unsigned long long mymask, float& l, f32x16 (&o)[2]) {
    int tid_ = threadIdx.x; asm volatile("" : "+v"(tid_)); const int tid = tid_;
    const int lrow = tid >> 3, lch = tid & 7;
    const int loff = lrow * 144 + lch * 16;
    const unsigned char* kgp = (const unsigned char*)Kg + tid * 16;
    const unsigned char* vgp = (const unsigned char*)Vtg + tid * 16;
    float mdummy = 0.f;
    unsigned long long rem = blocks;
    int j0 = __builtin_ctzll(rem); rem &= rem - 1;
    int j1 = rem ? __builtin_ctzll(rem) : -1; if (rem) rem &= rem - 1;
    v4u k0, v0, k1 = {0u, 0u, 0u, 0u}, v1 = {0u, 0u, 0u, 0u};
    k0 = *(const v4u*)(kgp + (size_t)j0 * 8192); v0 = *(const v4u*)(vgp + (size_t)j0 * 8192);
    if (j1 >= 0) { k1 = *(const v4u*)(kgp + (size_t)j1 * 8192); v1 = *(const v4u*)(vgp + (size_t)j1 * 8192); }
    *(LAS v4u*)(lds + AT_SLOT + loff) = k0; *(LAS v4u*)(lds + AT_SLOT + 9216 + loff) = v0;
    *(LAS v4u*)(lds + AT_SLOT + 18432 + loff) = k1; *(LAS v4u*)(lds + AT_SLOT + 27648 + loff) = v1;
    __syncthreads();
    int cur = 0;
    for (;;) {
        const int n0 = rem ? __builtin_ctzll(rem) : -1; if (rem) rem &= rem - 1;
        const int n1 = rem ? __builtin_ctzll(rem) : -1; if (rem) rem &= rem - 1;
        if (n0 >= 0) { k0 = *(const v4u*)(kgp + (size_t)n0 * 8192); v0 = *(const v4u*)(vgp + (size_t)n0 * 8192); }
        if (n1 >= 0) { k1 = *(const v4u*)(kgp + (size_t)n1 * 8192); v1 = *(const v4u*)(vgp + (size_t)n1 * 8192); }
        const LAS unsigned char* sb = lds + AT_SLOT + cur * 36864;
#pragma unroll
        for (int u = 0; u < 2; ++u) {
            const int j = u ? j1 : j0;
            if (j >= 0 && ((wmask >> j) & 1ull)) {
                int rr = r, hh = h2; asm volatile("" : "+v"(rr), "+v"(hh));
                const bool on = (mymask >> j) & 1ull;
                const int rel = tpos - 64 * j - 4 * h2;
                float A = -slope2 * (float)rel - smax2;
                if (MODE == 2 && !on) A = -INFINITY;
                const LAS unsigned char* kb = sb + u * 18432; const LAS unsigned char* vb = kb + 9216;
                if (j == iq || (MODE == 3 && j == iq - 8)) attn_tile<MODE, true, true>(kb, vb, 144, 0, qf, rr, hh, slope2, A, (MODE == 3) ? rel - 511 : -100000, rel, mdummy, l, o, 0.f, nullptr);
                else attn_tile<MODE, false, true>(kb, vb, 144, 0, qf, rr, hh, slope2, A, 0, 0, mdummy, l, o, 0.f, nullptr);
            }
        }
        if (n0 >= 0) {
            LAS unsigned char* nb = lds + AT_SLOT + (cur ^ 1) * 36864;
            *(LAS v4u*)(nb + loff) = k0; *(LAS v4u*)(nb + 9216 + loff) = v0;
            if (n1 >= 0) { *(LAS v4u*)(nb + 18432 + loff) = k1; *(LAS v4u*)(nb + 27648 + loff) = v1; }
        }
        __syncthreads();
        if (n0 < 0) break;
        j0 = n0; j1 = n1; cur ^= 1;
    }
}

__device__ __forceinline__ float max_abs64(const float* g) { float m = 0.f; for (int i = 0; i < 64; ++i) m = fmaxf(m, fabsf(g[i])); return m; }

__device__ __forceinline__ void phase5(const Args& a, LAS unsigned char* lds) {
    int tid_ = threadIdx.x; asm volatile("" : "+v"(tid_)); const int tid = tid_, lane = tid & 63, wave = tid >> 6, G = gridDim.x, c = blockIdx.x;
    unsigned char* ws = a.ws;
    const bf16* QN = (const bf16*)(ws + WS_QN);
    const float* gates = (const float*)(ws + WS_GATES);
    bf16* mixed = (bf16*)(ws + WS_MIXED);
    LAS float* PS = (LAS float*)(lds + AT_PS);
    LAS unsigned long long* WU = (LAS unsigned long long*)(lds + AT_WU);
    const float qb = max_abs64(a.in[7]) * (64.0f * 0.125f * LOG2E * 1.02f);
    const float smax_s = qb * max_abs64(a.in[9]), smax_w = qb * max_abs64(a.in[10]);
    for (int rd = 0;; ++rd) {
        const int rank = rd * G + ((rd & 1) ? (G - 1 - c) : c);
        if (rd * G >= 1024) break;
        if (rank >= 1024) continue;
        int ln_ = lane; asm volatile("" : "+v"(ln_));
        const int r = ln_ & 31, h2 = ln_ >> 5, hq = r & 3, tl = r >> 2;
        const int i = 63 - (rank >> 4), bg = rank & 15, b = bg >> 1, g = bg & 1;
        const int T0 = 64 * i, tpos = T0 + 8 * wave + tl;
        const int head = 4 * g + hq;
        const float slope2 = exp2f(-(float)(head + 1)) * LOG2E;
        const size_t mrow = (size_t)b * SEQ + tpos;
        {
            const unsigned char* kc = (const unsigned char*)((const bf16*)(ws + WS_KCN) + (size_t)bg * 256 * 64);
            const unsigned char* vc = (const unsigned char*)((const bf16*)(ws + WS_VCT) + (size_t)bg * 64 * 256);
#pragma unroll
            for (int q = 0; q < 4; ++q) { const int idx = q * 512 + tid;
                const v4u kv_ = *(const v4u*)(kc + (size_t)idx * 16); *(LAS v4u*)(lds + AT_CK + (idx >> 3) * 144 + (idx & 7) * 16) = kv_;
                const v4u vv_ = *(const v4u*)(vc + (size_t)idx * 16); *(LAS v4u*)(lds + AT_CV + (idx >> 5) * 528 + (idx & 31) * 16) = vv_; }
        }
        bf16x8 qf[4];
        { const bf16* qp = QN + ((size_t)(b * 8 + head) * SEQ + tpos) * 64 + 8 * h2;
#pragma unroll
          for (int ks = 0; ks < 4; ++ks) qf[ks] = *(const bf16x8*)(qp + 16 * ks); }
        __syncthreads();
        f32x16 ofin[2];
        const int KT = ((4 * i + 2) >> 6) + 1;
        float g_c, g_s, g_w;
        { const float* gp = gates + mrow * 24 + head * 3; g_c = gp[0]; g_s = gp[1]; g_w = gp[2]; }
#if PROBE_CMP
        for (int rep = 0; rep < 2; ++rep)
#endif
        {
            float m = NEG_BIG, l = 0.f; f32x16 o[2];
#pragma unroll
            for (int dt = 0; dt < 2; ++dt)
#pragma unroll
                for (int e = 0; e < 16; ++e) o[dt][e] = 0.f;
            const float cs = 16.0f * slope2;
            for (int kt = 0; kt < KT; ++kt) {
                const int rel = tpos - 31 - 1024 * kt;
                attn_tile<0, true>(lds + AT_CK + kt * 64 * 144, lds + AT_CV, 528, kt * 128, qf, r, h2, cs, -slope2 * (float)(rel - 64 * h2), -100000, (rel >> 4) - 4 * h2, m, l, o, 0.f, nullptr);
            }
            const float lt = l + __shfl_xor(l, 32);
            const float inv_l = lt > 0.f ? 1.0f / lt : 0.f;
            LAS float* psrow = PS + (8 * wave + tl) * PS_PITCH;
            for (int kt = 0; kt < KT; ++kt) {
                const int rel = tpos - 31 - 1024 * kt;
                attn_tile<1, true>(lds + AT_CK + kt * 64 * 144, lds + AT_CV, 528, kt * 128, qf, r, h2, cs, -slope2 * (float)(rel - 64 * h2), -100000, (rel >> 4) - 4 * h2, m, l, o, inv_l, psrow + 64 * kt);
            }
#pragma unroll
            for (int dt = 0; dt < 2; ++dt)
#pragma unroll
                for (int e = 0; e < 16; ++e) ofin[dt][e] = g_c * o[dt][e];
        }
        LDS_WAIT(); asm volatile("" ::: "memory");
        unsigned long long mymask = 0ull, wunion = 0ull;
#if PROBE_TOPK
        for (int rep = 0; rep < 2; ++rep)
#endif
        {
            const int nmax = (4 * i + 3) < 254 ? (4 * i + 3) : 254;
            const unsigned long long validbits = (i >= 63) ? ~0ull : ((1ull << (i + 1)) - 1ull);
            const bool forced = (lane == 0) || (lane == i) || (lane == i - 1);
            LAS unsigned* KEYS = (LAS unsigned*)(lds + AT_KEYS) + wave * 64;
#pragma unroll 1
            for (int t8 = 0; t8 < 8; ++t8) {
                const LAS float* ps = PS + (8 * wave + t8) * PS_PITCH;
                float imp = 0.f;
#pragma unroll
                for (int dn = -1; dn <= 3; ++dn) { const int n = 4 * lane + dn; if (n >= 0 && n <= nmax) imp += ps[n]; }
                unsigned key = (lane <= i) ? (((__builtin_bit_cast(unsigned, imp) & ~63u) + 64u) | (unsigned)(63 - lane)) : (unsigned)(63 - lane);
                key = forced ? (0xFFFFFFC0u | (unsigned)(63 - lane)) : key;
                KEYS[lane] = key;
                LDS_WAIT(); asm volatile("" ::: "memory");
                int cnt = 0;
#pragma unroll
                for (int k4 = 0; k4 < 16; ++k4) { const v4u kk = *(const LAS v4u*)(KEYS + 4 * k4);
                    cnt += (kk.x > key) ? 1 : 0; cnt += (kk.y > key) ? 1 : 0; cnt += (kk.z > key) ? 1 : 0; cnt += (kk.w > key) ? 1 : 0; }
                LDS_WAIT(); asm volatile("" ::: "memory");
                const unsigned long long msk = __ballot(cnt < 16) & validbits;
                wunion |= msk;
                if (tl == t8) mymask = msk;
            }
            if (lane == 0) WU[wave] = wunion;
        }
        __syncthreads();
        unsigned long long uni = 0ull;
#pragma unroll
        for (int w = 0; w < 8; ++w) uni |= WU[w];
        {
            const unsigned lo = __builtin_amdgcn_readfirstlane((unsigned)uni), hi = __builtin_amdgcn_readfirstlane((unsigned)(uni >> 32));
            uni = ((unsigned long long)hi << 32) | lo;
        }
        LAS float* OF = (LAS float*)(lds + AT_OF) + tid;
#pragma unroll
        for (int dt = 0; dt < 2; ++dt)
#pragma unroll
            for (int e = 0; e < 16; ++e) OF[(dt * 16 + e) * 512] = ofin[dt][e];
        {
            float l = 0.f; f32x16 o[2];
#pragma unroll
            for (int dt = 0; dt < 2; ++dt)
#pragma unroll
                for (int e = 0; e < 16; ++e) o[dt][e] = 0.f;
            attn_blocks<2>(lds, uni, wunion, i, (const bf16*)(ws + WS_KSN) + (size_t)bg * SEQ * 64, (const bf16*)(ws + WS_PROJ) + ((size_t)(b * NSEG + 14 + g) * SEQ) * 64, qf, r, h2, slope2, smax_s, tpos, mymask, l, o);
            const float lt = l + __shfl_xor(l, 32);
            const float sc = lt > 0.f ? g_s / lt : 0.f;
#pragma unroll
            for (int dt = 0; dt < 2; ++dt)
#pragma unroll
                for (int e = 0; e < 16; ++e) OF[(dt * 16 + e) * 512] += sc * o[dt][e];
        }
        {
            float l = 0.f; f32x16 o[2];
#pragma unroll
            for (int dt = 0; dt < 2; ++dt)
#pragma unroll
                for (int e = 0; e < 16; ++e) o[dt][e] = 0.f;
            const int jlo = i - 8 < 0 ? 0 : i - 8;
            const unsigned long long upto = (i >= 63) ? ~0ull : ((1ull << (i + 1)) - 1ull);
            const unsigned long long wb = upto & ~((1ull << jlo) - 1ull);
            attn_blocks<3>(lds, wb, ~0ull, i, (const bf16*)(ws + WS_KWN) + (size_t)bg * SEQ * 64, (const bf16*)(ws + WS_PROJ) + ((size_t)(b * NSEG + 18 + g) * SEQ) * 64, qf, r, h2, slope2, smax_w, tpos, ~0ull, l, o);
            const float lt = l + __shfl_xor(l, 32);
            const float sc = lt > 0.f ? g_w / lt : 0.f;
#pragma unroll
            for (int dt = 0; dt < 2; ++dt)
#pragma unroll
                for (int e = 0; e < 16; ++e) ofin[dt][e] = OF[(dt * 16 + e) * 512] + sc * o[dt][e];
        }
        {
            float ss = 0.f;
#pragma unroll
            for (int dt = 0; dt < 2; ++dt)
#pragma unroll
                for (int e = 0; e < 16; ++e) ss += ofin[dt][e] * ofin[dt][e];
            ss += __shfl_xor(ss, 32);
            const float rs = rsqrtf(ss * (1.0f / 64.0f) + EPS);
            const float* og = a.in[18] + head * 64;
            LAS unsigned char* ob = lds + AT_CK + (wave * 32 + r) * 144;
#pragma unroll
            for (int dt = 0; dt < 2; ++dt)
#pragma unroll
                for (int i4 = 0; i4 < 4; ++i4) { const int d0 = 32 * dt + 8 * i4 + 4 * h2; const f32x4 gv = *(const f32x4*)(og + d0);
                    v2u w; w.x = pk2(ofin[dt][4 * i4 + 0] * rs * gv[0], ofin[dt][4 * i4 + 1] * rs * gv[1]); w.y = pk2(ofin[dt][4 * i4 + 2] * rs * gv[2], ofin[dt][4 * i4 + 3] * rs * gv[3]);
                    *(LAS v2u*)(ob + d0 * 2) = w; }
            __syncthreads();
#pragma unroll
            for (int q = 0; q < 4; ++q) { const int idx = q * 512 + tid, row = idx >> 3, chunk = idx & 7;
                const v4u v = *(const LAS v4u*)(lds + AT_CK + row * 144 + chunk * 16);
                *(v4u*)(mixed + ((size_t)b * SEQ + T0 + (row >> 2)) * DM + (4 * g + (row & 3)) * 64 + chunk * 8) = v; }
            __syncthreads();
        }
    }
}

__device__ __forceinline__ void phase8b(const Args& a) {
    unsigned char* ws = a.ws;
    const float* gtail = (const float*)(ws + WS_GTAIL); const float* ghead = (const float*)(ws + WS_GHEAD); const float* uhead = (const float*)(ws + WS_UHEAD);
    const float* cw = a.in[24]; bf16* H = (bf16*)(ws + WS_H);
    for (int e = blockIdx.x * NTHREADS + threadIdx.x; e < 128 * DFF; e += gridDim.x * NTHREADS) {
        const int pm = e / DFF, ch = e % DFF;
        float t0 = 0.f, t1 = 0.f;
        if (pm & 15) { t0 = gtail[((size_t)(pm - 1) * 2 + 0) * DFF + ch]; t1 = gtail[((size_t)(pm - 1) * 2 + 1) * DFF + ch]; }
        const float g0 = ghead[((size_t)pm * 2 + 0) * DFF + ch], g1 = ghead[((size_t)pm * 2 + 1) * DFF + ch];
        const float u0 = uhead[((size_t)pm * 2 + 0) * DFF + ch], u1 = uhead[((size_t)pm * 2 + 1) * DFF + ch];
        const float w0 = cw[ch], w1 = cw[DFF + ch], w2 = cw[2 * DFF + ch];
        H[((size_t)pm * 256 + 0) * DFF + ch] = (bf16)f2bf(silu_f(w0 * t0 + w1 * t1 + w2 * g0) * u0);
        H[((size_t)pm * 256 + 1) * DFF + ch] = (bf16)f2bf(silu_f(w0 * t1 + w1 * g0 + w2 * g1) * u1);
    }
}

__global__ void __launch_bounds__(NTHREADS) nsa_layer_fwd(Args a) {
    extern __shared__ __attribute__((aligned(16))) unsigned char smem[];
    LAS unsigned char* lds = (LAS unsigned char*)smem;
    cg::grid_group grid = cg::this_grid();
    unsigned char* ws = a.ws;
    const int G = gridDim.x, c = blockIdx.x;
    const float* mod = (const float*)(ws + WS_MOD);

    if (threadIdx.x < 2) ((volatile LAS unsigned*)(lds + XB_LDS_OFF))[threadIdx.x] = 0u;
    __syncthreads();
    const XcdBarrier xbar = xcd_barrier_post((unsigned*)(ws + WS_BAR), (volatile LAS unsigned*)(lds + XB_LDS_OFF));
    if (a.ws == nullptr) grid.sync();
    phase0(a, lds);
    xcd_barrier(xbar);
    norm_rows(a.in[0], a.in[4], mod, 0, 1024, (bf16*)(ws + WS_XN));
    weight_copies(a, lds);
    xcd_barrier(xbar);
    {
        pg8::Gemm g{(const bf16*)(ws + WS_XN), (const bf16*)(ws + WS_BT_IN), MTOK, NINP, 1024, 1024};
        pg8::StaticOrder S; S.init(MTOK, NINP, G, c);
        EpiProj E{(bf16*)(ws + WS_PROJ), (bf16*)(ws + WS_QN), (bf16*)(ws + WS_KSN), (bf16*)(ws + WS_KWN), (float*)(ws + WS_GATES), a.in[7], a.in[9], a.in[10], a.in[6]};
        pg8::gemm_phase<EpiProj, pg8::StaticOrder, true, true>(lds, g, S, E);
    }
    xcd_barrier(xbar);
    if (c < 32) {
        pg8::Gemm g{(const bf16*)(ws + WS_PROJ), (const bf16*)(ws + WS_BT_C1), 4096, 256, 2048, 1024};
        CmpOrder S{c, (const bf16*)(ws + WS_PROJ), (const bf16*)(ws + WS_BT_C1)};
        EpiCmp E{(float*)(ws + WS_HID), (const float*)(ws + WS_BIAS1)};
        pg8::gemm_phase<EpiCmp, CmpOrder, true, true>(lds, g, S, E);
    } else {
        phase3_prep(a, lds, (c - 32) * NWAVES + (int)(threadIdx.x >> 6), (G - 32) * NWAVES);
    }
    xcd_barrier(xbar);
    phase4(a, lds);
    xcd_barrier(xbar);
    phase5(a, lds);
    xcd_barrier(xbar);
    {
        pg8::Gemm g{(const bf16*)(ws + WS_MIXED), (const bf16*)(ws + WS_BT_OUT), MTOK, 1024, 1024, 1024};
        pg8::StaticOrder S; S.init(MTOK, 1024, G, c);
        EpiResB E{a.in[0], (bf16*)(ws + WS_X1B), mod, 2048};
        pg8::gemm_phase<EpiResB, pg8::StaticOrder, true, true>(lds, g, S, E);
    }
    xcd_barrier(xbar);
    norm_rows_b((const bf16*)(ws + WS_X1B), a.in[21], mod, 3072, 4096, (bf16*)(ws + WS_XN));
    xcd_barrier(xbar);
    {
        pg8::Gemm g{(const bf16*)(ws + WS_XN), (const bf16*)(ws + WS_BT_GU), MTOK, NGU, 1024, 1024};
        pg8::StaticOrder S; S.init(MTOK, NGU, G, c);
        EpiFfn E{(bf16*)(ws + WS_H), a.in[24], (float*)(ws + WS_GTAIL), (float*)(ws + WS_GHEAD), (float*)(ws + WS_UHEAD), (LAS float*)(lds + HB_OFF)};
        pg8::gemm_phase<EpiFfn, pg8::StaticOrder, true, true>(lds, g, S, E);
    }
    xcd_barrier(xbar);
    phase8b(a);
    xcd_barrier(xbar);
    {
        pg8::Gemm g{(const bf16*)(ws + WS_H), (const bf16*)(ws + WS_BT_DN), MTOK, 1024, DFF, DFF};
        pg8::StaticOrder S; S.init(MTOK, 1024, G, c);
        EpiResF E{(const bf16*)(ws + WS_X1B), a.out, mod, 5120};
        pg8::gemm_phase<EpiResF, pg8::StaticOrder, true, true>(lds, g, S, E);
    }
}

extern "C" void kernel_launch(void* const* d_in, const int* in_sizes, int n_in, void* d_out, int out_size, void* d_ws, size_t ws_size, hipStream_t stream) {
    static int grid = 0;
    if (grid == 0) {
        if (n_in != 26 || out_size != MTOK * DM || ws_size < WS_END) { fprintf(stderr, "kernel_launch: unexpected problem (n_in %d, out %d, ws %zu)\n", n_in, out_size, ws_size); grid = -1; return; }
        int dev = 0, cus = 0, per_cu = 0;
        (void)hipGetDevice(&dev);
        (void)hipDeviceGetAttribute(&cus, hipDeviceAttributeMultiprocessorCount, dev);
        if (hipFuncSetAttribute((const void*)nsa_layer_fwd, hipFuncAttributeMaxDynamicSharedMemorySize, LDS_BYTES) != hipSuccess) { fprintf(stderr, "kernel_launch: hipFuncSetAttribute failed\n"); grid = -1; return; }
        if (hipOccupancyMaxActiveBlocksPerMultiprocessor(&per_cu, (const void*)nsa_layer_fwd, NTHREADS, LDS_BYTES) != hipSuccess || per_cu < 1) { fprintf(stderr, "kernel_launch: occupancy query says %d\n", per_cu); per_cu = 1; }
        (void)hipGetLastError();
        grid = cus * per_cu;
        if (grid > 1024) grid = 1024;
    }
    if (grid < 0) return;
    if (hipMemsetAsync((char*)d_ws + WS_BAR, 0, BAR_BYTES, stream) != hipSuccess) { fprintf(stderr, "kernel_launch: memset of the barrier words failed\n"); return; }
    Args a{};
    for (int i = 0; i < 26; ++i) a.in[i] = (const float*)d_in[i];
    a.out = (float*)d_out; a.ws = (unsigned char*)d_ws;
    void* args[] = {&a};
    hipError_t e = hipLaunchCooperativeKernel((const void*)nsa_layer_fwd, dim3(grid), dim3(NTHREADS), args, LDS_BYTES, stream);
    if (e != hipSuccess) fprintf(stderr, "cooperative launch failed: %s (grid %d)\n", hipGetErrorString(e), grid);
}
```

```cpp
#include <hip/hip_runtime.h>
#include <hip/hip_cooperative_groups.h>
#include <cstdio>
#include <cstdint>
namespace cg = cooperative_groups;

namespace pg8 {
#define PG8_LAS __attribute__((address_space(3)))
typedef unsigned short bf16_t;
typedef short bf16x8 __attribute__((ext_vector_type(8)));
typedef float f32x4 __attribute__((ext_vector_type(4)));
typedef unsigned u32x4 __attribute__((ext_vector_type(4)));
constexpr int BM = 256, BK = 64, HALF = 128, HTB = HALF * BK * 2, STAGE_BYTES = 8 * HTB, NXCD = 8, WGM = 8;

__host__ __device__ __forceinline__ int lds_byte(int r, int c) { const int st = (r >> 4) * 2 + (c >> 5), rr = r & 15, cc = c & 31, ob = rr * 64 + cc * 2; return st * 1024 + (ob ^ (((ob >> 9) & 1) << 5)); }
__host__ __device__ __forceinline__ void stage_rc(int b, int& R, int& C) { const int st = b / 1024, sb = b % 1024, swz = sb ^ (((sb >> 9) & 1) << 5); R = (st >> 1) * 16 + swz / 64; C = (st & 1) * 32 + (swz % 64) / 2; }
__host__ __device__ __forceinline__ int perm32(int rho) { const int n = rho >> 4, i = rho & 15; return 8 * (i >> 2) + 4 * n + (i & 3); }

struct Unit { int pm, pn; };
struct Gemm { const bf16_t* A; const bf16_t* Bt; int M, N, K, lda; };

struct StaticOrder {
    int nM, nN, nwg, G, c;
    __device__ void init(int M, int N, int G_, int c_) { nM = M / BM; nN = N / BM; nwg = nM * nN; G = G_; c = c_; }
    __device__ bool next(int i, Unit& u) const {
        const long L = (long)i * G + c; if (L >= nwg) return false;
        int wgid = (int)L; { const int q = nwg / NXCD, r = nwg % NXCD, xcd = wgid % NXCD, off = wgid / NXCD; wgid = (xcd < r ? xcd * (q + 1) : r * (q + 1) + (xcd - r) * q) + off; }
        const int nig = WGM * nN, gid = wgid / nig, fm = gid * WGM, gsz = (nM - fm) < WGM ? (nM - fm) : WGM;
        u.pm = fm + ((wgid % nig) % gsz); u.pn = (wgid % nig) / gsz; return true;
    }
    __device__ __forceinline__ const char* a_ptr(const Gemm& g, const Unit& u) const { return (const char*)g.A + (size_t)u.pm * (size_t)(BM * 2) * (size_t)g.lda; }
    __device__ __forceinline__ const char* b_ptr(const Gemm& g, const Unit& u) const { return (const char*)g.Bt + (size_t)u.pn * (size_t)(BM * 2) * (size_t)g.K; }
    __device__ __forceinline__ void a_ready(const Unit&) const {}
    __device__ __forceinline__ void done(const Unit&) const {}
};

template <class Epi, class Sched, bool ALIGN_EPI = false, bool SP2 = false>
__device__ __forceinline__ void gemm_phase(PG8_LAS unsigned char* lds, const Gemm g, const Sched& S, const Epi& E) {
    int tid_ = threadIdx.x; asm volatile("" : "+v"(tid_));
    const int tid = tid_, wid = __builtin_amdgcn_readfirstlane(tid >> 6), lane = tid & 63, wr = wid >> 2, wc = wid & 3, fr = lane & 15, fq = lane >> 4;
    const int K = g.K, nt = K / BK;
    unsigned voffA[2], voffB[2];
#pragma unroll
    for (int i = 0; i < 2; ++i) { int R, C; stage_rc(tid * 16 + i * 8192, R, C); const int Rb = Epi::PERM2 ? (64 * (R >> 5) + perm32(R & 31)) : (Epi::PERM ? ((R & ~31) + perm32(R & 31)) : R);
        voffA[i] = (unsigned)(R * g.lda + C) * 2u; voffB[i] = (unsigned)(Rb * K + C) * 2u; }
    const size_t kstep = (size_t)(BK * 2);
    const size_t hsA = (size_t)HALF * g.lda * 2, hsB = (size_t)(Epi::PERM2 ? 32 : HALF) * K * 2;
    const unsigned ldsw = (unsigned)wid * 1024u;
    const int aoff = lds_byte(wr * 64 + fr, fq * 8), boff = lds_byte(wc * 32 + fr, fq * 8);
#define PG8_SA(b, h) (((b) * 2 + (h)) * HTB)
#define PG8_SB(b, h) ((4 + (b) * 2 + (h)) * HTB)
#define PG8_STAGE(bufoff, gbase, voff) do { _Pragma("unroll") for (int _i = 0; _i < 2; ++_i) \
        __builtin_amdgcn_global_load_lds((const unsigned*)((const char*)(gbase) + (voff)[_i]), (PG8_LAS unsigned*)(lds + (bufoff) + ldsw + _i * 8192), 16, 0, 0); } while (0)
#define PG8_LDA(dst, b, h) do { _Pragma("unroll") for (int m = 0; m < 4; ++m) _Pragma("unroll") for (int k = 0; k < 2; ++k) dst[m][k] = *(const PG8_LAS bf16x8*)(lds + PG8_SA(b, h) + aoff + m * 2048 + k * 1024); } while (0)
#define PG8_LDB(dst, b, h) do { _Pragma("unroll") for (int n = 0; n < 2; ++n) _Pragma("unroll") for (int k = 0; k < 2; ++k) dst[n][k] = *(const PG8_LAS bf16x8*)(lds + PG8_SB(b, h) + boff + n * 2048 + k * 1024); } while (0)
#define PG8_MMA(ai, bj, At, Bt) do { __builtin_amdgcn_s_setprio(1); _Pragma("unroll") for (int m = 0; m < 4; ++m) _Pragma("unroll") for (int n = 0; n < 2; ++n) _Pragma("unroll") for (int k = 0; k < 2; ++k) \
        acc[ai][bj][m][n] = __builtin_amdgcn_mfma_f32_16x16x32_bf16(Bt[n][k], At[m][k], acc[ai][bj][m][n], 0, 0, 0); __builtin_amdgcn_s_setprio(0); } while (0)
#define PG8_WAIT_V(n) asm volatile("s_waitcnt vmcnt(" #n ")" ::: "memory")
#define PG8_WAIT_L(n) asm volatile("s_waitcnt lgkmcnt(" #n ")" ::: "memory")
#define PG8_BAR __builtin_amdgcn_s_barrier()
#define PG8_SCHED __builtin_amdgcn_sched_barrier(0)
    Unit cur, nxt; int ui = 0;
    if (!S.next(0, cur)) return;
    f32x4 acc[2][2][4][2];
#pragma unroll
    for (int a = 0; a < 2; ++a)
#pragma unroll
        for (int b = 0; b < 2; ++b)
#pragma unroll
            for (int m = 0; m < 4; ++m)
#pragma unroll
                for (int n = 0; n < 2; ++n) acc[a][b][m][n] = (f32x4){0.f, 0.f, 0.f, 0.f};
    bf16x8 At[4][2], B0[2][2], B1[2][2];
    const char* cA = S.a_ptr(g, cur); const char* cB = S.b_ptr(g, cur);
    S.a_ready(cur);
    if constexpr (SP2) {
        PG8_STAGE(PG8_SB(0, 0), cB, voffB); PG8_STAGE(PG8_SB(0, 1), cB + hsB, voffB); PG8_STAGE(PG8_SA(0, 0), cA, voffA); PG8_STAGE(PG8_SA(0, 1), cA + hsA, voffA);
        if (wr == 1) PG8_BAR;
        PG8_WAIT_V(2); PG8_BAR;
        PG8_STAGE(PG8_SB(1, 0), cB + kstep, voffB); PG8_STAGE(PG8_SA(1, 0), cA + kstep, voffA); PG8_STAGE(PG8_SB(1, 1), cB + hsB + kstep, voffB);
        PG8_WAIT_V(6); PG8_BAR;
    } else {
        PG8_STAGE(PG8_SB(0, 0), cB, voffB); PG8_STAGE(PG8_SA(0, 0), cA, voffA); PG8_STAGE(PG8_SB(0, 1), cB + hsB, voffB); PG8_STAGE(PG8_SA(0, 1), cA + hsA, voffA);
        if (wr == 1) PG8_BAR;
        PG8_WAIT_V(4); PG8_BAR;
        PG8_STAGE(PG8_SB(1, 0), cB + kstep, voffB); PG8_STAGE(PG8_SA(1, 0), cA + kstep, voffA); PG8_STAGE(PG8_SB(1, 1), cB + hsB + kstep, voffB);
        PG8_WAIT_V(6); PG8_BAR;
    }
    for (;;) {
        const bool has_next = S.next(ui + 1, nxt);
        const char* nA = has_next ? S.a_ptr(g, nxt) : cA; const char* nB = has_next ? S.b_ptr(g, nxt) : cB;
        for (int t = 0; t < nt; t += 2) {
            const bool last = (t == nt - 2);
            const char* a1 = cA + (size_t)(t + 1) * kstep;
            const char* a2 = last ? nA : cA + (size_t)(t + 2) * kstep; const char* b2 = last ? nB : cB + (size_t)(t + 2) * kstep;
            const char* a3 = a2 + kstep; const char* b3 = b2 + kstep;
            if (last && has_next) S.a_ready(nxt);
            if constexpr (SP2) {
            PG8_LDB(B0, 0, 0); PG8_LDB(B1, 0, 1); PG8_SCHED; PG8_LDA(At, 0, 0); PG8_STAGE(PG8_SA(1, 1), a1 + hsA, voffA);
            PG8_WAIT_V(8); PG8_WAIT_L(0); PG8_BAR; PG8_MMA(0, 0, At, B0); PG8_MMA(0, 1, At, B1); PG8_BAR; PG8_SCHED;
            PG8_LDA(At, 0, 1); PG8_STAGE(PG8_SB(0, 0), b2, voffB); PG8_STAGE(PG8_SB(0, 1), b2 + hsB, voffB); PG8_STAGE(PG8_SA(0, 0), a2, voffA);
            PG8_WAIT_V(8); PG8_WAIT_L(0); PG8_BAR; PG8_MMA(1, 0, At, B0); PG8_MMA(1, 1, At, B1); PG8_BAR; PG8_SCHED;
            PG8_LDB(B0, 1, 0); PG8_LDB(B1, 1, 1); PG8_SCHED; PG8_LDA(At, 1, 0); PG8_STAGE(PG8_SA(0, 1), a2 + hsA, voffA);
            PG8_WAIT_V(8); PG8_WAIT_L(0); PG8_BAR; PG8_MMA(0, 0, At, B0); PG8_MMA(0, 1, At, B1); PG8_BAR; PG8_SCHED;
            PG8_LDA(At, 1, 1); PG8_STAGE(PG8_SB(1, 0), b3, voffB); PG8_STAGE(PG8_SB(1, 1), b3 + hsB, voffB); PG8_STAGE(PG8_SA(1, 0), a3, voffA);
            PG8_WAIT_V(8); PG8_WAIT_L(0); PG8_BAR; PG8_MMA(1, 0, At, B0); PG8_MMA(1, 1, At, B1); PG8_BAR; PG8_SCHED;
            } else {
            PG8_LDB(B0, 0, 0); PG8_SCHED; PG8_LDA(At, 0, 0); PG8_STAGE(PG8_SA(1, 1), a1 + hsA, voffA);
            PG8_WAIT_L(8); PG8_BAR; PG8_WAIT_L(0); PG8_MMA(0, 0, At, B0); PG8_BAR; PG8_SCHED;
            PG8_LDB(B1, 0, 1); PG8_STAGE(PG8_SB(0, 0), b2, voffB);
            PG8_BAR; PG8_WAIT_L(0); PG8_MMA(0, 1, At, B1); PG8_BAR;
            PG8_LDA(At, 0, 1); PG8_STAGE(PG8_SA(0, 0), a2, voffA);
            PG8_BAR; PG8_WAIT_L(0); PG8_MMA(1, 0, At, B0); PG8_BAR; PG8_SCHED;
            PG8_STAGE(PG8_SB(0, 1), b2 + hsB, voffB);
            PG8_WAIT_V(6); PG8_BAR; PG8_MMA(1, 1, At, B1); PG8_BAR;
            PG8_LDB(B0, 1, 0); PG8_SCHED; PG8_LDA(At, 1, 0); PG8_STAGE(PG8_SA(0, 1), a2 + hsA, voffA);
            PG8_WAIT_L(8); PG8_BAR; PG8_WAIT_L(0); PG8_MMA(0, 0, At, B0); PG8_BAR; PG8_SCHED;
            PG8_LDB(B1, 1, 1); PG8_STAGE(PG8_SB(1, 0), b3, voffB);
            PG8_BAR; PG8_WAIT_L(0); PG8_MMA(0, 1, At, B1); PG8_BAR;
            PG8_LDA(At, 1, 1); PG8_STAGE(PG8_SA(1, 0), a3, voffA);
            PG8_BAR; PG8_WAIT_L(0); PG8_MMA(1, 0, At, B0); PG8_BAR; PG8_SCHED;
            PG8_STAGE(PG8_SB(1, 1), b3 + hsB, voffB);
            PG8_WAIT_V(6); PG8_BAR; PG8_MMA(1, 1, At, B1); PG8_BAR;
            }
        }
        if constexpr (ALIGN_EPI) { if (wr == 0) PG8_BAR; }
        if constexpr (!Epi::AFTER_DRAIN) { E(acc, cur, wr, wc, fr, fq); S.done(cur); }
        if (!has_next) break;
#pragma unroll
        for (int a = 0; a < 2; ++a)
#pragma unroll
            for (int b = 0; b < 2; ++b)
#pragma unroll
                for (int m = 0; m < 4; ++m)
#pragma unroll
                    for (int n = 0; n < 2; ++n) acc[a][b][m][n] = (f32x4){0.f, 0.f, 0.f, 0.f};
        cur = nxt; cA = nA; cB = nB; ++ui;
        if constexpr (ALIGN_EPI) { if (wr == 1) PG8_BAR; }
    }
    PG8_WAIT_V(0);
    if constexpr (!ALIGN_EPI) { if (wr == 0) PG8_BAR; }
    PG8_BAR;
    if constexpr (Epi::AFTER_DRAIN) { E.fused(acc, cur, wr, wc, fr, fq, lds, wid, lane); S.done(cur); }
#undef PG8_SA
#undef PG8_SB
#undef PG8_STAGE
#undef PG8_LDA
#undef PG8_LDB
#undef PG8_MMA
#undef PG8_WAIT_V
#undef PG8_WAIT_L
#undef PG8_BAR
#undef PG8_SCHED
}
}


#define LAS __attribute__((address_space(3)))
typedef unsigned short bf16;
typedef unsigned v4u __attribute__((ext_vector_type(4)));
typedef unsigned v2u __attribute__((ext_vector_type(2)));
typedef float f32x4 __attribute__((ext_vector_type(4)));
typedef float f32x2 __attribute__((ext_vector_type(2)));
typedef float f32x16 __attribute__((ext_vector_type(16)));
typedef short bf16x8 __attribute__((ext_vector_type(8)));
typedef short s16x4 __attribute__((ext_vector_type(4)));
typedef __bf16 bf16x2_t __attribute__((ext_vector_type(2)));

constexpr int NB = 8, SEQ = 4096, DM = 1024, MTOK = NB * SEQ;
constexpr int NIN = 2840, NINP = 3072, NSEG = NINP / 64, DFF = 2816, NGU = 2 * DFF;
constexpr float EPS = 1e-6f;
constexpr float LOG2E = 1.4426950408889634f;
constexpr int NTHREADS = 512, NWAVES = 8;
constexpr int LDS_BYTES = 147456 + 256;
constexpr int XB_LDS_OFF = 147456;
constexpr int HB_OFF = 131072;

constexpr size_t MiB = 1u << 20;
constexpr size_t WS_MOD = 0, WS_BIAS1 = 256 * 1024, WS_BAR = 512 * 1024, BAR_BYTES = 16384;
constexpr size_t WS_BT_IN = 1 * MiB, WS_BT_OUT = 7 * MiB, WS_BT_GU = 9 * MiB, WS_BT_DN = 20 * MiB, WS_BT_C1 = 26 * MiB;
constexpr size_t WS_HID = 28 * MiB, WS_KCN = 36 * MiB, WS_VCT = 36 * MiB + 512 * 1024, WS_GATES = 37 * MiB;
constexpr size_t WS_GTAIL = 40 * MiB, WS_GHEAD = 43 * MiB, WS_UHEAD = 46 * MiB;
constexpr size_t WS_KSN = 50 * MiB, WS_KWN = 58 * MiB, WS_VST = 66 * MiB, WS_VWT = 74 * MiB, WS_QN = 82 * MiB;
constexpr size_t WS_X1B = 50 * MiB;
constexpr size_t WS_XN = 114 * MiB, WS_MIXED = 178 * MiB, WS_PROJ = 242 * MiB, WS_H = WS_PROJ, WS_END = 434 * MiB;

struct Args { const float* in[26]; float* out; unsigned char* ws; };

#define LDS_WAIT() asm volatile("s_waitcnt lgkmcnt(0)" ::: "memory")
__device__ __forceinline__ unsigned f2bf(float f) { unsigned u = __builtin_bit_cast(unsigned, f); return (u + 0x7fffu + ((u >> 16) & 1u)) >> 16; }
__device__ __forceinline__ unsigned pk2(float lo, float hi) { f32x2 v = {lo, hi}; bf16x2_t b = __builtin_convertvector(v, bf16x2_t); return __builtin_bit_cast(unsigned, b); }
__device__ __forceinline__ float bf2f(unsigned short h) { return __builtin_bit_cast(float, (unsigned)h << 16); }
__device__ __forceinline__ float bflo(unsigned w) { return __builtin_bit_cast(float, w << 16); }
__device__ __forceinline__ float bfhi(unsigned w) { return __builtin_bit_cast(float, w & 0xffff0000u); }
__device__ __forceinline__ float wave_sum(float v) {
#pragma unroll
    for (int o = 1; o < 64; o <<= 1) v += __shfl_xor(v, o);
    return v;
}
__device__ __forceinline__ float silu_f(float x) { return x * __builtin_amdgcn_rcpf(1.0f + __builtin_amdgcn_exp2f(-LOG2E * x)); }
__device__ __forceinline__ float gelu_tanh_f(float x) { const float y = 0.7978845608028654f * (x + 0.044715f * x * x * x); const float t = 1.0f - 2.0f * __builtin_amdgcn_rcpf(__builtin_amdgcn_exp2f(2.0f * LOG2E * y) + 1.0f); return 0.5f * x * (1.0f + t); }

#define XB_TMO      128
#define XB_XCNT(j)  (256  + 64 * (j))
#define XB_XSUB(j)  (1280 + 64 * (j))
#define XB_XGEN(j)  (2304 + 64 * (j))
#define XB_TOP      3328
#define XB_TOPGEN   3392
#define XCD_BAR_WORDS 3456
#define XB_SPIN_CAP (1u << 18)

__device__ __forceinline__ unsigned xb_ld(unsigned* p)              { return __hip_atomic_load(p, __ATOMIC_RELAXED, __HIP_MEMORY_SCOPE_AGENT); }
__device__ __forceinline__ unsigned xb_add(unsigned* p, unsigned v) { return __hip_atomic_fetch_add(p, v, __ATOMIC_RELAXED, __HIP_MEMORY_SCOPE_AGENT); }
__device__ __forceinline__ unsigned xb_xcc_id() { return (unsigned)__builtin_amdgcn_s_getreg((3 << 11) | 20) & 0xFu; }
#define XB_SPIN(cond, bar) do { unsigned _sp = 0; while (cond) { __builtin_amdgcn_s_sleep(1); \
    if ((++_sp & 255u) == 0u) { if (xb_ld(&(bar)[XB_TMO])) break; if (_sp > XB_SPIN_CAP) { atomicAdd(&(bar)[XB_TMO], 1u); break; } } } } while (0)

struct XcdBarrier {
    unsigned* bar; unsigned x;
    volatile LAS unsigned* st;
};

__device__ __forceinline__ XcdBarrier xcd_barrier_post(unsigned* bar, volatile LAS unsigned* st) {
    XcdBarrier b; b.bar = bar; b.x = xb_xcc_id(); b.st = st;
    if (threadIdx.x == 0) (void)xb_add(&bar[XB_XCNT(b.x)], 1u);
    return b;
}
__device__ __forceinline__ void xcd_barrier_complete(unsigned* bar, unsigned x, unsigned& nloc, unsigned& nx) {
    const unsigned G = gridDim.x * gridDim.y * gridDim.z;
    unsigned sum, cnt, mine, sp = 0u;
    for (;;) {
        sum = 0u; cnt = 0u; mine = 0u;
#pragma unroll
        for (unsigned j = 0; j < 16; ++j) { const unsigned c = xb_ld(&bar[XB_XCNT(j)]); sum += c; cnt += (c > 0u) ? 1u : 0u; mine = (j == x) ? c : mine; }
        if (sum == G) break;
        __builtin_amdgcn_s_sleep(1);
        if ((++sp & 255u) == 0u) { if (xb_ld(&bar[XB_TMO])) break; if (sp > XB_SPIN_CAP) { atomicAdd(&bar[XB_TMO], 1u); break; } }
    }
    nloc = mine > 0u ? mine : 1u; nx = cnt > 0u ? cnt : 1u;
}

__device__ __forceinline__ void xcd_barrier(const XcdBarrier& b) {
    asm volatile("s_waitcnt vmcnt(0)" ::: "memory");
    __syncthreads();
    if (threadIdx.x == 0) {
        unsigned* bar = b.bar;
        __builtin_amdgcn_s_waitcnt(0);
        unsigned nloc = b.st[0], nx = b.st[1];
        if (nloc == 0u) { xcd_barrier_complete(bar, b.x, nloc, nx); b.st[0] = nloc; b.st[1] = nx; }
        const unsigned old = xb_add(&bar[XB_XSUB(b.x)], 1u);
        const unsigned gen = old / nloc;
        if (old + 1u == (gen + 1u) * nloc) {
            __builtin_amdgcn_fence(__ATOMIC_RELEASE, "agent");
            asm volatile("s_waitcnt vmcnt(0)" ::: "memory");
            const unsigned og = xb_add(&bar[XB_TOP], 1u);
            const unsigned tg = og / nx;
            if (og + 1u == (tg + 1u) * nx) xb_add(&bar[XB_TOPGEN], 1u);
            else XB_SPIN(xb_ld(&bar[XB_TOPGEN]) == tg, bar);
            __builtin_amdgcn_fence(__ATOMIC_ACQUIRE, "agent");
            xb_add(&bar[XB_XGEN(b.x)], 1u);
            asm volatile("s_waitcnt vmcnt(0)" ::: "memory");
        } else {
            XB_SPIN(xb_ld(&bar[XB_XGEN(b.x)]) == gen, bar);
            __builtin_amdgcn_fence(__ATOMIC_ACQUIRE, "agent");
            asm volatile("s_waitcnt vmcnt(0)" ::: "memory");
        }
    }
    __syncthreads();
}


__device__ __forceinline__ void transpose_item(const float* __restrict__ W, int K, int N, bf16* WT, int k0, int n0, int drow0, LAS float* scr, int lane) {
    const int nn = n0 + (lane & 31);
#pragma unroll 8
    for (int i = 0; i < 32; ++i) { const int kk = 2 * i + (lane >> 5); scr[kk * 33 + (lane & 31)] = (nn < N) ? W[(size_t)(k0 + kk) * N + nn] : 0.0f; }
    LDS_WAIT(); asm volatile("" ::: "memory");
    const int c = lane & 7;
#pragma unroll
    for (int j = 0; j < 4; ++j) { const int n = (lane >> 3) + 8 * j; const LAS float* s = scr + (8 * c) * 33 + n;
        v4u o; o.x = pk2(s[0 * 33], s[1 * 33]); o.y = pk2(s[2 * 33], s[3 * 33]); o.z = pk2(s[4 * 33], s[5 * 33]); o.w = pk2(s[6 * 33], s[7 * 33]);
        *(v4u*)(WT + (size_t)(drow0 + n) * K + k0 + 8 * c) = o; }
    LDS_WAIT(); asm volatile("" ::: "memory");
}

__device__ __forceinline__ void phase0(const Args& a, LAS unsigned char* lds) {
    int tid_ = threadIdx.x; asm volatile("" : "+v"(tid_)); const int tid = tid_, lane = tid & 63, wave = tid >> 6, G = gridDim.x;
    unsigned char* ws = a.ws;
    LAS float* SC = (LAS float*)lds;
    LAS float* RED = (LAS float*)(lds + 32768);
    float* mod = (float*)(ws + WS_MOD);
    float* bias1 = (float*)(ws + WS_BIAS1);
    for (int it = blockIdx.x; it < 208; it += G) {
        const int cl = tid & 31, sl = tid >> 5;
        if (it < 192) {
            const float* c = a.in[1]; const float* w_ada = a.in[2]; const float* b_ada = a.in[3];
            for (int i = tid; i < 8192; i += NTHREADS) { const float v = c[i]; SC[i] = silu_f(v); }
            __syncthreads();
            float acc[8];
#pragma unroll
            for (int b = 0; b < 8; ++b) acc[b] = 0.f;
            const int col = it * 32 + cl;
#pragma unroll 8
            for (int k = sl * 64; k < sl * 64 + 64; ++k) {
                const float w = w_ada[(size_t)k * 6144 + col];
#pragma unroll
                for (int b = 0; b < 8; ++b) acc[b] += SC[b * 1024 + k] * w;
            }
#pragma unroll
            for (int b = 0; b < 8; ++b) RED[(sl * 8 + b) * 32 + cl] = acc[b];
            __syncthreads();
            if (tid < 256) { const int b = tid >> 5; float s = 0.f;
#pragma unroll
              for (int w = 0; w < 16; ++w) s += RED[(w * 8 + b) * 32 + cl];
              mod[b * 6144 + it * 32 + cl] = s + b_ada[it * 32 + cl]; }
            __syncthreads();
        } else {
            const int q = it - 192, kv = q >> 3, cgp = q & 7;
            const float* pos = a.in[11 + kv]; const float* w1 = a.in[13 + 2 * kv];
            float acc = 0.f;
#pragma unroll 8
            for (int k = sl * 128; k < sl * 128 + 128; ++k) acc += pos[k] * w1[(size_t)k * 256 + cgp * 32 + cl];
            RED[sl * 32 + cl] = acc;
            __syncthreads();
            if (tid < 32) { float s = 0.f;
#pragma unroll
                for (int w = 0; w < 16; ++w) s += RED[w * 32 + tid];
                bias1[kv * 256 + cgp * 32 + tid] = s; }
            __syncthreads();
        }
    }
}

__device__ __forceinline__ void weight_copies(const Args& a, LAS unsigned char* lds) {
    int tid_ = threadIdx.x; asm volatile("" : "+v"(tid_)); const int tid = tid_, lane = tid & 63, wave = tid >> 6, G = gridDim.x;
    unsigned char* ws = a.ws;
    LAS float* scr = (LAS float*)(lds + 49152 + wave * 8448);
    const int gw = blockIdx.x * NWAVES + wave, NGW = G * NWAVES;
    constexpr int I_IN = 16 * 96, I_OUT = 16 * 32, I_G = 16 * 88, I_D = 44 * 32, I_C = 32 * 8;
    constexpr int TOT = I_IN + I_OUT + 2 * I_G + I_D + 2 * I_C;
    for (int it = gw; it < TOT; it += NGW) {
        int r = it;
        if (r < I_IN) { const int kb = r / 96, nb = r % 96; transpose_item(a.in[5], 1024, NIN, (bf16*)(ws + WS_BT_IN), 64 * kb, 32 * nb, 32 * nb, scr, lane); continue; } r -= I_IN;
        if (r < I_OUT) { const int kb = r / 32, nb = r % 32; transpose_item(a.in[20], 1024, 1024, (bf16*)(ws + WS_BT_OUT), 64 * kb, 32 * nb, 32 * nb, scr, lane); continue; } r -= I_OUT;
        if (r < I_G) { const int kb = r / 88, nb = r % 88, n0 = 32 * nb; transpose_item(a.in[22], 1024, DFF, (bf16*)(ws + WS_BT_GU), 64 * kb, n0, 256 * (n0 >> 7) + (n0 & 127), scr, lane); continue; } r -= I_G;
        if (r < I_G) { const int kb = r / 88, nb = r % 88, n0 = 32 * nb; transpose_item(a.in[23], 1024, DFF, (bf16*)(ws + WS_BT_GU), 64 * kb, n0, 256 * (n0 >> 7) + (n0 & 127) + 128, scr, lane); continue; } r -= I_G;
        if (r < I_D) { const int kb = r / 32, nb = r % 32; transpose_item(a.in[25], DFF, 1024, (bf16*)(ws + WS_BT_DN), 64 * kb, 32 * nb, 32 * nb, scr, lane); continue; } r -= I_D;
        if (r < I_C) { const int kb = r / 8, nb = r % 8; transpose_item(a.in[13], 2048, 256, (bf16*)(ws + WS_BT_C1), 64 * kb, 32 * nb, 32 * nb, scr, lane); continue; } r -= I_C;
        { const int kb = r / 8, nb = r % 8; transpose_item(a.in[15], 2048, 256, (bf16*)(ws + WS_BT_C1) + 256 * 2048, 64 * kb, 32 * nb, 32 * nb, scr, lane); }
    }
}

__device__ __forceinline__ void norm_rows(const float* __restrict__ src, const float* __restrict__ gamma, const float* __restrict__ mod, int sh_off, int sc_off, bf16* dst) {
    int tid_ = threadIdx.x; asm volatile("" : "+v"(tid_)); const int tid = tid_, lane = tid & 63, wave = tid >> 6;
    const int gw = blockIdx.x * NWAVES + wave, NGW = gridDim.x * NWAVES;
    const int per = (MTOK + NGW - 1) / NGW;
    const int r0 = gw * per, r1 = (r0 + per) < MTOK ? (r0 + per) : MTOK;
    if (r0 >= r1) return;
    f32x4 ga[4], sh[4];
    int bcur = -1;
    f32x4 va[4], vb[4];
    { const f32x4* xr = (const f32x4*)(src + (size_t)r0 * DM) + lane;
#pragma unroll
      for (int j = 0; j < 4; ++j) va[j] = xr[64 * j]; }
    { const int rr = (r0 + 1 < r1) ? r0 + 1 : r0; const f32x4* xr = (const f32x4*)(src + (size_t)rr * DM) + lane;
#pragma unroll
      for (int j = 0; j < 4; ++j) vb[j] = xr[64 * j]; }
    for (int row = r0; row < r1; ++row) {
        f32x4 v[4];
#pragma unroll
        for (int j = 0; j < 4; ++j) { v[j] = va[j]; va[j] = vb[j]; }
        { const int rr = (row + 2 < r1) ? row + 2 : row; const f32x4* xr = (const f32x4*)(src + (size_t)rr * DM) + lane;
#pragma unroll
          for (int j = 0; j < 4; ++j) vb[j] = xr[64 * j]; }
        const int b = row >> 12;
        if (b != bcur) { bcur = b; const float* mb = mod + b * 6144;
#pragma unroll
            for (int j = 0; j < 4; ++j) { const int col = 4 * lane + 256 * j; const f32x4 gv = *(const f32x4*)(gamma + col), sc = *(const f32x4*)(mb + sc_off + col);
                sh[j] = *(const f32x4*)(mb + sh_off + col); ga[j] = gv * (1.0f + sc); } }
        float ss = 0.f;
#pragma unroll
        for (int j = 0; j < 4; ++j) ss += v[j][0] * v[j][0] + v[j][1] * v[j][1] + v[j][2] * v[j][2] + v[j][3] * v[j][3];
        ss = wave_sum(ss);
        const float rstd = rsqrtf(ss * (1.0f / DM) + EPS);
#pragma unroll
        for (int j = 0; j < 4; ++j) {
            const int col = 4 * lane + 256 * j;
            f32x4 y;
#pragma unroll
            for (int e = 0; e < 4; ++e) y[e] = (v[j][e] * rstd) * ga[j][e] + sh[j][e];
            v2u o; o.x = pk2(y[0], y[1]); o.y = pk2(y[2], y[3]);
            *(v2u*)(dst + (size_t)row * DM + col) = o;
        }
    }
}

__device__ __forceinline__ void norm_rows_b(const bf16* __restrict__ src, const float* __restrict__ gamma, const float* __restrict__ mod, int sh_off, int sc_off, bf16* dst) {
    int tid_ = threadIdx.x; asm volatile("" : "+v"(tid_)); const int tid = tid_, lane = tid & 63, wave = tid >> 6;
    const int gw = blockIdx.x * NWAVES + wave, NGW = gridDim.x * NWAVES;
    const int per = (MTOK + NGW - 1) / NGW;
    const int r0 = gw * per, r1 = (r0 + per) < MTOK ? (r0 + per) : MTOK;
    if (r0 >= r1) return;
    f32x4 ga[4], sh[4];
    int bcur = -1;
    v4u va[2], vb[2];
    { const v4u* xr = (const v4u*)(src + (size_t)r0 * DM) + lane; va[0] = xr[0]; va[1] = xr[64]; }
    { const int rr = (r0 + 1 < r1) ? r0 + 1 : r0; const v4u* xr = (const v4u*)(src + (size_t)rr * DM) + lane; vb[0] = xr[0]; vb[1] = xr[64]; }
    for (int row = r0; row < r1; ++row) {
        v4u raw[2]; raw[0] = va[0]; raw[1] = va[1]; va[0] = vb[0]; va[1] = vb[1];
        { const int rr = (row + 2 < r1) ? row + 2 : row; const v4u* xr = (const v4u*)(src + (size_t)rr * DM) + lane; vb[0] = xr[0]; vb[1] = xr[64]; }
        const int b = row >> 12;
        if (b != bcur) { bcur = b; const float* mb = mod + b * 6144;
#pragma unroll
            for (int j = 0; j < 4; ++j) { const int col = 512 * (j >> 1) + 8 * lane + 4 * (j & 1); const f32x4 gv = *(const f32x4*)(gamma + col), sc = *(const f32x4*)(mb + sc_off + col);
                sh[j] = *(const f32x4*)(mb + sh_off + col); ga[j] = gv * (1.0f + sc); } }
        f32x4 v[4];
#pragma unroll
        for (int h = 0; h < 2; ++h) { v[2 * h] = (f32x4){bflo(raw[h].x), bfhi(raw[h].x), bflo(raw[h].y), bfhi(raw[h].y)}; v[2 * h + 1] = (f32x4){bflo(raw[h].z), bfhi(raw[h].z), bflo(raw[h].w), bfhi(raw[h].w)}; }
        float ss = 0.f;
#pragma unroll
        for (int j = 0; j < 4; ++j) ss += v[j][0] * v[j][0] + v[j][1] * v[j][1] + v[j][2] * v[j][2] + v[j][3] * v[j][3];
        ss = wave_sum(ss);
        const float rstd = rsqrtf(ss * (1.0f / DM) + EPS);
#pragma unroll
        for (int h = 0; h < 2; ++h) {
            f32x4 y0, y1;
#pragma unroll
            for (int e = 0; e < 4; ++e) { y0[e] = (v[2 * h][e] * rstd) * ga[2 * h][e] + sh[2 * h][e]; y1[e] = (v[2 * h + 1][e] * rstd) * ga[2 * h + 1][e] + sh[2 * h + 1][e]; }
            v4u o; o.x = pk2(y0[0], y0[1]); o.y = pk2(y0[2], y0[3]); o.z = pk2(y1[0], y1[1]); o.w = pk2(y1[2], y1[3]);
            *(v4u*)(dst + (size_t)row * DM + 512 * h + 8 * lane) = o;
        }
    }
}

__device__ __forceinline__ float dpp_shr1(float v) { return __builtin_bit_cast(float, __builtin_amdgcn_update_dpp(0, __builtin_bit_cast(int, v), 0x111, 0xf, 0xf, true)); }
__device__ __forceinline__ float dpp_shr2(float v) { return __builtin_bit_cast(float, __builtin_amdgcn_update_dpp(0, __builtin_bit_cast(int, v), 0x112, 0xf, 0xf, true)); }
__device__ __forceinline__ unsigned dpp_ror8(unsigned v) { return (unsigned)__builtin_amdgcn_update_dpp(0, (int)v, 0x128, 0xf, 0xf, false); }
struct EpiProj {
    static constexpr bool PERM = true, PERM2 = true, AFTER_DRAIN = false;
    bf16* P; bf16* QN; bf16* KSN; bf16* KWN; float* gates; const float* gq; const float* gs; const float* gw; const float* bgate;
    __device__ __forceinline__ void operator()(const f32x4 (&acc)[2][2][4][2], const pg8::Unit& u, int wr, int wc, int fr, int fq) const {
        const bool lo = fr < 8;
        const int colb = u.pn * 256 + wc * 64, seg = colb >> 6, d = (lo ? 0 : 32) + 8 * fq;
        const bool keep = (colb + d) < NIN;
        const int rowb = u.pm * 256 + wr * 64 + (fr & 7);
        bf16* base = P; int ns = NSEG, sidx = seg; const float* gm = nullptr; float mult = 1.0f;
        if (seg < 8) { base = QN; ns = 8; gm = gq; mult = 0.125f * LOG2E; }
        else if (seg == 12 || seg == 13) { base = KSN; ns = 2; sidx = seg - 12; gm = gs; }
        else if (seg == 16 || seg == 17) { base = KWN; ns = 2; sidx = seg - 16; gm = gw; }
        f32x4 g00 = {1.f, 1.f, 1.f, 1.f}, g01 = g00, g10 = g00, g11 = g00;
        if (gm) { g00 = *(const f32x4*)(gm + 8 * fq); g01 = *(const f32x4*)(gm + 8 * fq + 4); g10 = *(const f32x4*)(gm + 32 + 8 * fq); g11 = *(const f32x4*)(gm + 32 + 8 * fq + 4); }
#pragma unroll
        for (int ai = 0; ai < 2; ++ai)
#pragma unroll
            for (int m = 0; m < 4; ++m) {
                f32x4 a0 = acc[ai][0][m][0], a1 = acc[ai][0][m][1], b0 = acc[ai][1][m][0], b1 = acc[ai][1][m][1];
                const int rown = u.pm * 256 + wr * 64 + ai * 128 + m * 16 + fr;
                if (gm) {
                    float ss = 0.f;
#pragma unroll
                    for (int e = 0; e < 4; ++e) ss += a0[e] * a0[e] + a1[e] * a1[e] + b0[e] * b0[e] + b1[e] * b1[e];
                    ss += __shfl_xor(ss, 16); ss += __shfl_xor(ss, 32);
                    const float rs = rsqrtf(ss * (1.0f / 64.0f) + EPS) * mult;
                    a0 = a0 * rs * g00; a1 = a1 * rs * g01; b0 = b0 * rs * g10; b1 = b1 * rs * g11;
                } else if (seg == 20 && fq < 3) {
                    const f32x4 bg0 = *(const f32x4*)(bgate + 8 * fq), bg1 = *(const f32x4*)(bgate + 8 * fq + 4);
                    f32x4 s0, s1;
#pragma unroll
                    for (int e = 0; e < 4; ++e) { s0[e] = __builtin_amdgcn_rcpf(1.0f + __builtin_amdgcn_exp2f(-LOG2E * (a0[e] + bg0[e]))); s1[e] = __builtin_amdgcn_rcpf(1.0f + __builtin_amdgcn_exp2f(-LOG2E * (a1[e] + bg1[e]))); }
                    *(f32x4*)(gates + (size_t)rown * 24 + 8 * fq) = s0; *(f32x4*)(gates + (size_t)rown * 24 + 8 * fq + 4) = s1;
                }
                v4u p0, p1; p0.x = pk2(a0[0], a0[1]); p0.y = pk2(a0[2], a0[3]); p0.z = pk2(a1[0], a1[1]); p0.w = pk2(a1[2], a1[3]);
                p1.x = pk2(b0[0], b0[1]); p1.y = pk2(b0[2], b0[3]); p1.z = pk2(b1[0], b1[1]); p1.w = pk2(b1[2], b1[3]);
                const unsigned sx = lo ? p1.x : p0.x, sy = lo ? p1.y : p0.y, sz = lo ? p1.z : p0.z, sw = lo ? p1.w : p0.w;
                v4u rc; rc.x = dpp_ror8(sx); rc.y = dpp_ror8(sy); rc.z = dpp_ror8(sz); rc.w = dpp_ror8(sw);
                v4u s1, s2;
                s1.x = lo ? p0.x : rc.x; s1.y = lo ? p0.y : rc.y; s1.z = lo ? p0.z : rc.z; s1.w = lo ? p0.w : rc.w;
                s2.x = lo ? rc.x : p1.x; s2.y = lo ? rc.y : p1.y; s2.z = lo ? rc.z : p1.z; s2.w = lo ? rc.w : p1.w;
                const int r = rowb + ai * 128 + m * 16, b = r >> 12, t = r & 4095;
                bf16* dst = base + ((size_t)(b * ns + sidx) * SEQ + t) * 64 + d;
                if (keep) { __builtin_nontemporal_store(s1, (v4u*)dst); __builtin_nontemporal_store(s2, (v4u*)(dst + 8 * 64)); }
            }
    }
};
struct EpiRes {
    static constexpr bool PERM = true, PERM2 = false, AFTER_DRAIN = false;
    const float* base; float* out; const float* mod; int goff;
    __device__ __forceinline__ void operator()(const f32x4 (&acc)[2][2][4][2], const pg8::Unit& u, int wr, int wc, int fr, int fq) const {
        const int row0 = u.pm * 256 + wr * 64 + fr, col0 = u.pn * 256 + wc * 32 + 8 * fq;
        const int b = (u.pm * 256) >> 12;
        f32x4 gv[2][2];
#pragma unroll
        for (int bj = 0; bj < 2; ++bj)
#pragma unroll
            for (int n = 0; n < 2; ++n) gv[bj][n] = *(const f32x4*)(mod + b * 6144 + goff + col0 + bj * 128 + n * 4);
#pragma unroll
        for (int ai = 0; ai < 2; ++ai) {
            f32x4 xv[4][2][2];
#pragma unroll
            for (int m = 0; m < 4; ++m) { const size_t r = (size_t)(row0 + ai * 128 + m * 16);
#pragma unroll
                for (int bj = 0; bj < 2; ++bj)
#pragma unroll
                    for (int n = 0; n < 2; ++n) xv[m][bj][n] = *(const f32x4*)(base + r * DM + col0 + bj * 128 + n * 4); }
#pragma unroll
            for (int m = 0; m < 4; ++m) { const size_t r = (size_t)(row0 + ai * 128 + m * 16);
#pragma unroll
                for (int bj = 0; bj < 2; ++bj)
#pragma unroll
                    for (int n = 0; n < 2; ++n) *(f32x4*)(out + r * DM + col0 + bj * 128 + n * 4) = xv[m][bj][n] + gv[bj][n] * acc[ai][bj][m][n]; }
        }
    }
};
struct EpiResB {
    static constexpr bool PERM = true, PERM2 = false, AFTER_DRAIN = false;
    const float* base; bf16* out; const float* mod; int goff;
    __device__ __forceinline__ void operator()(const f32x4 (&acc)[2][2][4][2], const pg8::Unit& u, int wr, int wc, int fr, int fq) const {
        const int row0 = u.pm * 256 + wr * 64 + fr, col0 = u.pn * 256 + wc * 32 + 8 * fq;
        const int b = (u.pm * 256) >> 12;
        f32x4 gv[2][2];
#pragma unroll
        for (int bj = 0; bj < 2; ++bj)
#pragma unroll
            for (int n = 0; n < 2; ++n) gv[bj][n] = *(const f32x4*)(mod + b * 6144 + goff + col0 + bj * 128 + n * 4);
#pragma unroll
        for (int ai = 0; ai < 2; ++ai) {
            f32x4 xv[4][2][2];
#pragma unroll
            for (int m = 0; m < 4; ++m) { const size_t r = (size_t)(row0 + ai * 128 + m * 16);
#pragma unroll
                for (int bj = 0; bj < 2; ++bj)
#pragma unroll
                    for (int n = 0; n < 2; ++n) xv[m][bj][n] = *(const f32x4*)(base + r * DM + col0 + bj * 128 + n * 4); }
#pragma unroll
            for (int m = 0; m < 4; ++m) { const size_t r = (size_t)(row0 + ai * 128 + m * 16);
#pragma unroll
                for (int bj = 0; bj < 2; ++bj) { const f32x4 v0 = xv[m][bj][0] + gv[bj][0] * acc[ai][bj][m][0], v1 = xv[m][bj][1] + gv[bj][1] * acc[ai][bj][m][1];
                    v4u w; w.x = pk2(v0[0], v0[1]); w.y = pk2(v0[2], v0[3]); w.z = pk2(v1[0], v1[1]); w.w = pk2(v1[2], v1[3]);
                    *(v4u*)(out + r * DM + col0 + bj * 128) = w; } }
        }
    }
};
struct EpiResF {
    static constexpr bool PERM = true, PERM2 = false, AFTER_DRAIN = false;
    const bf16* base; float* out; const float* mod; int goff;
    __device__ __forceinline__ void operator()(const f32x4 (&acc)[2][2][4][2], const pg8::Unit& u, int wr, int wc, int fr, int fq) const {
        const int row0 = u.pm * 256 + wr * 64 + fr, col0 = u.pn * 256 + wc * 32 + 8 * fq;
        const int b = (u.pm * 256) >> 12;
        f32x4 gv[2][2];
#pragma unroll
        for (int bj = 0; bj < 2; ++bj)
#pragma unroll
            for (int n = 0; n < 2; ++n) gv[bj][n] = *(const f32x4*)(mod + b * 6144 + goff + col0 + bj * 128 + n * 4);
#pragma unroll
        for (int ai = 0; ai < 2; ++ai) {
            v4u xv[4][2];
#pragma unroll
            for (int m = 0; m < 4; ++m) { const size_t r = (size_t)(row0 + ai * 128 + m * 16);
#pragma unroll
                for (int bj = 0; bj < 2; ++bj) xv[m][bj] = *(const v4u*)(base + r * DM + col0 + bj * 128); }
#pragma unroll
            for (int m = 0; m < 4; ++m) { const size_t r = (size_t)(row0 + ai * 128 + m * 16);
#pragma unroll
                for (int bj = 0; bj < 2; ++bj) { const v4u x = xv[m][bj];
                    const f32x4 x0 = {bflo(x.x), bfhi(x.x), bflo(x.y), bfhi(x.y)}, x1 = {bflo(x.z), bfhi(x.z), bflo(x.w), bfhi(x.w)};
                    *(f32x4*)(out + r * DM + col0 + bj * 128) = x0 + gv[bj][0] * acc[ai][bj][m][0];
                    *(f32x4*)(out + r * DM + col0 + bj * 128 + 4) = x1 + gv[bj][1] * acc[ai][bj][m][1]; } }
        }
    }
};
struct EpiCmp {
    static constexpr bool PERM = false, PERM2 = false, AFTER_DRAIN = false;
    float* hid; const float* bias1;
    __device__ __forceinline__ void operator()(const f32x4 (&acc)[2][2][4][2], const pg8::Unit& u, int wr, int wc, int fr, int fq) const {
        const int row0 = wr * 64 + fr, col0 = wc * 32 + 4 * fq;
        float* hb = hid + ((size_t)u.pn * 4096 + (size_t)u.pm * 256) * 256;
#pragma unroll
        for (int ai = 0; ai < 2; ++ai)
#pragma unroll
            for (int m = 0; m < 4; ++m) { const int r = row0 + ai * 128 + m * 16;
#pragma unroll
                for (int bj = 0; bj < 2; ++bj)
#pragma unroll
                    for (int n = 0; n < 2; ++n) { const int c = col0 + bj * 128 + n * 16;
                        const f32x4 bv = *(const f32x4*)(bias1 + u.pn * 256 + c); f32x4 v = acc[ai][bj][m][n] + bv;
#pragma unroll
                        for (int e = 0; e < 4; ++e) v[e] = gelu_tanh_f(v[e]);
                        *(f32x4*)(hb + (size_t)r * 256 + c) = v; } }
    }
};
struct CmpOrder {
    int c; const bf16* proj; const bf16* btc1;
    __device__ bool next(int i, pg8::Unit& u) const { if (i > 0 || c >= 32) return false; u.pm = c & 15; u.pn = c >> 4; return true; }
    __device__ __forceinline__ const char* a_ptr(const pg8::Gemm&, const pg8::Unit& u) const { const int b = u.pm >> 1, g = u.pm & 1; return (const char*)(proj + ((size_t)(b * NSEG + 8 + 2 * u.pn + g) * SEQ) * 64); }
    __device__ __forceinline__ const char* b_ptr(const pg8::Gemm&, const pg8::Unit& u) const { return (const char*)(btc1 + (size_t)u.pn * 256 * 2048); }
    __device__ __forceinline__ void a_ready(const pg8::Unit&) const {}
    __device__ __forceinline__ void done(const pg8::Unit&) const {}
};
struct EpiFfn {
    static constexpr bool PERM = true, PERM2 = false, AFTER_DRAIN = false;
    bf16* H; const float* cw; float* gtail; float* ghead; float* uhead; LAS float* hb;
    __device__ __forceinline__ void operator()(const f32x4 (&acc)[2][2][4][2], const pg8::Unit& u, int wr, int wc, int fr, int fq) const {
        int cl_ = wc * 32 + 8 * fq; asm volatile("" : "+v"(cl_));
        const int cl = cl_, ch0 = u.pn * 128 + cl;
        if (fr >= 14) {
#pragma unroll
            for (int ai = 0; ai < 2; ++ai)
#pragma unroll
                for (int m = 0; m < 4; ++m) { const int kk = 8 * ai + 4 * wr + m;
#pragma unroll
                    for (int n = 0; n < 2; ++n) *(LAS f32x4*)(hb + ((kk * 2 + (fr - 14)) * 128 + cl + 4 * n)) = acc[ai][0][m][n]; }
        }
        asm volatile("s_waitcnt lgkmcnt(0)" ::: "memory"); __builtin_amdgcn_s_barrier(); asm volatile("" ::: "memory");
        f32x4 w0[2], w1[2], w2[2];
#pragma unroll
        for (int n = 0; n < 2; ++n) { w0[n] = *(const f32x4*)(cw + ch0 + 4 * n); w1[n] = *(const f32x4*)(cw + DFF + ch0 + 4 * n); w2[n] = *(const f32x4*)(cw + 2 * DFF + ch0 + 4 * n); }
#pragma unroll
        for (int ai = 0; ai < 2; ++ai)
#pragma unroll
            for (int m = 0; m < 4; ++m) { const int kk = 8 * ai + 4 * wr + m; const int rl = 128 * ai + 64 * wr + 16 * m + fr; const size_t r = (size_t)u.pm * 256 + rl;
                f32x4 hv[2];
#pragma unroll
                for (int n = 0; n < 2; ++n) { const f32x4 g0 = acc[ai][0][m][n]; f32x4 g1, g2;
                    g1[0] = dpp_shr1(g0[0]); g1[1] = dpp_shr1(g0[1]); g1[2] = dpp_shr1(g0[2]); g1[3] = dpp_shr1(g0[3]);
                    g2[0] = dpp_shr2(g0[0]); g2[1] = dpp_shr2(g0[1]); g2[2] = dpp_shr2(g0[2]); g2[3] = dpp_shr2(g0[3]);
                    if (fr < 2) { const f32x4 z = {0.f, 0.f, 0.f, 0.f};
                        const f32x4 p15 = kk > 0 ? *(const LAS f32x4*)(hb + (((kk - 1) * 2 + 1) * 128 + cl + 4 * n)) : z;
                        const f32x4 p14 = kk > 0 ? *(const LAS f32x4*)(hb + (((kk - 1) * 2 + 0) * 128 + cl + 4 * n)) : z;
                        if (fr == 0) { g1 = p15; g2 = p14; } else { g2 = p15; } }
                    const f32x4 pre = w0[n] * g2 + w1[n] * g1 + w2[n] * g0; const f32x4 up = acc[ai][1][m][n];
#pragma unroll
                    for (int e = 0; e < 4; ++e) hv[n][e] = silu_f(pre[e]) * up[e];
                    if (kk == 0 && fr < 2) { *(f32x4*)(ghead + ((size_t)u.pm * 2 + fr) * DFF + ch0 + 4 * n) = g0; *(f32x4*)(uhead + ((size_t)u.pm * 2 + fr) * DFF + ch0 + 4 * n) = up; }
                    if (kk == 15 && fr >= 14) *(f32x4*)(gtail + ((size_t)u.pm * 2 + (fr - 14)) * DFF + ch0 + 4 * n) = g0;
                }
                v4u w; w.x = pk2(hv[0][0], hv[0][1]); w.y = pk2(hv[0][2], hv[0][3]); w.z = pk2(hv[1][0], hv[1][1]); w.w = pk2(hv[1][2], hv[1][3]);
                __builtin_nontemporal_store(w, (v4u*)(H + r * DFF + ch0)); }
    }
};

__device__ __forceinline__ void phase3_prep(const Args& a, LAS unsigned char* lds, int pw, int PW) {
    int tid_ = threadIdx.x; asm volatile("" : "+v"(tid_)); const int tid = tid_, lane = tid & 63, wave = tid >> 6;
    unsigned char* ws = a.ws;
    const bf16* __restrict__ proj = (const bf16*)(ws + WS_PROJ);
    {
        bf16* mixed = (bf16*)(ws + WS_MIXED);
        const float* cw = a.in[17]; const float* cg_g = a.in[19];
        const int sub = lane & 7;
        constexpr int NST = NB * 8 * SEQ / 8;
        for (int st0 = pw; st0 < NST; st0 += 2 * PW) {
            v4u rb[2], rc0[2], rx0[2], rc1[2], rx1[2], rc2[2], rx2[2];
#pragma unroll
            for (int u = 0; u < 2; ++u) { const int st1 = st0 + u * PW, st = st1 < NST ? st1 : NST - 1;
                {
                    const int b = st >> 12, cgp = (st >> 9) & 7, t = (st & 511) * 8 + (lane >> 3);
                    const int c = cgp * 64 + sub * 8;
                    const int colB = 1304 + c, colC = 1816 + c, colX = 2328 + c;
                    const bf16* pB = proj + ((size_t)(b * NSEG + (colB >> 6)) * SEQ + t) * 64 + (colB & 63);
                    const bf16* pC = proj + ((size_t)(b * NSEG + (colC >> 6)) * SEQ + t) * 64 + (colC & 63);
                    const bf16* pX = proj + ((size_t)(b * NSEG + (colX >> 6)) * SEQ + t) * 64 + (colX & 63);
                    const v4u z = {0u, 0u, 0u, 0u};
                    rb[u] = *(const v4u*)pB; rc0[u] = *(const v4u*)pC; rx0[u] = *(const v4u*)pX;
                    rc1[u] = t >= 1 ? *(const v4u*)(pC - 64) : z; rx1[u] = t >= 1 ? *(const v4u*)(pX - 64) : z;
                    rc2[u] = t >= 2 ? *(const v4u*)(pC - 128) : z; rx2[u] = t >= 2 ? *(const v4u*)(pX - 128) : z; } }
#pragma unroll
            for (int u = 0; u < 2; ++u) { const int st1 = st0 + u * PW, st = st1 < NST ? st1 : NST - 1;
                {
                    const int b = st >> 12, cgp = (st >> 9) & 7, t = (st & 511) * 8 + (lane >> 3);
                    const int c = cgp * 64 + sub * 8;
                    const f32x4 w0a = *(const f32x4*)(cw + c), w0b = *(const f32x4*)(cw + c + 4), w1a = *(const f32x4*)(cw + 512 + c), w1b = *(const f32x4*)(cw + 512 + c + 4);
                    const f32x4 w2a = *(const f32x4*)(cw + 1024 + c), w2b = *(const f32x4*)(cw + 1024 + c + 4), ga = *(const f32x4*)(cg_g + c), gb = *(const f32x4*)(cg_g + c + 4);
                    float v[8];
#define CONV_E(e, RW, W0, W1, W2, LOHI) v[e] = LOHI(rb[u].RW) * (W0 * (LOHI(rc2[u].RW) * LOHI(rx2[u].RW)) + W1 * (LOHI(rc1[u].RW) * LOHI(rx1[u].RW)) + W2 * (LOHI(rc0[u].RW) * LOHI(rx0[u].RW)))
                    CONV_E(0, x, w0a[0], w1a[0], w2a[0], bflo); CONV_E(1, x, w0a[1], w1a[1], w2a[1], bfhi); CONV_E(2, y, w0a[2], w1a[2], w2a[2], bflo); CONV_E(3, y, w0a[3], w1a[3], w2a[3], bfhi);
                    CONV_E(4, z, w0b[0], w1b[0], w2b[0], bflo); CONV_E(5, z, w0b[1], w1b[1], w2b[1], bfhi); CONV_E(6, w, w0b[2], w1b[2], w2b[2], bflo); CONV_E(7, w, w0b[3], w1b[3], w2b[3], bfhi);
#undef CONV_E
                    float ss = 0.f;
#pragma unroll
                    for (int e = 0; e < 8; ++e) ss += v[e] * v[e];
                    ss += __shfl_xor(ss, 1); ss += __shfl_xor(ss, 2); ss += __shfl_xor(ss, 4);
                    const float rs = rsqrtf(ss * (1.0f / 64.0f) + EPS);
                    v4u o; o.x = pk2(v[0] * rs * ga[0], v[1] * rs * ga[1]); o.y = pk2(v[2] * rs * ga[2], v[3] * rs * ga[3]);
                    o.z = pk2(v[4] * rs * gb[0], v[5] * rs * gb[1]); o.w = pk2(v[6] * rs * gb[2], v[7] * rs * gb[3]);
                    if (st1 < NST) *(v4u*)(mixed + ((size_t)b * SEQ + t) * DM + 512 + c) = o;
                } }
        }
    }
}

__device__ __forceinline__ void phase4(const Args& a, LAS unsigned char* lds) {
    int tid_ = threadIdx.x; asm volatile("" : "+v"(tid_)); const int tid = tid_, lane = tid & 63, wave = tid >> 6;
    unsigned char* ws = a.ws;
    const float* hid = (const float*)(ws + WS_HID);
    const int G = gridDim.x, half = G >> 1;
    const int kv = (int)blockIdx.x >= half ? 1 : 0;
    const int bl = (int)blockIdx.x - kv * half, nb = kv ? (G - half) : half;
    LAS float* W2 = (LAS float*)lds;
    LAS float* scr = (LAS float*)(lds + 65536 + wave * 4096);
    { const float* w2 = a.in[14 + 2 * kv];
#pragma unroll
      for (int q = 0; q < 8; ++q) { const int idx = q * 512 + tid; *(LAS f32x4*)(W2 + idx * 4) = *(const f32x4*)(w2 + idx * 4); } }
    __syncthreads();
    for (int it = bl * NWAVES + wave; it < 1024; it += nb * NWAVES) {
        const int r4 = it * 4;
#pragma unroll
        for (int j = 0; j < 4; ++j)
#pragma unroll
            for (int q = 0; q < 4; ++q) scr[(q * 64 + lane) * 4 + j] = hid[((size_t)kv * 4096 + r4 + j) * 256 + q * 64 + lane];
        LDS_WAIT(); asm volatile("" ::: "memory");
        f32x4 acc = {0.f, 0.f, 0.f, 0.f};
#pragma unroll 16
        for (int k = 0; k < 256; ++k) { const float w = W2[k * 64 + lane]; const f32x4 h = *(const LAS f32x4*)(scr + k * 4); acc += h * w; }
        LDS_WAIT(); asm volatile("" ::: "memory");
#pragma unroll
        for (int j = 0; j < 4; ++j) {
            const int row = r4 + j, pair = row >> 8, n = row & 255;
            if (kv == 0) {
                const float ss = wave_sum(acc[j] * acc[j]);
                const float y = acc[j] * rsqrtf(ss * (1.0f / 64.0f) + EPS) * a.in[8][lane];
                ((bf16*)(ws + WS_KCN))[((size_t)pair * 256 + n) * 64 + lane] = (n < 255) ? (bf16)f2bf(y) : (bf16)0;
            } else {
                ((bf16*)(ws + WS_VCT))[((size_t)pair * 64 + lane) * 256 + n] = (n < 255) ? (bf16)f2bf(acc[j]) : (bf16)0;
            }
        }
    }
}

#ifndef PROBE_CMP
#define PROBE_CMP 0
#endif
#ifndef PROBE_TOPK
#define PROBE_TOPK 0
#endif
#ifndef PROBE_SEL
#define PROBE_SEL 0
#endif
#ifndef PROBE_WIN
#define PROBE_WIN 0
#endif
#define MFMA32(a, b, c) __builtin_amdgcn_mfma_f32_32x32x16_bf16((a), (b), (c), 0, 0, 0)
constexpr int AT_CK = 0, AT_CV = 36864, AT_PS = 70656, AT_SLOT = 0, AT_OF = 73728, AT_WU = 139264, AT_KEYS = 139392, PS_PITCH = 260;
constexpr int QCTR_WORD = 3584;
constexpr int AT_KB0 = 0, AT_KB1 = 9216, AT_VB0 = 18432, AT_VB1 = 27648;
constexpr float NEG_BIG = -1.0e30f;

__device__ __forceinline__ float quad_sum(float t) {
    t += __builtin_bit_cast(float, __builtin_amdgcn_mov_dpp(__builtin_bit_cast(int, t), 0xB1, 0xf, 0xf, true));
    t += __builtin_bit_cast(float, __builtin_amdgcn_mov_dpp(__builtin_bit_cast(int, t), 0x4E, 0xf, 0xf, true));
    return t;
}
__device__ __forceinline__ s16x4 vtr(const LAS unsigned char* p) { return __builtin_amdgcn_ds_read_tr16_b64_v4i16((LAS s16x4*)p); }
template <int MODE, bool DIAG, bool VTR = false>
__device__ __forceinline__ void attn_tile(const LAS unsigned char* Kt, const LAS unsigned char* Vt, int vpitch, int vkoff, const bf16x8 (&qf)[4], int r, int h2,
                                          float cs, float A, int lo, int hi, float& m, float& l, f32x16 (&o)[2], float inv_l, LAS float* psrow) {
    float rowsum = 0.f;
#pragma unroll
    for (int sub = 0; sub < 2; ++sub) {
        f32x16 s;
#pragma unroll
        for (int i = 0; i < 16; ++i) s[i] = __builtin_fmaf(cs, (float)(32 * sub + (i & 3) + 8 * (i >> 2)), A);
#pragma unroll
        for (int ks = 0; ks < 4; ++ks) { const bf16x8 kf = *(const LAS bf16x8*)(Kt + (32 * sub + r) * 144 + (16 * ks + 8 * h2) * 2); s = MFMA32(kf, qf[ks], s); }
        if (DIAG) {
#pragma unroll
            for (int i = 0; i < 16; ++i) { const int ci = 32 * sub + (i & 3) + 8 * (i >> 2); s[i] = (ci >= lo && ci <= hi) ? s[i] : -INFINITY; }
        }
        if (MODE == 0) {
            float mx = s[0];
#pragma unroll
            for (int i = 1; i < 16; ++i) mx = fmaxf(mx, s[i]);
            mx = fmaxf(mx, __shfl_xor(mx, 32));
            const float mn = fmaxf(m, mx); l *= __builtin_amdgcn_exp2f(m - mn); m = mn;
            float rs = 0.f;
#pragma unroll
            for (int i = 0; i < 16; ++i) rs += __builtin_amdgcn_exp2f(s[i] - mn);
            l += rs;
            continue;
        }
#pragma unroll
        for (int i = 0; i < 16; ++i) {
            float p;
            if (MODE == 1) p = __builtin_amdgcn_exp2f(s[i] - m) * inv_l; else p = __builtin_amdgcn_exp2f(s[i]);
            rowsum += p; s[i] = p;
        }
        if (MODE == 1) {
#pragma unroll
            for (int i = 0; i < 16; ++i) { const float t = quad_sum(s[i]);
                if ((r & 3) == 0) psrow[32 * sub + (i & 3) + 8 * (i >> 2) + 4 * h2] = t; }
        }
#pragma unroll
        for (int st = 0; st < 2; ++st) {
            v4u pw; pw.x = pk2(s[8 * st + 0], s[8 * st + 1]); pw.y = pk2(s[8 * st + 2], s[8 * st + 3]);
            pw.z = pk2(s[8 * st + 4], s[8 * st + 5]); pw.w = pk2(s[8 * st + 6], s[8 * st + 7]);
            const bf16x8 pf = __builtin_bit_cast(bf16x8, pw);
#pragma unroll
            for (int dt = 0; dt < 2; ++dt) {
                s16x4 lo4, hi4;
                if (VTR) {
                    const LAS unsigned char* vp = Vt + (32 * sub + 16 * st + 4 * h2 + ((r & 15) >> 2)) * vpitch + (32 * dt + 16 * (r >> 4)) * 2 + 8 * (r & 3);
                    lo4 = vtr(vp); hi4 = vtr(vp + 8 * vpitch);
                } else {
                    const LAS unsigned char* vp = Vt + (32 * dt + r) * vpitch + vkoff + (32 * sub + 16 * st + 4 * h2) * 2;
                    lo4 = *(const LAS s16x4*)(vp); hi4 = *(const LAS s16x4*)(vp + 16);
                }
                const bf16x8 vf = __builtin_shufflevector(lo4, hi4, 0, 1, 2, 3, 4, 5, 6, 7);
                o[dt] = MFMA32(vf, pf, o[dt]);
            }
        }
    }
    if (MODE >= 2) l += rowsum;
}

template <int MODE>
__device__ __forceinline__ void attn_blocks(LAS unsigned char* lds, unsigned long long blocks, unsigned long long wmask, int iq, const bf16* Kg, const bf16* Vtg, const bf16x8 (&qf)[4], int r, int h2,
                                            float slope2, float smax2, int tpos, unsigned long long mymask, float& l, f32x16 (&o)[2]) {
    int tid_ = threadIdx.x; asm volatile("" : "+v"(tid_)); const int tid = tid_;
    const int lrow = tid >> 3, lch = tid & 7;
    const int loff = lrow * 144 + lch * 16;
    const unsigned char* kgp = (const unsigned char*)Kg + tid * 16;
    const unsigned char* vgp = (const unsigned char*)Vtg + tid * 16;
    float mdummy = 0.f;
    unsigned long long rem = blocks;
    int j0 = __builtin_ctzll(rem); rem &= rem - 1;
    int j1 = rem ? __builtin_ctzll(rem) : -1; if (rem) rem &= rem - 1;
    v4u k0, v0, k1 = {0u, 0u, 0u, 0u}, v1 = {0u, 0u, 0u, 0u};
    k0 = *(const v4u*)(kgp + (size_t)j0 * 8192); v0 = *(const v4u*)(vgp + (size_t)j0 * 8192);
    if (j1 >= 0) { k1 = *(const v4u*)(kgp + (size_t)j1 * 8192); v1 = *(const v4u*)(vgp + (size_t)j1 * 8192); }
    *(LAS v4u*)(lds + AT_SLOT + loff) = k0; *(LAS v4u*)(lds + AT_SLOT + 9216 + loff) = v0;
    *(LAS v4u*)(lds + AT_SLOT + 18432 + loff) = k1; *(LAS v4u*)(lds + AT_SLOT + 27648 + loff) = v1;
    __syncthreads();
    int cur = 0;
    for (;;) {
        const int n0 = rem ? __builtin_ctzll(rem) : -1; if (rem) rem &= rem - 1;
        const int n1 = rem ? __builtin_ctzll(rem) : -1; if (rem) rem &= rem - 1;
        if (n0 >= 0) { k0 = *(const v4u*)(kgp + (size_t)n0 * 8192); v0 = *(const v4u*)(vgp + (size_t)n0 * 8192); }
        if (n1 >= 0) { k1 = *(const v4u*)(kgp + (size_t)n1 * 8192); v1 = *(const v4u*)(vgp + (size_t)n1 * 8192); }
        const LAS unsigned char* sb = lds + AT_SLOT + cur * 36864;
#pragma unroll
        for (int u = 0; u < 2; ++u) {
            const int j = u ? j1 : j0;
            if (j >= 0 && ((wmask >> j) & 1ull)) {
                int rr = r, hh = h2; asm volatile("" : "+v"(rr), "+v"(hh));
                const bool on = (mymask >> j) & 1ull;
                const int rel = tpos - 64 * j - 4 * h2;
                float A = -slope2 * (float)rel - smax2;
                if (MODE == 2 && !on) A = -INFINITY;
                const LAS unsigned char* kb = sb + u * 18432; const LAS unsigned char* vb = kb + 9216;
                if (j == iq || (MODE == 3 && j == iq - 8)) attn_tile<MODE, true, true>(kb, vb, 144, 0, qf, rr, hh, slope2, A, (MODE == 3) ? rel - 511 : -100000, rel, mdummy, l, o, 0.f, nullptr);
                else attn_tile<MODE, false, true>(kb, vb, 144, 0, qf, rr, hh, slope2, A, 0, 0, mdummy, l, o, 0.f, nullptr);
            }
        }
        if (n0 >= 0) {
            LAS unsigned char* nb = lds + AT_SLOT + (cur ^ 1) * 36864;
            *(LAS v4u*)(nb + loff) = k0; *(LAS v4u*)(nb + 9216 + loff) = v0;
            if (n1 >= 0) { *(LAS v4u*)(nb + 18432 + loff) = k1; *(LAS v4u*)(nb + 27648 + loff) = v1; }
        }
        __syncthreads();
        if (n0 < 0) break;
        j0 = n0; j1 = n1; cur ^= 1;
    }
}

__device__ __forceinline__ float max_abs64(const float* g) {
    float m = fabsf(g[threadIdx.x & 63]);
#pragma unroll
    for (int o = 1; o < 64; o <<= 1) m = fmaxf(m, __shfl_xor(m, o));
    return m; }

__device__ __forceinline__ void phase5(const Args& a, LAS unsigned char* lds) {
    int tid_ = threadIdx.x; asm volatile("" : "+v"(tid_)); const int tid = tid_, lane = tid & 63, wave = tid >> 6, G = gridDim.x, c = blockIdx.x;
    unsigned char* ws = a.ws;
    const bf16* QN = (const bf16*)(ws + WS_QN);
    const float* gates = (const float*)(ws + WS_GATES);
    bf16* mixed = (bf16*)(ws + WS_MIXED);
    LAS float* PS = (LAS float*)(lds + AT_PS);
    LAS unsigned long long* WU = (LAS unsigned long long*)(lds + AT_WU);
    const float qb = max_abs64(a.in[7]) * (64.0f * 0.125f * LOG2E * 1.02f);
    const float smax_s = qb * max_abs64(a.in[9]), smax_w = qb * max_abs64(a.in[10]);
    for (int rd = 0;; ++rd) {
        const int rank = rd * G + ((rd & 1) ? (G - 1 - c) : c);
        if (rd * G >= 1024) break;
        if (rank >= 1024) continue;
        int ln_ = lane; asm volatile("" : "+v"(ln_));
        const int r = ln_ & 31, h2 = ln_ >> 5, hq = r & 3, tl = r >> 2;
        const int i = 63 - (rank >> 4), bg = rank & 15, b = bg >> 1, g = bg & 1;
        const int T0 = 64 * i, tpos = T0 + 8 * wave + tl;
        const int head = 4 * g + hq;
        const float slope2 = exp2f(-(float)(head + 1)) * LOG2E;
        const size_t mrow = (size_t)b * SEQ + tpos;
        {
            const unsigned char* kc = (const unsigned char*)((const bf16*)(ws + WS_KCN) + (size_t)bg * 256 * 64);
            const unsigned char* vc = (const unsigned char*)((const bf16*)(ws + WS_VCT) + (size_t)bg * 64 * 256);
#pragma unroll
            for (int q = 0; q < 4; ++q) { const int idx = q * 512 + tid;
                const v4u kv_ = *(const v4u*)(kc + (size_t)idx * 16); *(LAS v4u*)(lds + AT_CK + (idx >> 3) * 144 + (idx & 7) * 16) = kv_;
                const v4u vv_ = *(const v4u*)(vc + (size_t)idx * 16); *(LAS v4u*)(lds + AT_CV + (idx >> 5) * 528 + (idx & 31) * 16) = vv_; }
        }
        bf16x8 qf[4];
        { const bf16* qp = QN + ((size_t)(b * 8 + head) * SEQ + tpos) * 64 + 8 * h2;
#pragma unroll
          for (int ks = 0; ks < 4; ++ks) qf[ks] = *(const bf16x8*)(qp + 16 * ks); }
        __syncthreads();
        f32x16 ofin[2];
        const int KT = ((4 * i + 2) >> 6) + 1;
        float g_c, g_s, g_w;
        { const float* gp = gates + mrow * 24 + head * 3; g_c = gp[0]; g_s = gp[1]; g_w = gp[2]; }
#if PROBE_CMP
        for (int rep = 0; rep < 2; ++rep)
#endif
        {
            float m = NEG_BIG, l = 0.f; f32x16 o[2];
#pragma unroll
            for (int dt = 0; dt < 2; ++dt)
#pragma unroll
                for (int e = 0; e < 16; ++e) o[dt][e] = 0.f;
            const float cs = 16.0f * slope2;
            for (int kt = 0; kt < KT; ++kt) {
                const int rel = tpos - 31 - 1024 * kt;
                attn_tile<0, true>(lds + AT_CK + kt * 64 * 144, lds + AT_CV, 528, kt * 128, qf, r, h2, cs, -slope2 * (float)(rel - 64 * h2), -100000, (rel >> 4) - 4 * h2, m, l, o, 0.f, nullptr);
            }
            const float lt = l + __shfl_xor(l, 32);
            const float inv_l = lt > 0.f ? 1.0f / lt : 0.f;
            LAS float* psrow = PS + (8 * wave + tl) * PS_PITCH;
            for (int kt = 0; kt < KT; ++kt) {
                const int rel = tpos - 31 - 1024 * kt;
                attn_tile<1, true>(lds + AT_CK + kt * 64 * 144, lds + AT_CV, 528, kt * 128, qf, r, h2, cs, -slope2 * (float)(rel - 64 * h2), -100000, (rel >> 4) - 4 * h2, m, l, o, inv_l, psrow + 64 * kt);
            }
#pragma unroll
            for (int dt = 0; dt < 2; ++dt)
#pragma unroll
                for (int e = 0; e < 16; ++e) ofin[dt][e] = g_c * o[dt][e];
        }
        LDS_WAIT(); asm volatile("" ::: "memory");
        unsigned long long mymask = 0ull, wunion = 0ull;
#if PROBE_TOPK
        for (int rep = 0; rep < 2; ++rep)
#endif
        {
            const int nmax = (4 * i + 3) < 254 ? (4 * i + 3) : 254;
            const unsigned long long validbits = (i >= 63) ? ~0ull : ((1ull << (i + 1)) - 1ull);
            const bool forced = (lane == 0) || (lane == i) || (lane == i - 1);
            LAS unsigned* KEYS = (LAS unsigned*)(lds + AT_KEYS) + wave * 64;
#pragma unroll 1
            for (int t8 = 0; t8 < 8; ++t8) {
                const LAS float* ps = PS + (8 * wave + t8) * PS_PITCH;
                float imp = 0.f;
#pragma unroll
                for (int dn = -1; dn <= 3; ++dn) { const int n = 4 * lane + dn; if (n >= 0 && n <= nmax) imp += ps[n]; }
                unsigned key = (lane <= i) ? (((__builtin_bit_cast(unsigned, imp) & ~63u) + 64u) | (unsigned)(63 - lane)) : (unsigned)(63 - lane);
                key = forced ? (0xFFFFFFC0u | (unsigned)(63 - lane)) : key;
                KEYS[lane] = key;
                LDS_WAIT(); asm volatile("" ::: "memory");
                int cnt = 0;
#pragma unroll
                for (int k4 = 0; k4 < 16; ++k4) { const v4u kk = *(const LAS v4u*)(KEYS + 4 * k4);
                    cnt += (kk.x > key) ? 1 : 0; cnt += (kk.y > key) ? 1 : 0; cnt += (kk.z > key) ? 1 : 0; cnt += (kk.w > key) ? 1 : 0; }
                LDS_WAIT(); asm volatile("" ::: "memory");
                const unsigned long long msk = __ballot(cnt < 16) & validbits;
                wunion |= msk;
                if (tl == t8) mymask = msk;
            }
            if (lane == 0) WU[wave] = wunion;
        }
        __syncthreads();
        unsigned long long uni = 0ull;
#pragma unroll
        for (int w = 0; w < 8; ++w) uni |= WU[w];
        {
            const unsigned lo = __builtin_amdgcn_readfirstlane((unsigned)uni), hi = __builtin_amdgcn_readfirstlane((unsigned)(uni >> 32));
            uni = ((unsigned long long)hi << 32) | lo;
        }
        LAS float* OF = (LAS float*)(lds + AT_OF) + tid;
#pragma unroll
        for (int dt = 0; dt < 2; ++dt)
#pragma unroll
            for (int e = 0; e < 16; ++e) OF[(dt * 16 + e) * 512] = ofin[dt][e];
        {
            float l = 0.f; f32x16 o[2];
#pragma unroll
            for (int dt = 0; dt < 2; ++dt)
#pragma unroll
                for (int e = 0; e < 16; ++e) o[dt][e] = 0.f;
            attn_blocks<2>(lds, uni, wunion, i, (const bf16*)(ws + WS_KSN) + (size_t)bg * SEQ * 64, (const bf16*)(ws + WS_PROJ) + ((size_t)(b * NSEG + 14 + g) * SEQ) * 64, qf, r, h2, slope2, smax_s, tpos, mymask, l, o);
            const float lt = l + __shfl_xor(l, 32);
            const float sc = lt > 0.f ? g_s / lt : 0.f;
#pragma unroll
            for (int dt = 0; dt < 2; ++dt)
#pragma unroll
                for (int e = 0; e < 16; ++e) OF[(dt * 16 + e) * 512] += sc * o[dt][e];
        }
        {
            float l = 0.f; f32x16 o[2];
#pragma unroll
            for (int dt = 0; dt < 2; ++dt)
#pragma unroll
                for (int e = 0; e < 16; ++e) o[dt][e] = 0.f;
            const int jlo = i - 8 < 0 ? 0 : i - 8;
            const unsigned long long upto = (i >= 63) ? ~0ull : ((1ull << (i + 1)) - 1ull);
            const unsigned long long wb = upto & ~((1ull << jlo) - 1ull);
            attn_blocks<3>(lds, wb, ~0ull, i, (const bf16*)(ws + WS_KWN) + (size_t)bg * SEQ * 64, (const bf16*)(ws + WS_PROJ) + ((size_t)(b * NSEG + 18 + g) * SEQ) * 64, qf, r, h2, slope2, smax_w, tpos, ~0ull, l, o);
            const float lt = l + __shfl_xor(l, 32);
            const float sc = lt > 0.f ? g_w / lt : 0.f;
#pragma unroll
            for (int dt = 0; dt < 2; ++dt)
#pragma unroll
                for (int e = 0; e < 16; ++e) ofin[dt][e] = OF[(dt * 16 + e) * 512] + sc * o[dt][e];
        }
        {
            float ss = 0.f;
#pragma unroll
            for (int dt = 0; dt < 2; ++dt)
#pragma unroll
                for (int e = 0; e < 16; ++e) ss += ofin[dt][e] * ofin[dt][e];
            ss += __shfl_xor(ss, 32);
            const float rs = rsqrtf(ss * (1.0f / 64.0f) + EPS);
            const float* og = a.in[18] + head * 64;
            LAS unsigned char* ob = lds + AT_CK + (wave * 32 + r) * 144;
#pragma unroll
            for (int dt = 0; dt < 2; ++dt)
#pragma unroll
                for (int i4 = 0; i4 < 4; ++i4) { const int d0 = 32 * dt + 8 * i4 + 4 * h2; const f32x4 gv = *(const f32x4*)(og + d0);
                    v2u w; w.x = pk2(ofin[dt][4 * i4 + 0] * rs * gv[0], ofin[dt][4 * i4 + 1] * rs * gv[1]); w.y = pk2(ofin[dt][4 * i4 + 2] * rs * gv[2], ofin[dt][4 * i4 + 3] * rs * gv[3]);
                    *(LAS v2u*)(ob + d0 * 2) = w; }
            __syncthreads();
#pragma unroll
            for (int q = 0; q < 4; ++q) { const int idx = q * 512 + tid, row = idx >> 3, chunk = idx & 7;
                const v4u v = *(const LAS v4u*)(lds + AT_CK + row * 144 + chunk * 16);
                *(v4u*)(mixed + ((size_t)b * SEQ + T0 + (row >> 2)) * DM + (4 * g + (row & 3)) * 64 + chunk * 8) = v; }
            __syncthreads();
        }
    }
}

__device__ __forceinline__ void phase8b(const Args& a) {
    unsigned char* ws = a.ws;
    const float* gtail = (const float*)(ws + WS_GTAIL); const float* ghead = (const float*)(ws + WS_GHEAD); const float* uhead = (const float*)(ws + WS_UHEAD);
    const float* cw = a.in[24]; bf16* H = (bf16*)(ws + WS_H);
    for (int e = blockIdx.x * NTHREADS + threadIdx.x; e < 128 * DFF; e += gridDim.x * NTHREADS) {
        const int pm = e / DFF, ch = e % DFF;
        float t0 = 0.f, t1 = 0.f;
        if (pm & 15) { t0 = gtail[((size_t)(pm - 1) * 2 + 0) * DFF + ch]; t1 = gtail[((size_t)(pm - 1) * 2 + 1) * DFF + ch]; }
        const float g0 = ghead[((size_t)pm * 2 + 0) * DFF + ch], g1 = ghead[((size_t)pm * 2 + 1) * DFF + ch];
        const float u0 = uhead[((size_t)pm * 2 + 0) * DFF + ch], u1 = uhead[((size_t)pm * 2 + 1) * DFF + ch];
        const float w0 = cw[ch], w1 = cw[DFF + ch], w2 = cw[2 * DFF + ch];
        H[((size_t)pm * 256 + 0) * DFF + ch] = (bf16)f2bf(silu_f(w0 * t0 + w1 * t1 + w2 * g0) * u0);
        H[((size_t)pm * 256 + 1) * DFF + ch] = (bf16)f2bf(silu_f(w0 * t1 + w1 * g0 + w2 * g1) * u1);
    }
}

__global__ void __launch_bounds__(NTHREADS) nsa_layer_fwd(Args a) {
    extern __shared__ __attribute__((aligned(16))) unsigned char smem[];
    LAS unsigned char* lds = (LAS unsigned char*)smem;
    cg::grid_group grid = cg::this_grid();
    unsigned char* ws = a.ws;
    const int G = gridDim.x, c = blockIdx.x;
    const float* mod = (const float*)(ws + WS_MOD);

    if (threadIdx.x < 2) ((volatile LAS unsigned*)(lds + XB_LDS_OFF))[threadIdx.x] = 0u;
    __syncthreads();
    const XcdBarrier xbar = xcd_barrier_post((unsigned*)(ws + WS_BAR), (volatile LAS unsigned*)(lds + XB_LDS_OFF));
    if (a.ws == nullptr) grid.sync();
    phase0(a, lds);
    xcd_barrier(xbar);
    norm_rows(a.in[0], a.in[4], mod, 0, 1024, (bf16*)(ws + WS_XN));
    weight_copies(a, lds);
    xcd_barrier(xbar);
    {
        pg8::Gemm g{(const bf16*)(ws + WS_XN), (const bf16*)(ws + WS_BT_IN), MTOK, NINP, 1024, 1024};
        pg8::StaticOrder S; S.init(MTOK, NINP, G, c);
        EpiProj E{(bf16*)(ws + WS_PROJ), (bf16*)(ws + WS_QN), (bf16*)(ws + WS_KSN), (bf16*)(ws + WS_KWN), (float*)(ws + WS_GATES), a.in[7], a.in[9], a.in[10], a.in[6]};
        pg8::gemm_phase<EpiProj, pg8::StaticOrder, true, true>(lds, g, S, E);
    }
    xcd_barrier(xbar);
    if (c < 32) {
        pg8::Gemm g{(const bf16*)(ws + WS_PROJ), (const bf16*)(ws + WS_BT_C1), 4096, 256, 2048, 1024};
        CmpOrder S{c, (const bf16*)(ws + WS_PROJ), (const bf16*)(ws + WS_BT_C1)};
        EpiCmp E{(float*)(ws + WS_HID), (const float*)(ws + WS_BIAS1)};
        pg8::gemm_phase<EpiCmp, CmpOrder, true, true>(lds, g, S, E);
    } else {
        phase3_prep(a, lds, (c - 32) * NWAVES + (int)(threadIdx.x >> 6), (G - 32) * NWAVES);
    }
    xcd_barrier(xbar);
    phase4(a, lds);
    xcd_barrier(xbar);
    phase5(a, lds);
    xcd_barrier(xbar);
    {
        pg8::Gemm g{(const bf16*)(ws + WS_MIXED), (const bf16*)(ws + WS_BT_OUT), MTOK, 1024, 1024, 1024};
        pg8::StaticOrder S; S.init(MTOK, 1024, G, c);
        EpiResB E{a.in[0], (bf16*)(ws + WS_X1B), mod, 2048};
        pg8::gemm_phase<EpiResB, pg8::StaticOrder, true, true>(lds, g, S, E);
    }
    xcd_barrier(xbar);
    norm_rows_b((const bf16*)(ws + WS_X1B), a.in[21], mod, 3072, 4096, (bf16*)(ws + WS_XN));
    xcd_barrier(xbar);
    {
        pg8::Gemm g{(const bf16*)(ws + WS_XN), (const bf16*)(ws + WS_BT_GU), MTOK, NGU, 1024, 1024};
        pg8::StaticOrder S; S.init(MTOK, NGU, G, c);
        EpiFfn E{(bf16*)(ws + WS_H), a.in[24], (float*)(ws + WS_GTAIL), (float*)(ws + WS_GHEAD), (float*)(ws + WS_UHEAD), (LAS float*)(lds + HB_OFF)};
        pg8::gemm_phase<EpiFfn, pg8::StaticOrder, true, true>(lds, g, S, E);
    }
    xcd_barrier(xbar);
    phase8b(a);
    xcd_barrier(xbar);
    {
        pg8::Gemm g{(const bf16*)(ws + WS_H), (const bf16*)(ws + WS_BT_DN), MTOK, 1024, DFF, DFF};
        pg8::StaticOrder S; S.init(MTOK, 1024, G, c);
        EpiResF E{(const bf16*)(ws + WS_X1B), a.out, mod, 5120};
        pg8::gemm_phase<EpiResF, pg8::StaticOrder, true, true>(lds, g, S, E);
    }
}

extern "C" void kernel_launch(void* const* d_in, const int* in_sizes, int n_in, void* d_out, int out_size, void* d_ws, size_t ws_size, hipStream_t stream) {
    static int grid = 0;
    if (grid == 0) {
        if (n_in != 26 || out_size != MTOK * DM || ws_size < WS_END) { fprintf(stderr, "kernel_launch: unexpected problem (n_in %d, out %d, ws %zu)\n", n_in, out_size, ws_size); grid = -1; return; }
        int dev = 0, cus = 0, per_cu = 0;
        (void)hipGetDevice(&dev);
        (void)hipDeviceGetAttribute(&cus, hipDeviceAttributeMultiprocessorCount, dev);
        if (hipFuncSetAttribute((const void*)nsa_layer_fwd, hipFuncAttributeMaxDynamicSharedMemorySize, LDS_BYTES) != hipSuccess) { fprintf(stderr, "kernel_launch: hipFuncSetAttribute failed\n"); grid = -1; return; }
        if (hipOccupancyMaxActiveBlocksPerMultiprocessor(&per_cu, (const void*)nsa_layer_fwd, NTHREADS, LDS_BYTES) != hipSuccess || per_cu < 1) { fprintf(stderr, "kernel_launch: occupancy query says %d\n", per_cu); per_cu = 1; }
        (void)hipGetLastError();
        grid = cus * per_cu;
        if (grid > 1024) grid = 1024;
    }
    if (grid < 0) return;
    if (hipMemsetAsync((char*)d_ws + WS_BAR, 0, BAR_BYTES, stream) != hipSuccess) { fprintf(stderr, "kernel_launch: memset of the barrier words failed\n"); return; }
    Args a{};
    for (int i = 0; i < 26; ++i) a.in[i] = (const float*)d_in[i];
    a.out = (float*)d_out; a.ws = (unsigned char*)d_ws;
    void* args[] = {&a};
    hipError_t e = hipLaunchCooperativeKernel((const void*)nsa_layer_fwd, dim3(grid), dim3(NTHREADS), args, LDS_BYTES, stream);
    if (e != hipSuccess) fprintf(stderr, "cooperative launch failed: %s (grid %d)\n", hipGetErrorString(e), grid);
}
```

```cpp
#include <hip/hip_runtime.h>
#include <hip/hip_cooperative_groups.h>
#include <cstdio>
#include <cstdint>
namespace cg = cooperative_groups;

namespace pg8 {
#define PG8_LAS __attribute__((address_space(3)))
typedef unsigned short bf16_t;
typedef short bf16x8 __attribute__((ext_vector_type(8)));
typedef float f32x4 __attribute__((ext_vector_type(4)));
typedef unsigned u32x4 __attribute__((ext_vector_type(4)));
constexpr int BM = 256, BK = 64, HALF = 128, HTB = HALF * BK * 2, STAGE_BYTES = 8 * HTB, NXCD = 8, WGM = 8;

__host__ __device__ __forceinline__ int lds_byte(int r, int c) { const int st = (r >> 4) * 2 + (c >> 5), rr = r & 15, cc = c & 31, ob = rr * 64 + cc * 2; return st * 1024 + (ob ^ (((ob >> 9) & 1) << 5)); }
__host__ __device__ __forceinline__ void stage_rc(int b, int& R, int& C) { const int st = b / 1024, sb = b % 1024, swz = sb ^ (((sb >> 9) & 1) << 5); R = (st >> 1) * 16 + swz / 64; C = (st & 1) * 32 + (swz % 64) / 2; }
__host__ __device__ __forceinline__ int perm32(int rho) { const int n = rho >> 4, i = rho & 15; return 8 * (i >> 2) + 4 * n + (i & 3); }

struct Unit { int pm, pn; };
struct Gemm { const bf16_t* A; const bf16_t* Bt; int M, N, K, lda; };

struct StaticOrder {
    int nM, nN, nwg, G, c;
    __device__ void init(int M, int N, int G_, int c_) { nM = M / BM; nN = N / BM; nwg = nM * nN; G = G_; c = c_; }
    __device__ bool next(int i, Unit& u) const {
        const long L = (long)i * G + c; if (L >= nwg) return false;
        int wgid = (int)L; { const int q = nwg / NXCD, r = nwg % NXCD, xcd = wgid % NXCD, off = wgid / NXCD; wgid = (xcd < r ? xcd * (q + 1) : r * (q + 1) + (xcd - r) * q) + off; }
        const int nig = WGM * nN, gid = wgid / nig, fm = gid * WGM, gsz = (nM - fm) < WGM ? (nM - fm) : WGM;
        u.pm = fm + ((wgid % nig) % gsz); u.pn = (wgid % nig) / gsz; return true;
    }
    __device__ __forceinline__ const char* a_ptr(const Gemm& g, const Unit& u) const { return (const char*)g.A + (size_t)u.pm * (size_t)(BM * 2) * (size_t)g.lda; }
    __device__ __forceinline__ const char* b_ptr(const Gemm& g, const Unit& u) const { return (const char*)g.Bt + (size_t)u.pn * (size_t)(BM * 2) * (size_t)g.K; }
    __device__ __forceinline__ void a_ready(const Unit&) const {}
    __device__ __forceinline__ void done(const Unit&) const {}
};

template <class Epi, class Sched, bool ALIGN_EPI = false, bool SP2 = false>
__device__ __forceinline__ void gemm_phase(PG8_LAS unsigned char* lds, const Gemm g, const Sched& S, const Epi& E) {
    int tid_ = threadIdx.x; asm volatile("" : "+v"(tid_));
    const int tid = tid_, wid = __builtin_amdgcn_readfirstlane(tid >> 6), lane = tid & 63, wr = wid >> 2, wc = wid & 3, fr = lane & 15, fq = lane >> 4;
    const int K = g.K, nt = K / BK;
    unsigned voffA[2], voffB[2];
#pragma unroll
    for (int i = 0; i < 2; ++i) { int R, C; stage_rc(tid * 16 + i * 8192, R, C); const int Rb = Epi::PERM2 ? (64 * (R >> 5) + perm32(R & 31)) : (Epi::PERM ? ((R & ~31) + perm32(R & 31)) : R);
        voffA[i] = (unsigned)(R * g.lda + C) * 2u; voffB[i] = (unsigned)(Rb * K + C) * 2u; }
    const size_t kstep = (size_t)(BK * 2);
    const size_t hsA = (size_t)HALF * g.lda * 2, hsB = (size_t)(Epi::PERM2 ? 32 : HALF) * K * 2;
    const unsigned ldsw = (unsigned)wid * 1024u;
    const int aoff = lds_byte(wr * 64 + fr, fq * 8), boff = lds_byte(wc * 32 + fr, fq * 8);
#define PG8_SA(b, h) (((b) * 2 + (h)) * HTB)
#define PG8_SB(b, h) ((4 + (b) * 2 + (h)) * HTB)
#define PG8_STAGE(bufoff, gbase, voff) do { _Pragma("unroll") for (int _i = 0; _i < 2; ++_i) \
        __builtin_amdgcn_global_load_lds((const unsigned*)((const char*)(gbase) + (voff)[_i]), (PG8_LAS unsigned*)(lds + (bufoff) + ldsw + _i * 8192), 16, 0, 0); } while (0)
#define PG8_LDA(dst, b, h) do { _Pragma("unroll") for (int m = 0; m < 4; ++m) _Pragma("unroll") for (int k = 0; k < 2; ++k) dst[m][k] = *(const PG8_LAS bf16x8*)(lds + PG8_SA(b, h) + aoff + m * 2048 + k * 1024); } while (0)
#define PG8_LDB(dst, b, h) do { _Pragma("unroll") for (int n = 0; n < 2; ++n) _Pragma("unroll") for (int k = 0; k < 2; ++k) dst[n][k] = *(const PG8_LAS bf16x8*)(lds + PG8_SB(b, h) + boff + n * 2048 + k * 1024); } while (0)
#define PG8_MMA(ai, bj, At, Bt) do { __builtin_amdgcn_s_setprio(1); _Pragma("unroll") for (int m = 0; m < 4; ++m) _Pragma("unroll") for (int n = 0; n < 2; ++n) _Pragma("unroll") for (int k = 0; k < 2; ++k) \
        acc[ai][bj][m][n] = __builtin_amdgcn_mfma_f32_16x16x32_bf16(Bt[n][k], At[m][k], acc[ai][bj][m][n], 0, 0, 0); __builtin_amdgcn_s_setprio(0); } while (0)
#define PG8_WAIT_V(n) asm volatile("s_waitcnt vmcnt(" #n ")" ::: "memory")
#define PG8_WAIT_L(n) asm volatile("s_waitcnt lgkmcnt(" #n ")" ::: "memory")
#define PG8_BAR __builtin_amdgcn_s_barrier()
#define PG8_SCHED __builtin_amdgcn_sched_barrier(0)
    Unit cur, nxt; int ui = 0;
    if (!S.next(0, cur)) return;
    f32x4 acc[2][2][4][2];
#pragma unroll
    for (int a = 0; a < 2; ++a)
#pragma unroll
        for (int b = 0; b < 2; ++b)
#pragma unroll
            for (int m = 0; m < 4; ++m)
#pragma unroll
                for (int n = 0; n < 2; ++n) acc[a][b][m][n] = (f32x4){0.f, 0.f, 0.f, 0.f};
    bf16x8 At[4][2], B0[2][2], B1[2][2];
    const char* cA = S.a_ptr(g, cur); const char* cB = S.b_ptr(g, cur);
    S.a_ready(cur);
    if constexpr (SP2) {
        PG8_STAGE(PG8_SB(0, 0), cB, voffB); PG8_STAGE(PG8_SB(0, 1), cB + hsB, voffB); PG8_STAGE(PG8_SA(0, 0), cA, voffA); PG8_STAGE(PG8_SA(0, 1), cA + hsA, voffA);
        if (wr == 1) PG8_BAR;
        PG8_WAIT_V(2); PG8_BAR;
        PG8_STAGE(PG8_SB(1, 0), cB + kstep, voffB); PG8_STAGE(PG8_SA(1, 0), cA + kstep, voffA); PG8_STAGE(PG8_SB(1, 1), cB + hsB + kstep, voffB);
        PG8_WAIT_V(6); PG8_BAR;
    } else {
        PG8_STAGE(PG8_SB(0, 0), cB, voffB); PG8_STAGE(PG8_SA(0, 0), cA, voffA); PG8_STAGE(PG8_SB(0, 1), cB + hsB, voffB); PG8_STAGE(PG8_SA(0, 1), cA + hsA, voffA);
        if (wr == 1) PG8_BAR;
        PG8_WAIT_V(4); PG8_BAR;
        PG8_STAGE(PG8_SB(1, 0), cB + kstep, voffB); PG8_STAGE(PG8_SA(1, 0), cA + kstep, voffA); PG8_STAGE(PG8_SB(1, 1), cB + hsB + kstep, voffB);
        PG8_WAIT_V(6); PG8_BAR;
    }
    for (;;) {
        const bool has_next = S.next(ui + 1, nxt);
        const char* nA = has_next ? S.a_ptr(g, nxt) : cA; const char* nB = has_next ? S.b_ptr(g, nxt) : cB;
        for (int t = 0; t < nt; t += 2) {
            const bool last = (t == nt - 2);
            const char* a1 = cA + (size_t)(t + 1) * kstep;
            const char* a2 = last ? nA : cA + (size_t)(t + 2) * kstep; const char* b2 = last ? nB : cB + (size_t)(t + 2) * kstep;
            const char* a3 = a2 + kstep; const char* b3 = b2 + kstep;
            if (last && has_next) S.a_ready(nxt);
            if constexpr (SP2) {
            PG8_LDB(B0, 0, 0); PG8_LDB(B1, 0, 1); PG8_SCHED; PG8_LDA(At, 0, 0); PG8_STAGE(PG8_SA(1, 1), a1 + hsA, voffA);
            PG8_WAIT_V(8); PG8_WAIT_L(0); PG8_BAR; PG8_MMA(0, 0, At, B0); PG8_MMA(0, 1, At, B1); PG8_BAR; PG8_SCHED;
            PG8_LDA(At, 0, 1); PG8_STAGE(PG8_SB(0, 0), b2, voffB); PG8_STAGE(PG8_SB(0, 1), b2 + hsB, voffB); PG8_STAGE(PG8_SA(0, 0), a2, voffA);
            PG8_WAIT_V(8); PG8_WAIT_L(0); PG8_BAR; PG8_MMA(1, 0, At, B0); PG8_MMA(1, 1, At, B1); PG8_BAR; PG8_SCHED;
            PG8_LDB(B0, 1, 0); PG8_LDB(B1, 1, 1); PG8_SCHED; PG8_LDA(At, 1, 0); PG8_STAGE(PG8_SA(0, 1), a2 + hsA, voffA);
            PG8_WAIT_V(8); PG8_WAIT_L(0); PG8_BAR; PG8_MMA(0, 0, At, B0); PG8_MMA(0, 1, At, B1); PG8_BAR; PG8_SCHED;
            PG8_LDA(At, 1, 1); PG8_STAGE(PG8_SB(1, 0), b3, voffB); PG8_STAGE(PG8_SB(1, 1), b3 + hsB, voffB); PG8_STAGE(PG8_SA(1, 0), a3, voffA);
            PG8_WAIT_V(8); PG8_WAIT_L(0); PG8_BAR; PG8_MMA(1, 0, At, B0); PG8_MMA(1, 1, At, B1); PG8_BAR; PG8_SCHED;
            } else {
            PG8_LDB(B0, 0, 0); PG8_SCHED; PG8_LDA(At, 0, 0); PG8_STAGE(PG8_SA(1, 1), a1 + hsA, voffA);
            PG8_WAIT_L(8); PG8_BAR; PG8_WAIT_L(0); PG8_MMA(0, 0, At, B0); PG8_BAR; PG8_SCHED;
            PG8_LDB(B1, 0, 1); PG8_STAGE(PG8_SB(0, 0), b2, voffB);
            PG8_BAR; PG8_WAIT_L(0); PG8_MMA(0, 1, At, B1); PG8_BAR;
            PG8_LDA(At, 0, 1); PG8_STAGE(PG8_SA(0, 0), a2, voffA);
            PG8_BAR; PG8_WAIT_L(0); PG8_MMA(1, 0, At, B0); PG8_BAR; PG8_SCHED;
            PG8_STAGE(PG8_SB(0, 1), b2 + hsB, voffB);
            PG8_WAIT_V(6); PG8_BAR; PG8_MMA(1, 1, At, B1); PG8_BAR;
            PG8_LDB(B0, 1, 0); PG8_SCHED; PG8_LDA(At, 1, 0); PG8_STAGE(PG8_SA(0, 1), a2 + hsA, voffA);
            PG8_WAIT_L(8); PG8_BAR; PG8_WAIT_L(0); PG8_MMA(0, 0, At, B0); PG8_BAR; PG8_SCHED;
            PG8_LDB(B1, 1, 1); PG8_STAGE(PG8_SB(1, 0), b3, voffB);
            PG8_BAR; PG8_WAIT_L(0); PG8_MMA(0, 1, At, B1); PG8_BAR;
            PG8_LDA(At, 1, 1); PG8_STAGE(PG8_SA(1, 0), a3, voffA);
            PG8_BAR; PG8_WAIT_L(0); PG8_MMA(1, 0, At, B0); PG8_BAR; PG8_SCHED;
            PG8_STAGE(PG8_SB(1, 1), b3 + hsB, voffB);
            PG8_WAIT_V(6); PG8_BAR; PG8_MMA(1, 1, At, B1); PG8_BAR;
            }
        }
        if constexpr (ALIGN_EPI) { if (wr == 0) PG8_BAR; }
        if constexpr (!Epi::AFTER_DRAIN) { E(acc, cur, wr, wc, fr, fq); S.done(cur); }
        if (!has_next) break;
#pragma unroll
        for (int a = 0; a < 2; ++a)
#pragma unroll
            for (int b = 0; b < 2; ++b)
#pragma unroll
                for (int m = 0; m < 4; ++m)
#pragma unroll
                    for (int n = 0; n < 2; ++n) acc[a][b][m][n] = (f32x4){0.f, 0.f, 0.f, 0.f};
        cur = nxt; cA = nA; cB = nB; ++ui;
        if constexpr (ALIGN_EPI) { if (wr == 1) PG8_BAR; }
    }
    PG8_WAIT_V(0);
    if constexpr (!ALIGN_EPI) { if (wr == 0) PG8_BAR; }
    PG8_BAR;
    if constexpr (Epi::AFTER_DRAIN) { E.fused(acc, cur, wr, wc, fr, fq, lds, wid, lane); S.done(cur); }
#undef PG8_SA
#undef PG8_SB
#undef PG8_STAGE
#undef PG8_LDA
#undef PG8_LDB
#undef PG8_MMA
#undef PG8_WAIT_V
#undef PG8_WAIT_L
#undef PG8_BAR
#undef PG8_SCHED
}
}


#define LAS __attribute__((address_space(3)))
typedef unsigned short bf16;
typedef unsigned v4u __attribute__((ext_vector_type(4)));
typedef unsigned v2u __attribute__((ext_vector_type(2)));
typedef float f32x4 __attribute__((ext_vector_type(4)));
typedef float f32x2 __attribute__((ext_vector_type(2)));
typedef float f32x16 __attribute__((ext_vector_type(16)));
typedef short bf16x8 __attribute__((ext_vector_type(8)));
typedef short s16x4 __attribute__((ext_vector_type(4)));
typedef __bf16 bf16x2_t __attribute__((ext_vector_type(2)));

constexpr int NB = 8, SEQ = 4096, DM = 1024, MTOK = NB * SEQ;
constexpr int NIN = 2840, NINP = 3072, NSEG = NINP / 64, DFF = 2816, NGU = 2 * DFF;
constexpr float EPS = 1e-6f;
constexpr float LOG2E = 1.4426950408889634f;
constexpr int NTHREADS = 512, NWAVES = 8;
constexpr int LDS_BYTES = 147456 + 256;
constexpr int XB_LDS_OFF = 147456;
constexpr int HB_OFF = 131072;

constexpr size_t MiB = 1u << 20;
constexpr size_t WS_MOD = 0, WS_BIAS1 = 256 * 1024, WS_BAR = 512 * 1024, BAR_BYTES = 16384;
constexpr size_t WS_BT_IN = 1 * MiB, WS_BT_OUT = 7 * MiB, WS_BT_GU = 9 * MiB, WS_BT_DN = 20 * MiB, WS_BT_C1 = 26 * MiB;
constexpr size_t WS_HID = 28 * MiB, WS_KCN = 36 * MiB, WS_VCT = 36 * MiB + 512 * 1024, WS_GATES = 37 * MiB;
constexpr size_t WS_GTAIL = 40 * MiB, WS_GHEAD = 43 * MiB, WS_UHEAD = 46 * MiB;
constexpr size_t WS_KSN = 50 * MiB, WS_KWN = 58 * MiB, WS_VST = 66 * MiB, WS_VWT = 74 * MiB, WS_QN = 82 * MiB;
constexpr size_t WS_X1B = 50 * MiB;
constexpr size_t WS_XN = 114 * MiB, WS_MIXED = 178 * MiB, WS_PROJ = 242 * MiB, WS_H = WS_PROJ, WS_END = 434 * MiB;

struct Args { const float* in[26]; float* out; unsigned char* ws; };

#define LDS_WAIT() asm volatile("s_waitcnt lgkmcnt(0)" ::: "memory")
__device__ __forceinline__ unsigned f2bf(float f) { unsigned u = __builtin_bit_cast(unsigned, f); return (u + 0x7fffu + ((u >> 16) & 1u)) >> 16; }
__device__ __forceinline__ unsigned pk2(float lo, float hi) { f32x2 v = {lo, hi}; bf16x2_t b = __builtin_convertvector(v, bf16x2_t); return __builtin_bit_cast(unsigned, b); }
__device__ __forceinline__ float bf2f(unsigned short h) { return __builtin_bit_cast(float, (unsigned)h << 16); }
__device__ __forceinline__ float bflo(unsigned w) { return __builtin_bit_cast(float, w << 16); }
__device__ __forceinline__ float bfhi(unsigned w) { return __builtin_bit_cast(float, w & 0xffff0000u); }
__device__ __forceinline__ float wave_sum(float v) {
#pragma unroll
    for (int o = 1; o < 64; o <<= 1) v += __shfl_xor(v, o);
    return v;
}
__device__ __forceinline__ float silu_f(float x) { return x * __builtin_amdgcn_rcpf(1.0f + __builtin_amdgcn_exp2f(-LOG2E * x)); }
__device__ __forceinline__ float gelu_tanh_f(float x) { const float y = 0.7978845608028654f * (x + 0.044715f * x * x * x); const float t = 1.0f - 2.0f * __builtin_amdgcn_rcpf(__builtin_amdgcn_exp2f(2.0f * LOG2E * y) + 1.0f); return 0.5f * x * (1.0f + t); }

#define XB_TMO      128
#define XB_XCNT(j)  (256  + 64 * (j))
#define XB_XSUB(j)  (1280 + 64 * (j))
#define XB_XGEN(j)  (2304 + 64 * (j))
#define XB_TOP      3328
#define XB_TOPGEN   3392
#define XCD_BAR_WORDS 3456
#define XB_SPIN_CAP (1u << 18)

__device__ __forceinline__ unsigned xb_ld(unsigned* p)              { return __hip_atomic_load(p, __ATOMIC_RELAXED, __HIP_MEMORY_SCOPE_AGENT); }
__device__ __forceinline__ unsigned xb_add(unsigned* p, unsigned v) { return __hip_atomic_fetch_add(p, v, __ATOMIC_RELAXED, __HIP_MEMORY_SCOPE_AGENT); }
__device__ __forceinline__ unsigned xb_xcc_id() { return (unsigned)__builtin_amdgcn_s_getreg((3 << 11) | 20) & 0xFu; }
#define XB_SPIN(cond, bar) do { unsigned _sp = 0; while (cond) { __builtin_amdgcn_s_sleep(1); \
    if ((++_sp & 255u) == 0u) { if (xb_ld(&(bar)[XB_TMO])) break; if (_sp > XB_SPIN_CAP) { atomicAdd(&(bar)[XB_TMO], 1u); break; } } } } while (0)

struct XcdBarrier {
    unsigned* bar; unsigned x;
    volatile LAS unsigned* st;
};

__device__ __forceinline__ XcdBarrier xcd_barrier_post(unsigned* bar, volatile LAS unsigned* st) {
    XcdBarrier b; b.bar = bar; b.x = xb_xcc_id(); b.st = st;
    if (threadIdx.x == 0) (void)xb_add(&bar[XB_XCNT(b.x)], 1u);
    return b;
}
__device__ __forceinline__ void xcd_barrier_complete(unsigned* bar, unsigned x, unsigned& nloc, unsigned& nx) {
    const unsigned G = gridDim.x * gridDim.y * gridDim.z;
    unsigned sum, cnt, mine, sp = 0u;
    for (;;) {
        sum = 0u; cnt = 0u; mine = 0u;
#pragma unroll
        for (unsigned j = 0; j < 16; ++j) { const unsigned c = xb_ld(&bar[XB_XCNT(j)]); sum += c; cnt += (c > 0u) ? 1u : 0u; mine = (j == x) ? c : mine; }
        if (sum == G) break;
        __builtin_amdgcn_s_sleep(1);
        if ((++sp & 255u) == 0u) { if (xb_ld(&bar[XB_TMO])) break; if (sp > XB_SPIN_CAP) { atomicAdd(&bar[XB_TMO], 1u); break; } }
    }
    nloc = mine > 0u ? mine : 1u; nx = cnt > 0u ? cnt : 1u;
}

__device__ __forceinline__ void xcd_barrier(const XcdBarrier& b) {
    asm volatile("s_waitcnt vmcnt(0)" ::: "memory");
    __syncthreads();
    if (threadIdx.x == 0) {
        unsigned* bar = b.bar;
        __builtin_amdgcn_s_waitcnt(0);
        unsigned nloc = b.st[0], nx = b.st[1];
        if (nloc == 0u) { xcd_barrier_complete(bar, b.x, nloc, nx); b.st[0] = nloc; b.st[1] = nx; }
        const unsigned old = xb_add(&bar[XB_XSUB(b.x)], 1u);
        const unsigned gen = old / nloc;
        if (old + 1u == (gen + 1u) * nloc) {
            __builtin_amdgcn_fence(__ATOMIC_RELEASE, "agent");
            asm volatile("s_waitcnt vmcnt(0)" ::: "memory");
            const unsigned og = xb_add(&bar[XB_TOP], 1u);
            const unsigned tg = og / nx;
            if (og + 1u == (tg + 1u) * nx) xb_add(&bar[XB_TOPGEN], 1u);
            else XB_SPIN(xb_ld(&bar[XB_TOPGEN]) == tg, bar);
            __builtin_amdgcn_fence(__ATOMIC_ACQUIRE, "agent");
            xb_add(&bar[XB_XGEN(b.x)], 1u);
            asm volatile("s_waitcnt vmcnt(0)" ::: "memory");
        } else {
            XB_SPIN(xb_ld(&bar[XB_XGEN(b.x)]) == gen, bar);
            __builtin_amdgcn_fence(__ATOMIC_ACQUIRE, "agent");
            asm volatile("s_waitcnt vmcnt(0)" ::: "memory");
        }
    }
    __syncthreads();
}


__device__ __forceinline__ void transpose_item(const float* __restrict__ W, int K, int N, bf16* WT, int k0, int n0, int drow0, LAS float* scr, int lane) {
    const int nn = n0 + (lane & 31);
#pragma unroll 8
    for (int i = 0; i < 32; ++i) { const int kk = 2 * i + (lane >> 5); scr[kk * 33 + (lane & 31)] = (nn < N) ? W[(size_t)(k0 + kk) * N + nn] : 0.0f; }
    LDS_WAIT(); asm volatile("" ::: "memory");
    const int c = lane & 7;
#pragma unroll
    for (int j = 0; j < 4; ++j) { const int n = (lane >> 3) + 8 * j; const LAS float* s = scr + (8 * c) * 33 + n;
        v4u o; o.x = pk2(s[0 * 33], s[1 * 33]); o.y = pk2(s[2 * 33], s[3 * 33]); o.z = pk2(s[4 * 33], s[5 * 33]); o.w = pk2(s[6 * 33], s[7 * 33]);
        *(v4u*)(WT + (size_t)(drow0 + n) * K + k0 + 8 * c) = o; }
    LDS_WAIT(); asm volatile("" ::: "memory");
}

__device__ __forceinline__ void phase0(const Args& a, LAS unsigned char* lds) {
    int tid_ = threadIdx.x; asm volatile("" : "+v"(tid_)); const int tid = tid_, lane = tid & 63, wave = tid >> 6, G = gridDim.x;
    unsigned char* ws = a.ws;
    LAS float* SC = (LAS float*)lds;
    LAS float* RED = (LAS float*)(lds + 32768);
    float* mod = (float*)(ws + WS_MOD);
    float* bias1 = (float*)(ws + WS_BIAS1);
    for (int it = blockIdx.x; it < 208; it += G) {
        const int cl = tid & 31, sl = tid >> 5;
        if (it < 192) {
            const float* c = a.in[1]; const float* w_ada = a.in[2]; const float* b_ada = a.in[3];
            for (int i = tid; i < 8192; i += NTHREADS) { const float v = c[i]; SC[i] = silu_f(v); }
            __syncthreads();
            float acc[8];
#pragma unroll
            for (int b = 0; b < 8; ++b) acc[b] = 0.f;
            const int col = it * 32 + cl;
#pragma unroll 8
            for (int k = sl * 64; k < sl * 64 + 64; ++k) {
                const float w = w_ada[(size_t)k * 6144 + col];
#pragma unroll
                for (int b = 0; b < 8; ++b) acc[b] += SC[b * 1024 + k] * w;
            }
#pragma unroll
            for (int b = 0; b < 8; ++b) RED[(sl * 8 + b) * 32 + cl] = acc[b];
            __syncthreads();
            if (tid < 256) { const int b = tid >> 5; float s = 0.f;
#pragma unroll
              for (int w = 0; w < 16; ++w) s += RED[(w * 8 + b) * 32 + cl];
              mod[b * 6144 + it * 32 + cl] = s + b_ada[it * 32 + cl]; }
            __syncthreads();
        } else {
            const int q = it - 192, kv = q >> 3, cgp = q & 7;
            const float* pos = a.in[11 + kv]; const float* w1 = a.in[13 + 2 * kv];
            float acc = 0.f;
#pragma unroll 8
            for (int k = sl * 128; k < sl * 128 + 128; ++k) acc += pos[k] * w1[(size_t)k * 256 + cgp * 32 + cl];
            RED[sl * 32 + cl] = acc;
            __syncthreads();
            if (tid < 32) { float s = 0.f;
#pragma unroll
                for (int w = 0; w < 16; ++w) s += RED[w * 32 + tid];
                bias1[kv * 256 + cgp * 32 + tid] = s; }
            __syncthreads();
        }
    }
}

__device__ __forceinline__ void weight_copies(const Args& a, LAS unsigned char* lds) {
    int tid_ = threadIdx.x; asm volatile("" : "+v"(tid_)); const int tid = tid_, lane = tid & 63, wave = tid >> 6, G = gridDim.x;
    unsigned char* ws = a.ws;
    LAS float* scr = (LAS float*)(lds + 49152 + wave * 8448);
    const int gw = blockIdx.x * NWAVES + wave, NGW = G * NWAVES;
    constexpr int I_IN = 16 * 96, I_OUT = 16 * 32, I_G = 16 * 88, I_D = 44 * 32, I_C = 32 * 8;
    constexpr int TOT = I_IN + I_OUT + 2 * I_G + I_D + 2 * I_C;
    for (int it = gw; it < TOT; it += NGW) {
        int r = it;
        if (r < I_IN) { const int kb = r / 96, nb = r % 96; transpose_item(a.in[5], 1024, NIN, (bf16*)(ws + WS_BT_IN), 64 * kb, 32 * nb, 32 * nb, scr, lane); continue; } r -= I_IN;
        if (r < I_OUT) { const int kb = r / 32, nb = r % 32; transpose_item(a.in[20], 1024, 1024, (bf16*)(ws + WS_BT_OUT), 64 * kb, 32 * nb, 32 * nb, scr, lane); continue; } r -= I_OUT;
        if (r < I_G) { const int kb = r / 88, nb = r % 88, n0 = 32 * nb; transpose_item(a.in[22], 1024, DFF, (bf16*)(ws + WS_BT_GU), 64 * kb, n0, 256 * (n0 >> 7) + (n0 & 127), scr, lane); continue; } r -= I_G;
        if (r < I_G) { const int kb = r / 88, nb = r % 88, n0 = 32 * nb; transpose_item(a.in[23], 1024, DFF, (bf16*)(ws + WS_BT_GU), 64 * kb, n0, 256 * (n0 >> 7) + (n0 & 127) + 128, scr, lane); continue; } r -= I_G;
        if (r < I_D) { const int kb = r / 32, nb = r % 32; transpose_item(a.in[25], DFF, 1024, (bf16*)(ws + WS_BT_DN), 64 * kb, 32 * nb, 32 * nb, scr, lane); continue; } r -= I_D;
        if (r < I_C) { const int kb = r / 8, nb = r % 8; transpose_item(a.in[13], 2048, 256, (bf16*)(ws + WS_BT_C1), 64 * kb, 32 * nb, 32 * nb, scr, lane); continue; } r -= I_C;
        { const int kb = r / 8, nb = r % 8; transpose_item(a.in[15], 2048, 256, (bf16*)(ws + WS_BT_C1) + 256 * 2048, 64 * kb, 32 * nb, 32 * nb, scr, lane); }
    }
}

__device__ __forceinline__ void norm_rows(const float* __restrict__ src, const float* __restrict__ gamma, const float* __restrict__ mod, int sh_off, int sc_off, bf16* dst) {
    int tid_ = threadIdx.x; asm volatile("" : "+v"(tid_)); const int tid = tid_, lane = tid & 63, wave = tid >> 6;
    const int gw = blockIdx.x * NWAVES + wave, NGW = gridDim.x * NWAVES;
    const int per = (MTOK + NGW - 1) / NGW;
    const int r0 = gw * per, r1 = (r0 + per) < MTOK ? (r0 + per) : MTOK;
    if (r0 >= r1) return;
    f32x4 ga[4], sh[4];
    int bcur = -1;
    f32x4 va[4], vb[4];
    { const f32x4* xr = (const f32x4*)(src + (size_t)r0 * DM) + lane;
#pragma unroll
      for (int j = 0; j < 4; ++j) va[j] = xr[64 * j]; }
    { const int rr = (r0 + 1 < r1) ? r0 + 1 : r0; const f32x4* xr = (const f32x4*)(src + (size_t)rr * DM) + lane;
#pragma unroll
      for (int j = 0; j < 4; ++j) vb[j] = xr[64 * j]; }
    for (int row = r0; row < r1; ++row) {
        f32x4 v[4];
#pragma unroll
        for (int j = 0; j < 4; ++j) { v[j] = va[j]; va[j] = vb[j]; }
        { const int rr = (row + 2 < r1) ? row + 2 : row; const f32x4* xr = (const f32x4*)(src + (size_t)rr * DM) + lane;
#pragma unroll
          for (int j = 0; j < 4; ++j) vb[j] = xr[64 * j]; }
        const int b = row >> 12;
        if (b != bcur) { bcur = b; const float* mb = mod + b * 6144;
#pragma unroll
            for (int j = 0; j < 4; ++j) { const int col = 4 * lane + 256 * j; const f32x4 gv = *(const f32x4*)(gamma + col), sc = *(const f32x4*)(mb + sc_off + col);
                sh[j] = *(const f32x4*)(mb + sh_off + col); ga[j] = gv * (1.0f + sc); } }
        float ss = 0.f;
#pragma unroll
        for (int j = 0; j < 4; ++j) ss += v[j][0] * v[j][0] + v[j][1] * v[j][1] + v[j][2] * v[j][2] + v[j][3] * v[j][3];
        ss = wave_sum(ss);
        const float rstd = rsqrtf(ss * (1.0f / DM) + EPS);
#pragma unroll
        for (int j = 0; j < 4; ++j) {
            const int col = 4 * lane + 256 * j;
            f32x4 y;
#pragma unroll
            for (int e = 0; e < 4; ++e) y[e] = (v[j][e] * rstd) * ga[j][e] + sh[j][e];
            v2u o; o.x = pk2(y[0], y[1]); o.y = pk2(y[2], y[3]);
            *(v2u*)(dst + (size_t)row * DM + col) = o;
        }
    }
}

__device__ __forceinline__ void norm_rows_b(const bf16* __restrict__ src, const float* __restrict__ gamma, const float* __restrict__ mod, int sh_off, int sc_off, bf16* dst) {
    int tid_ = threadIdx.x; asm volatile("" : "+v"(tid_)); const int tid = tid_, lane = tid & 63, wave = tid >> 6;
    const int gw = blockIdx.x * NWAVES + wave, NGW = gridDim.x * NWAVES;
    const int per = (MTOK + NGW - 1) / NGW;
    const int r0 = gw * per, r1 = (r0 + per) < MTOK ? (r0 + per) : MTOK;
    if (r0 >= r1) return;
    f32x4 ga[4], sh[4];
    int bcur = -1;
    v4u va[2], vb[2];
    { const v4u* xr = (const v4u*)(src + (size_t)r0 * DM) + lane; va[0] = xr[0]; va[1] = xr[64]; }
    { const int rr = (r0 + 1 < r1) ? r0 + 1 : r0; const v4u* xr = (const v4u*)(src + (size_t)rr * DM) + lane; vb[0] = xr[0]; vb[1] = xr[64]; }
    for (int row = r0; row < r1; ++row) {
        v4u raw[2]; raw[0] = va[0]; raw[1] = va[1]; va[0] = vb[0]; va[1] = vb[1];
        { const int rr = (row + 2 < r1) ? row + 2 : row; const v4u* xr = (const v4u*)(src + (size_t)rr * DM) + lane; vb[0] = xr[0]; vb[1] = xr[64]; }
        const int b = row >> 12;
        if (b != bcur) { bcur = b; const float* mb = mod + b * 6144;
#pragma unroll
            for (int j = 0; j < 4; ++j) { const int col = 512 * (j >> 1) + 8 * lane + 4 * (j & 1); const f32x4 gv = *(const f32x4*)(gamma + col), sc = *(const f32x4*)(mb + sc_off + col);
                sh[j] = *(const f32x4*)(mb + sh_off + col); ga[j] = gv * (1.0f + sc); } }
        f32x4 v[4];
#pragma unroll
        for (int h = 0; h < 2; ++h) { v[2 * h] = (f32x4){bflo(raw[h].x), bfhi(raw[h].x), bflo(raw[h].y), bfhi(raw[h].y)}; v[2 * h + 1] = (f32x4){bflo(raw[h].z), bfhi(raw[h].z), bflo(raw[h].w), bfhi(raw[h].w)}; }
        float ss = 0.f;
#pragma unroll
        for (int j = 0; j < 4; ++j) ss += v[j][0] * v[j][0] + v[j][1] * v[j][1] + v[j][2] * v[j][2] + v[j][3] * v[j][3];
        ss = wave_sum(ss);
        const float rstd = rsqrtf(ss * (1.0f / DM) + EPS);
#pragma unroll
        for (int h = 0; h < 2; ++h) {
            f32x4 y0, y1;
#pragma unroll
            for (int e = 0; e < 4; ++e) { y0[e] = (v[2 * h][e] * rstd) * ga[2 * h][e] + sh[2 * h][e]; y1[e] = (v[2 * h + 1][e] * rstd) * ga[2 * h + 1][e] + sh[2 * h + 1][e]; }
            v4u o; o.x = pk2(y0[0], y0[1]); o.y = pk2(y0[2], y0[3]); o.z = pk2(y1[0], y1[1]); o.w = pk2(y1[2], y1[3]);
            *(v4u*)(dst + (size_t)row * DM + 512 * h + 8 * lane) = o;
        }
    }
}

__device__ __forceinline__ float dpp_shr1(float v) { return __builtin_bit_cast(float, __builtin_amdgcn_update_dpp(0, __builtin_bit_cast(int, v), 0x111, 0xf, 0xf, true)); }
__device__ __forceinline__ float dpp_shr2(float v) { return __builtin_bit_cast(float, __builtin_amdgcn_update_dpp(0, __builtin_bit_cast(int, v), 0x112, 0xf, 0xf, true)); }
__device__ __forceinline__ unsigned dpp_ror8(unsigned v) { return (unsigned)__builtin_amdgcn_update_dpp(0, (int)v, 0x128, 0xf, 0xf, false); }
struct EpiProj {
    static constexpr bool PERM = true, PERM2 = true, AFTER_DRAIN = false;
    bf16* P; bf16* QN; bf16* KSN; bf16* KWN; float* gates; const float* gq; const float* gs; const float* gw; const float* bgate;
    __device__ __forceinline__ void operator()(const f32x4 (&acc)[2][2][4][2], const pg8::Unit& u, int wr, int wc, int fr, int fq) const {
        const bool lo = fr < 8;
        const int colb = u.pn * 256 + wc * 64, seg = colb >> 6, d = (lo ? 0 : 32) + 8 * fq;
        const bool keep = (colb + d) < NIN;
        const int rowb = u.pm * 256 + wr * 64 + (fr & 7);
        bf16* base = P; int ns = NSEG, sidx = seg; const float* gm = nullptr; float mult = 1.0f;
        if (seg < 8) { base = QN; ns = 8; gm = gq; mult = 0.125f * LOG2E; }
        else if (seg == 12 || seg == 13) { base = KSN; ns = 2; sidx = seg - 12; gm = gs; }
        else if (seg == 16 || seg == 17) { base = KWN; ns = 2; sidx = seg - 16; gm = gw; }
        f32x4 g00 = {1.f, 1.f, 1.f, 1.f}, g01 = g00, g10 = g00, g11 = g00;
        if (gm) { g00 = *(const f32x4*)(gm + 8 * fq); g01 = *(const f32x4*)(gm + 8 * fq + 4); g10 = *(const f32x4*)(gm + 32 + 8 * fq); g11 = *(const f32x4*)(gm + 32 + 8 * fq + 4); }
#pragma unroll
        for (int ai = 0; ai < 2; ++ai)
#pragma unroll
            for (int m = 0; m < 4; ++m) {
                f32x4 a0 = acc[ai][0][m][0], a1 = acc[ai][0][m][1], b0 = acc[ai][1][m][0], b1 = acc[ai][1][m][1];
                const int rown = u.pm * 256 + wr * 64 + ai * 128 + m * 16 + fr;
                if (gm) {
                    float ss = 0.f;
#pragma unroll
                    for (int e = 0; e < 4; ++e) ss += a0[e] * a0[e] + a1[e] * a1[e] + b0[e] * b0[e] + b1[e] * b1[e];
                    ss += __shfl_xor(ss, 16); ss += __shfl_xor(ss, 32);
                    const float rs = rsqrtf(ss * (1.0f / 64.0f) + EPS) * mult;
                    a0 = a0 * rs * g00; a1 = a1 * rs * g01; b0 = b0 * rs * g10; b1 = b1 * rs * g11;
                } else if (seg == 20 && fq < 3) {
                    const f32x4 bg0 = *(const f32x4*)(bgate + 8 * fq), bg1 = *(const f32x4*)(bgate + 8 * fq + 4);
                    f32x4 s0, s1;
#pragma unroll
                    for (int e = 0; e < 4; ++e) { s0[e] = __builtin_amdgcn_rcpf(1.0f + __builtin_amdgcn_exp2f(-LOG2E * (a0[e] + bg0[e]))); s1[e] = __builtin_amdgcn_rcpf(1.0f + __builtin_amdgcn_exp2f(-LOG2E * (a1[e] + bg1[e]))); }
                    *(f32x4*)(gates + (size_t)rown * 24 + 8 * fq) = s0; *(f32x4*)(gates + (size_t)rown * 24 + 8 * fq + 4) = s1;
                }
                v4u p0, p1; p0.x = pk2(a0[0], a0[1]); p0.y = pk2(a0[2], a0[3]); p0.z = pk2(a1[0], a1[1]); p0.w = pk2(a1[2], a1[3]);
                p1.x = pk2(b0[0], b0[1]); p1.y = pk2(b0[2], b0[3]); p1.z = pk2(b1[0], b1[1]); p1.w = pk2(b1[2], b1[3]);
                const unsigned sx = lo ? p1.x : p0.x, sy = lo ? p1.y : p0.y, sz = lo ? p1.z : p0.z, sw = lo ? p1.w : p0.w;
                v4u rc; rc.x = dpp_ror8(sx); rc.y = dpp_ror8(sy); rc.z = dpp_ror8(sz); rc.w = dpp_ror8(sw);
                v4u s1, s2;
                s1.x = lo ? p0.x : rc.x; s1.y = lo ? p0.y : rc.y; s1.z = lo ? p0.z : rc.z; s1.w = lo ? p0.w : rc.w;
                s2.x = lo ? rc.x : p1.x; s2.y = lo ? rc.y : p1.y; s2.z = lo ? rc.z : p1.z; s2.w = lo ? rc.w : p1.w;
                const int r = rowb + ai * 128 + m * 16, b = r >> 12, t = r & 4095;
                bf16* dst = base + ((size_t)(b * ns + sidx) * SEQ + t) * 64 + d;
                if (keep) { __builtin_nontemporal_store(s1, (v4u*)dst); __builtin_nontemporal_store(s2, (v4u*)(dst + 8 * 64)); }
            }
    }
};
struct EpiRes {
    static constexpr bool PERM = true, PERM2 = false, AFTER_DRAIN = false;
    const float* base; float* out; const float* mod; int goff;
    __device__ __forceinline__ void operator()(const f32x4 (&acc)[2][2][4][2], const pg8::Unit& u, int wr, int wc, int fr, int fq) const {
        const int row0 = u.pm * 256 + wr * 64 + fr, col0 = u.pn * 256 + wc * 32 + 8 * fq;
        const int b = (u.pm * 256) >> 12;
        f32x4 gv[2][2];
#pragma unroll
        for (int bj = 0; bj < 2; ++bj)
#pragma unroll
            for (int n = 0; n < 2; ++n) gv[bj][n] = *(const f32x4*)(mod + b * 6144 + goff + col0 + bj * 128 + n * 4);
#pragma unroll
        for (int ai = 0; ai < 2; ++ai) {
            f32x4 xv[4][2][2];
#pragma unroll
            for (int m = 0; m < 4; ++m) { const size_t r = (size_t)(row0 + ai * 128 + m * 16);
#pragma unroll
                for (int bj = 0; bj < 2; ++bj)
#pragma unroll
                    for (int n = 0; n < 2; ++n) xv[m][bj][n] = *(const f32x4*)(base + r * DM + col0 + bj * 128 + n * 4); }
#pragma unroll
            for (int m = 0; m < 4; ++m) { const size_t r = (size_t)(row0 + ai * 128 + m * 16);
#pragma unroll
                for (int bj = 0; bj < 2; ++bj)
#pragma unroll
                    for (int n = 0; n < 2; ++n) *(f32x4*)(out + r * DM + col0 + bj * 128 + n * 4) = xv[m][bj][n] + gv[bj][n] * acc[ai][bj][m][n]; }
        }
    }
};
struct EpiResB {
    static constexpr bool PERM = true, PERM2 = false, AFTER_DRAIN = false;
    const float* base; bf16* out; const float* mod; int goff;
    __device__ __forceinline__ void operator()(const f32x4 (&acc)[2][2][4][2], const pg8::Unit& u, int wr, int wc, int fr, int fq) const {
        const int row0 = u.pm * 256 + wr * 64 + fr, col0 = u.pn * 256 + wc * 32 + 8 * fq;
        const int b = (u.pm * 256) >> 12;
        f32x4 gv[2][2];
#pragma unroll
        for (int bj = 0; bj < 2; ++bj)
#pragma unroll
            for (int n = 0; n < 2; ++n) gv[bj][n] = *(const f32x4*)(mod + b * 6144 + goff + col0 + bj * 128 + n * 4);
#pragma unroll
        for (int ai = 0; ai < 2; ++ai) {
            f32x4 xv[4][2][2];
#pragma unroll
            for (int m = 0; m < 4; ++m) { const size_t r = (size_t)(row0 + ai * 128 + m * 16);
#pragma unroll
                for (int bj = 0; bj < 2; ++bj)
#pragma unroll
                    for (int n = 0; n < 2; ++n) xv[m][bj][n] = *(const f32x4*)(base + r * DM + col0 + bj * 128 + n * 4); }
#pragma unroll
            for (int m = 0; m < 4; ++m) { const size_t r = (size_t)(row0 + ai * 128 + m * 16);
#pragma unroll
                for (int bj = 0; bj < 2; ++bj) { const f32x4 v0 = xv[m][bj][0] + gv[bj][0] * acc[ai][bj][m][0], v1 = xv[m][bj][1] + gv[bj][1] * acc[ai][bj][m][1];
                    v4u w; w.x = pk2(v0[0], v0[1]); w.y = pk2(v0[2], v0[3]); w.z = pk2(v1[0], v1[1]); w.w = pk2(v1[2], v1[3]);
                    *(v4u*)(out + r * DM + col0 + bj * 128) = w; } }
        }
    }
};
struct EpiResF {
    static constexpr bool PERM = true, PERM2 = false, AFTER_DRAIN = false;
    const bf16* base; float* out; const float* mod; int goff;
    __device__ __forceinline__ void operator()(const f32x4 (&acc)[2][2][4][2], const pg8::Unit& u, int wr, int wc, int fr, int fq) const {
        const int row0 = u.pm * 256 + wr * 64 + fr, col0 = u.pn * 256 + wc * 32 + 8 * fq;
        const int b = (u.pm * 256) >> 12;
        f32x4 gv[2][2];
#pragma unroll
        for (int bj = 0; bj < 2; ++bj)
#pragma unroll
            for (int n = 0; n < 2; ++n) gv[bj][n] = *(const f32x4*)(mod + b * 6144 + goff + col0 + bj * 128 + n * 4);
#pragma unroll
        for (int ai = 0; ai < 2; ++ai) {
            v4u xv[4][2];
#pragma unroll
            for (int m = 0; m < 4; ++m) { const size_t r = (size_t)(row0 + ai * 128 + m * 16);
#pragma unroll
                for (int bj = 0; bj < 2; ++bj) xv[m][bj] = *(const v4u*)(base + r * DM + col0 + bj * 128); }
#pragma unroll
            for (int m = 0; m < 4; ++m) { const size_t r = (size_t)(row0 + ai * 128 + m * 16);
#pragma unroll
                for (int bj = 0; bj < 2; ++bj) { const v4u x = xv[m][bj];
                    const f32x4 x0 = {bflo(x.x), bfhi(x.x), bflo(x.y), bfhi(x.y)}, x1 = {bflo(x.z), bfhi(x.z), bflo(x.w), bfhi(x.w)};
                    *(f32x4*)(out + r * DM + col0 + bj * 128) = x0 + gv[bj][0] * acc[ai][bj][m][0];
                    *(f32x4*)(out + r * DM + col0 + bj * 128 + 4) = x1 + gv[bj][1] * acc[ai][bj][m][1]; } }
        }
    }
};
struct EpiCmp {
    static constexpr bool PERM = false, PERM2 = false, AFTER_DRAIN = false;
    float* hid; const float* bias1;
    __device__ __forceinline__ void operator()(const f32x4 (&acc)[2][2][4][2], const pg8::Unit& u, int wr, int wc, int fr, int fq) const {
        const int row0 = wr * 64 + fr, col0 = wc * 32 + 4 * fq;
        float* hb = hid + ((size_t)u.pn * 4096 + (size_t)u.pm * 256) * 256;
#pragma unroll
        for (int ai = 0; ai < 2; ++ai)
#pragma unroll
            for (int m = 0; m < 4; ++m) { const int r = row0 + ai * 128 + m * 16;
#pragma unroll
                for (int bj = 0; bj < 2; ++bj)
#pragma unroll
                    for (int n = 0; n < 2; ++n) { const int c = col0 + bj * 128 + n * 16;
                        const f32x4 bv = *(const f32x4*)(bias1 + u.pn * 256 + c); f32x4 v = acc[ai][bj][m][n] + bv;
#pragma unroll
                        for (int e = 0; e < 4; ++e) v[e] = gelu_tanh_f(v[e]);
                        *(f32x4*)(hb + (size_t)r * 256 + c) = v; } }
    }
};
struct CmpOrder {
    int c; const bf16* proj; const bf16* btc1;
    __device__ bool next(int i, pg8::Unit& u) const { if (i > 0 || c >= 32) return false; u.pm = c & 15; u.pn = c >> 4; return true; }
    __device__ __forceinline__ const char* a_ptr(const pg8::Gemm&, const pg8::Unit& u) const { const int b = u.pm >> 1, g = u.pm & 1; return (const char*)(proj + ((size_t)(b * NSEG + 8 + 2 * u.pn + g) * SEQ) * 64); }
    __device__ __forceinline__ const char* b_ptr(const pg8::Gemm&, const pg8::Unit& u) const { return (const char*)(btc1 + (size_t)u.pn * 256 * 2048); }
    __device__ __forceinline__ void a_ready(const pg8::Unit&) const {}
    __device__ __forceinline__ void done(const pg8::Unit&) const {}
};
struct EpiFfn {
    static constexpr bool PERM = true, PERM2 = false, AFTER_DRAIN = false;
    bf16* H; const float* cw; float* gtail; float* ghead; float* uhead; LAS float* hb;
    __device__ __forceinline__ void operator()(const f32x4 (&acc)[2][2][4][2], const pg8::Unit& u, int wr, int wc, int fr, int fq) const {
        int cl_ = wc * 32 + 8 * fq; asm volatile("" : "+v"(cl_));
        const int cl = cl_, ch0 = u.pn * 128 + cl;
        if (fr >= 14) {
#pragma unroll
            for (int ai = 0; ai < 2; ++ai)
#pragma unroll
                for (int m = 0; m < 4; ++m) { const int kk = 8 * ai + 4 * wr + m;
#pragma unroll
                    for (int n = 0; n < 2; ++n) *(LAS f32x4*)(hb + ((kk * 2 + (fr - 14)) * 128 + cl + 4 * n)) = acc[ai][0][m][n]; }
        }
        asm volatile("s_waitcnt lgkmcnt(0)" ::: "memory"); __builtin_amdgcn_s_barrier(); asm volatile("" ::: "memory");
        f32x4 w0[2], w1[2], w2[2];
#pragma unroll
        for (int n = 0; n < 2; ++n) { w0[n] = *(const f32x4*)(cw + ch0 + 4 * n); w1[n] = *(const f32x4*)(cw + DFF + ch0 + 4 * n); w2[n] = *(const f32x4*)(cw + 2 * DFF + ch0 + 4 * n); }
#pragma unroll
        for (int ai = 0; ai < 2; ++ai)
#pragma unroll
            for (int m = 0; m < 4; ++m) { const int kk = 8 * ai + 4 * wr + m; const int rl = 128 * ai + 64 * wr + 16 * m + fr; const size_t r = (size_t)u.pm * 256 + rl;
                f32x4 hv[2];
#pragma unroll
                for (int n = 0; n < 2; ++n) { const f32x4 g0 = acc[ai][0][m][n]; f32x4 g1, g2;
                    g1[0] = dpp_shr1(g0[0]); g1[1] = dpp_shr1(g0[1]); g1[2] = dpp_shr1(g0[2]); g1[3] = dpp_shr1(g0[3]);
                    g2[0] = dpp_shr2(g0[0]); g2[1] = dpp_shr2(g0[1]); g2[2] = dpp_shr2(g0[2]); g2[3] = dpp_shr2(g0[3]);
                    if (fr < 2) { const f32x4 z = {0.f, 0.f, 0.f, 0.f};
                        const f32x4 p15 = kk > 0 ? *(const LAS f32x4*)(hb + (((kk - 1) * 2 + 1) * 128 + cl + 4 * n)) : z;
                        const f32x4 p14 = kk > 0 ? *(const LAS f32x4*)(hb + (((kk - 1) * 2 + 0) * 128 + cl + 4 * n)) : z;
                        if (fr == 0) { g1 = p15; g2 = p14; } else { g2 = p15; } }
                    const f32x4 pre = w0[n] * g2 + w1[n] * g1 + w2[n] * g0; const f32x4 up = acc[ai][1][m][n];
#pragma unroll
                    for (int e = 0; e < 4; ++e) hv[n][e] = silu_f(pre[e]) * up[e];
                    if (kk == 0 && fr < 2) { *(f32x4*)(ghead + ((size_t)u.pm * 2 + fr) * DFF + ch0 + 4 * n) = g0; *(f32x4*)(uhead + ((size_t)u.pm * 2 + fr) * DFF + ch0 + 4 * n) = up; }
                    if (kk == 15 && fr >= 14) *(f32x4*)(gtail + ((size_t)u.pm * 2 + (fr - 14)) * DFF + ch0 + 4 * n) = g0;
                }
                v4u w; w.x = pk2(hv[0][0], hv[0][1]); w.y = pk2(hv[0][2], hv[0][3]); w.z = pk2(hv[1][0], hv[1][1]); w.w = pk2(hv[1][2], hv[1][3]);
                __builtin_nontemporal_store(w, (v4u*)(H + r * DFF + ch0)); }
    }
};

__device__ __forceinline__ void phase3_prep(const Args& a, LAS unsigned char* lds, int pw, int PW) {
    int tid_ = threadIdx.x; asm volatile("" : "+v"(tid_)); const int tid = tid_, lane = tid & 63, wave = tid >> 6;
    unsigned char* ws = a.ws;
    const bf16* __restrict__ proj = (const bf16*)(ws + WS_PROJ);
    {
        bf16* mixed = (bf16*)(ws + WS_MIXED);
        const float* cw = a.in[17]; const float* cg_g = a.in[19];
        const int sub = lane & 7;
        constexpr int NST = NB * 8 * SEQ / 8;
        for (int st0 = pw; st0 < NST; st0 += 2 * PW) {
            v4u rb[2], rc0[2], rx0[2], rc1[2], rx1[2], rc2[2], rx2[2];
#pragma unroll
            for (int u = 0; u < 2; ++u) { const int st1 = st0 + u * PW, st = st1 < NST ? st1 : NST - 1;
                {
                    const int b = st >> 12, cgp = (st >> 9) & 7, t = (st & 511) * 8 + (lane >> 3);
                    const int c = cgp * 64 + sub * 8;
                    const int colB = 1304 + c, colC = 1816 + c, colX = 2328 + c;
                    const bf16* pB = proj + ((size_t)(b * NSEG + (colB >> 6)) * SEQ + t) * 64 + (colB & 63);
                    const bf16* pC = proj + ((size_t)(b * NSEG + (colC >> 6)) * SEQ + t) * 64 + (colC & 63);
                    const bf16* pX = proj + ((size_t)(b * NSEG + (colX >> 6)) * SEQ + t) * 64 + (colX & 63);
                    const v4u z = {0u, 0u, 0u, 0u};
                    rb[u] = *(const v4u*)pB; rc0[u] = *(const v4u*)pC; rx0[u] = *(const v4u*)pX;
                    rc1[u] = t >= 1 ? *(const v4u*)(pC - 64) : z; rx1[u] = t >= 1 ? *(const v4u*)(pX - 64) : z;
                    rc2[u] = t >= 2 ? *(const v4u*)(pC - 128) : z; rx2[u] = t >= 2 ? *(const v4u*)(pX - 128) : z; } }
#pragma unroll
            for (int u = 0; u < 2; ++u) { const int st1 = st0 + u * PW, st = st1 < NST ? st1 : NST - 1;
                {
                    const int b = st >> 12, cgp = (st >> 9) & 7, t = (st & 511) * 8 + (lane >> 3);
                    const int c = cgp * 64 + sub * 8;
                    const f32x4 w0a = *(const f32x4*)(cw + c), w0b = *(const f32x4*)(cw + c + 4), w1a = *(const f32x4*)(cw + 512 + c), w1b = *(const f32x4*)(cw + 512 + c + 4);
                    const f32x4 w2a = *(const f32x4*)(cw + 1024 + c), w2b = *(const f32x4*)(cw + 1024 + c + 4), ga = *(const f32x4*)(cg_g + c), gb = *(const f32x4*)(cg_g + c + 4);
                    float v[8];
#define CONV_E(e, RW, W0, W1, W2, LOHI) v[e] = LOHI(rb[u].RW) * (W0 * (LOHI(rc2[u].RW) * LOHI(rx2[u].RW)) + W1 * (LOHI(rc1[u].RW) * LOHI(rx1[u].RW)) + W2 * (LOHI(rc0[u].RW) * LOHI(rx0[u].RW)))
                    CONV_E(0, x, w0a[0], w1a[0], w2a[0], bflo); CONV_E(1, x, w0a[1], w1a[1], w2a[1], bfhi); CONV_E(2, y, w0a[2], w1a[2], w2a[2], bflo); CONV_E(3, y, w0a[3], w1a[3], w2a[3], bfhi);
                    CONV_E(4, z, w0b[0], w1b[0], w2b[0], bflo); CONV_E(5, z, w0b[1], w1b[1], w2b[1], bfhi); CONV_E(6, w, w0b[2], w1b[2], w2b[2], bflo); CONV_E(7, w, w0b[3], w1b[3], w2b[3], bfhi);
#undef CONV_E
                    float ss = 0.f;
#pragma unroll
                    for (int e = 0; e < 8; ++e) ss += v[e] * v[e];
                    ss += __shfl_xor(ss, 1); ss += __shfl_xor(ss, 2); ss += __shfl_xor(ss, 4);
                    const float rs = rsqrtf(ss * (1.0f / 64.0f) + EPS);
                    v4u o; o.x = pk2(v[0] * rs * ga[0], v[1] * rs * ga[1]); o.y = pk2(v[2] * rs * ga[2], v[3] * rs * ga[3]);
                    o.z = pk2(v[4] * rs * gb[0], v[5] * rs * gb[1]); o.w = pk2(v[6] * rs * gb[2], v[7] * rs * gb[3]);
                    if (st1 < NST) *(v4u*)(mixed + ((size_t)b * SEQ + t) * DM + 512 + c) = o;
                } }
        }
    }
}

__device__ __forceinline__ void phase4(const Args& a, LAS unsigned char* lds) {
    int tid_ = threadIdx.x; asm volatile("" : "+v"(tid_)); const int tid = tid_, lane = tid & 63, wave = tid >> 6;
    unsigned char* ws = a.ws;
    const float* hid = (const float*)(ws + WS_HID);
    const int G = gridDim.x, half = G >> 1;
    const int kv = (int)blockIdx.x >= half ? 1 : 0;
    const int bl = (int)blockIdx.x - kv * half, nb = kv ? (G - half) : half;
    LAS float* W2 = (LAS float*)lds;
    LAS float* scr = (LAS float*)(lds + 65536 + wave * 4096);
    { const float* w2 = a.in[14 + 2 * kv];
#pragma unroll
      for (int q = 0; q < 8; ++q) { const int idx = q * 512 + tid; *(LAS f32x4*)(W2 + idx * 4) = *(const f32x4*)(w2 + idx * 4); } }
    __syncthreads();
    for (int it = bl * NWAVES + wave; it < 1024; it += nb * NWAVES) {
        const int r4 = it * 4;
#pragma unroll
        for (int j = 0; j < 4; ++j)
#pragma unroll
            for (int q = 0; q < 4; ++q) scr[(q * 64 + lane) * 4 + j] = hid[((size_t)kv * 4096 + r4 + j) * 256 + q * 64 + lane];
        LDS_WAIT(); asm volatile("" ::: "memory");
        f32x4 acc = {0.f, 0.f, 0.f, 0.f};
#pragma unroll 16
        for (int k = 0; k < 256; ++k) { const float w = W2[k * 64 + lane]; const f32x4 h = *(const LAS f32x4*)(scr + k * 4); acc += h * w; }
        LDS_WAIT(); asm volatile("" ::: "memory");
#pragma unroll
        for (int j = 0; j < 4; ++j) {
            const int row = r4 + j, pair = row >> 8, n = row & 255;
            if (kv == 0) {
                const float ss = wave_sum(acc[j] * acc[j]);
                const float y = acc[j] * rsqrtf(ss * (1.0f / 64.0f) + EPS) * a.in[8][lane];
                ((bf16*)(ws + WS_KCN))[((size_t)pair * 256 + n) * 64 + lane] = (n < 255) ? (bf16)f2bf(y) : (bf16)0;
            } else {
                ((bf16*)(ws + WS_VCT))[((size_t)pair * 64 + lane) * 256 + n] = (n < 255) ? (bf16)f2bf(acc[j]) : (bf16)0;
            }
        }
    }
}

#ifndef PROBE_CMP
#define PROBE_CMP 0
#endif
#ifndef PROBE_TOPK
#define PROBE_TOPK 0
#endif
#ifndef PROBE_SEL
#define PROBE_SEL 0
#endif
#ifndef PROBE_WIN
#define PROBE_WIN 0
#endif
#define MFMA32(a, b, c) __builtin_amdgcn_mfma_f32_32x32x16_bf16((a), (b), (c), 0, 0, 0)
constexpr int AT_CK = 0, AT_CV = 36864, AT_PS = 70656, AT_SLOT = 0, AT_OF = 73728, AT_WU = 139264, AT_KEYS = 139392, PS_PITCH = 260;
constexpr int QCTR_WORD = 3584;
constexpr int AT_KB0 = 0, AT_KB1 = 9216, AT_VB0 = 18432, AT_VB1 = 27648;
constexpr float NEG_BIG = -1.0e30f;

__device__ __forceinline__ float quad_sum(float t) {
    t += __builtin_bit_cast(float, __builtin_amdgcn_mov_dpp(__builtin_bit_cast(int, t), 0xB1, 0xf, 0xf, true));
    t += __builtin_bit_cast(float, __builtin_amdgcn_mov_dpp(__builtin_bit_cast(int, t), 0x4E, 0xf, 0xf, true));
    return t;
}
__device__ __forceinline__ s16x4 vtr(const LAS unsigned char* p) { return __builtin_amdgcn_ds_read_tr16_b64_v4i16((LAS s16x4*)p); }
template <int MODE, bool DIAG, bool VTR = false>
__device__ __forceinline__ void attn_tile(const LAS unsigned char* Kt, const LAS unsigned char* Vt, int vpitch, int vkoff, const bf16x8 (&qf)[4], int r, int h2,
                                          float cs, float A, int lo, int hi, float& m, float& l, f32x16 (&o)[2], float inv_l, LAS float* psrow) {
    float rowsum = 0.f;
#pragma unroll
    for (int sub = 0; sub < 2; ++sub) {
        f32x16 s;
#pragma unroll
        for (int i = 0; i < 16; ++i) s[i] = __builtin_fmaf(cs, (float)(32 * sub + (i & 3) + 8 * (i >> 2)), A);
#pragma unroll
        for (int ks = 0; ks < 4; ++ks) { const bf16x8 kf = *(const LAS bf16x8*)(Kt + (32 * sub + r) * 144 + (16 * ks + 8 * h2) * 2); s = MFMA32(kf, qf[ks], s); }
        if (DIAG) {
#pragma unroll
            for (int i = 0; i < 16; ++i) { const int ci = 32 * sub + (i & 3) + 8 * (i >> 2); s[i] = (ci >= lo && ci <= hi) ? s[i] : -INFINITY; }
        }
        if (MODE == 0) {
            float mx = s[0];
#pragma unroll
            for (int i = 1; i < 16; ++i) mx = fmaxf(mx, s[i]);
            mx = fmaxf(mx, __shfl_xor(mx, 32));
            const float mn = fmaxf(m, mx); l *= __builtin_amdgcn_exp2f(m - mn); m = mn;
            float rs = 0.f;
#pragma unroll
            for (int i = 0; i < 16; ++i) rs += __builtin_amdgcn_exp2f(s[i] - mn);
            l += rs;
            continue;
        }
#pragma unroll
        for (int i = 0; i < 16; ++i) {
            float p;
            if (MODE == 1) p = __builtin_amdgcn_exp2f(s[i] - m) * inv_l; else p = __builtin_amdgcn_exp2f(s[i]);
            rowsum += p; s[i] = p;
        }
        if (MODE == 1) {
#pragma unroll
            for (int i = 0; i < 16; ++i) { const float t = quad_sum(s[i]);
                if ((r & 3) == 0) psrow[32 * sub + (i & 3) + 8 * (i >> 2) + 4 * h2] = t; }
        }
#pragma unroll
        for (int st = 0; st < 2; ++st) {
            v4u pw; pw.x = pk2(s[8 * st + 0], s[8 * st + 1]); pw.y = pk2(s[8 * st + 2], s[8 * st + 3]);
            pw.z = pk2(s[8 * st + 4], s[8 * st + 5]); pw.w = pk2(s[8 * st + 6], s[8 * st + 7]);
            const bf16x8 pf = __builtin_bit_cast(bf16x8, pw);
#pragma unroll
            for (int dt = 0; dt < 2; ++dt) {
                s16x4 lo4, hi4;
                if (VTR) {
                    const LAS unsigned char* vp = Vt + (32 * sub + 16 * st + 4 * h2 + ((r & 15) >> 2)) * vpitch + (32 * dt + 16 * (r >> 4)) * 2 + 8 * (r & 3);
                    lo4 = vtr(vp); hi4 = vtr(vp + 8 * vpitch);
                } else {
                    const LAS unsigned char* vp = Vt + (32 * dt + r) * vpitch + vkoff + (32 * sub + 16 * st + 4 * h2) * 2;
                    lo4 = *(const LAS s16x4*)(vp); hi4 = *(const LAS s16x4*)(vp + 16);
                }
                const bf16x8 vf = __builtin_shufflevector(lo4, hi4, 0, 1, 2, 3, 4, 5, 6, 7);
                o[dt] = MFMA32(vf, pf, o[dt]);
            }
        }
    }
    if (MODE >= 2) l += rowsum;
}

template <int MODE>
__device__ __forceinline__ void attn_blocks(LAS unsigned char* lds, unsigned long long blocks, unsigned long long wmask, int iq, const bf16* Kg, const bf16* Vtg, const bf16x8 (&qf)[4], int r, int h2,
                                            float slope2, float smax2, int tpos, unsigned long long mymask, float& l, f32x16 (&o)[2]) {
    int tid_ = threadIdx.x; asm volatile("" : "+v"(tid_)); const int tid = tid_;
    const int lrow = tid >> 3, lch = tid & 7;
    const int loff = lrow * 144 + lch * 16;
    const unsigned char* kgp = (const unsigned char*)Kg + tid * 16;
    const unsigned char* vgp = (const unsigned char*)Vtg + tid * 16;
    float mdummy = 0.f;
    unsigned long long rem = blocks;
    int j0 = __builtin_ctzll(rem); rem &= rem - 1;
    int j1 = rem ? __builtin_ctzll(rem) : -1; if (rem) rem &= rem - 1;
    v4u k0, v0, k1 = {0u, 0u, 0u, 0u}, v1 = {0u, 0u, 0u, 0u};
    k0 = *(const v4u*)(kgp + (size_t)j0 * 8192); v0 = *(const v4u*)(vgp + (size_t)j0 * 8192);
    if (j1 >= 0) { k1 = *(const v4u*)(kgp + (size_t)j1 * 8192); v1 = *(const v4u*)(vgp + (size_t)j1 * 8192); }
    *(LAS v4u*)(lds + AT_SLOT + loff) = k0; *(LAS v4u*)(lds + AT_SLOT + 9216 + loff) = v0;
    *(LAS v4u*)(lds + AT_SLOT + 18432 + loff) = k1; *(LAS v4u*)(lds + AT_SLOT + 27648 + loff) = v1;
    __syncthreads();
    int cur = 0;
    for (;;) {
        const int n0 = rem ? __builtin_ctzll(rem) : -1; if (rem) rem &= rem - 1;
        const int n1 = rem ? __builtin_ctzll(rem) : -1; if (rem) rem &= rem - 1;
        if (n0 >= 0) { k0 = *(const v4u*)(kgp + (size_t)n0 * 8192); v0 = *(const v4u*)(vgp + (size_t)n0 * 8192); }
        if (n1 >= 0) { k1 = *(const v4u*)(kgp + (size_t)n1 * 8192); v1 = *(const v4u*)(vgp + (size_t)n1 * 8192); }
        const LAS unsigned char* sb = lds + AT_SLOT + cur * 36864;
#pragma unroll
        for (int u = 0; u < 2; ++u) {
            const int j = u ? j1 : j0;
            if (j >= 0 && ((wmask >> j) & 1ull)) {
                int rr = r, hh = h2; asm volatile("" : "+v"(rr), "+v"(hh));
                const bool on = (mymask >> j) & 1ull;
                const int rel = tpos - 64 * j - 4 * h2;
                float A = -slope2 * (float)rel - smax2;
                if (MODE == 2 && !on) A = -INFINITY;
                const LAS unsigned char* kb = sb + u * 18432; const LAS unsigned char* vb = kb + 9216;
                if (j == iq || (MODE == 3 && j == iq - 8)) attn_tile<MODE, true, true>(kb, vb, 144, 0, qf, rr, hh, slope2, A, (MODE == 3) ? rel - 511 : -100000, rel, mdummy, l, o, 0.f, nullptr);
                else attn_tile<MODE, false, true>(kb, vb, 144, 0, qf, rr, hh, slope2, A, 0, 0, mdummy, l, o, 0.f, nullptr);
            }
        }
        if (n0 >= 0) {
            LAS unsigned char* nb = lds + AT_SLOT + (cur ^ 1) * 36864;
            *(LAS v4u*)(nb + loff) = k0; *(LAS v4u*)(nb + 9216 + loff) = v0;
            if (n1 >= 0) { *(LAS v4u*)(nb + 18432 + loff) = k1; *(LAS v4u*)(nb + 27648 + loff) = v1; }
        }
        __syncthreads();
        if (n0 < 0) break;
        j0 = n0; j1 = n1; cur ^= 1;
    }
}

__device__ __forceinline__ float max_abs64(const float* g) {
    float m = fabsf(g[threadIdx.x & 63]);
#pragma unroll
    for (int o = 1; o < 64; o <<= 1) m = fmaxf(m, __shfl_xor(m, o));
    return m; }

__device__ __forceinline__ void phase5(const Args& a, LAS unsigned char* lds) {
    int tid_ = threadIdx.x; asm volatile("" : "+v"(tid_)); const int tid = tid_, lane = tid & 63, wave = tid >> 6, G = gridDim.x, c = blockIdx.x;
    unsigned char* ws = a.ws;
    const bf16* QN = (const bf16*)(ws + WS_QN);
    const float* gates = (const float*)(ws + WS_GATES);
    bf16* mixed = (bf16*)(ws + WS_MIXED);
    LAS float* PS = (LAS float*)(lds + AT_PS);
    LAS unsigned long long* WU = (LAS unsigned long long*)(lds + AT_WU);
    const float qb = max_abs64(a.in[7]) * (64.0f * 0.125f * LOG2E * 1.02f);
    const float smax_s = qb * max_abs64(a.in[9]), smax_w = qb * max_abs64(a.in[10]);
    for (int rd = 0;; ++rd) {
        const int rank = rd * G + ((rd & 1) ? (G - 1 - c) : c);
        if (rd * G >= 1024) break;
        if (rank >= 1024) continue;
        int ln_ = lane; asm volatile("" : "+v"(ln_));
        const int r = ln_ & 31, h2 = ln_ >> 5, hq = r & 3, tl = r >> 2;
        const int i = 63 - (rank >> 4), bg = rank & 15, b = bg >> 1, g = bg & 1;
        const int T0 = 64 * i, tpos = T0 + 8 * wave + tl;
        const int head = 4 * g + hq;
        const float slope2 = exp2f(-(float)(head + 1)) * LOG2E;
        const size_t mrow = (size_t)b * SEQ + tpos;
        {
            const unsigned char* kc = (const unsigned char*)((const bf16*)(ws + WS_KCN) + (size_t)bg * 256 * 64);
            const unsigned char* vc = (const unsigned char*)((const bf16*)(ws + WS_VCT) + (size_t)bg * 64 * 256);
#pragma unroll
            for (int q = 0; q < 4; ++q) { const int idx = q * 512 + tid;
                const v4u kv_ = *(const v4u*)(kc + (size_t)idx * 16); *(LAS v4u*)(lds + AT_CK + (idx >> 3) * 144 + (idx & 7) * 16) = kv_;
                const v4u vv_ = *(const v4u*)(vc + (size_t)idx * 16); *(LAS v4u*)(lds + AT_CV + (idx >> 5) * 528 + (idx & 31) * 16) = vv_; }
        }
        bf16x8 qf[4];
        { const bf16* qp = QN + ((size_t)(b * 8 + head) * SEQ + tpos) * 64 + 8 * h2;
#pragma unroll
          for (int ks = 0; ks < 4; ++ks) qf[ks] = *(const bf16x8*)(qp + 16 * ks); }
        __syncthreads();
        f32x16 ofin[2];
        const int KT = ((4 * i + 2) >> 6) + 1;
        float g_c, g_s, g_w;
        { const float* gp = gates + mrow * 24 + head * 3; g_c = gp[0]; g_s = gp[1]; g_w = gp[2]; }
#if PROBE_CMP
        for (int rep = 0; rep < 2; ++rep)
#endif
        {
            float m = NEG_BIG, l = 0.f; f32x16 o[2];
#pragma unroll
            for (int dt = 0; dt < 2; ++dt)
#pragma unroll
                for (int e = 0; e < 16; ++e) o[dt][e] = 0.f;
            const float cs = 16.0f * slope2;
            for (int kt = 0; kt < KT; ++kt) {
                const int rel = tpos - 31 - 1024 * kt;
                attn_tile<0, true>(lds + AT_CK + kt * 64 * 144, lds + AT_CV, 528, kt * 128, qf, r, h2, cs, -slope2 * (float)(rel - 64 * h2), -100000, (rel >> 4) - 4 * h2, m, l, o, 0.f, nullptr);
            }
            const float lt = l + __shfl_xor(l, 32);
            const float inv_l = lt > 0.f ? 1.0f / lt : 0.f;
            LAS float* psrow = PS + (8 * wave + tl) * PS_PITCH;
            for (int kt = 0; kt < KT; ++kt) {
                const int rel = tpos - 31 - 1024 * kt;
                attn_tile<1, true>(lds + AT_CK + kt * 64 * 144, lds + AT_CV, 528, kt * 128, qf, r, h2, cs, -slope2 * (float)(rel - 64 * h2), -100000, (rel >> 4) - 4 * h2, m, l, o, inv_l, psrow + 64 * kt);
            }
#pragma unroll
            for (int dt = 0; dt < 2; ++dt)
#pragma unroll
                for (int e = 0; e < 16; ++e) ofin[dt][e] = g_c * o[dt][e];
        }
        LDS_WAIT(); asm volatile("" ::: "memory");
        unsigned long long mymask = 0ull, wunion = 0ull;
#if PROBE_TOPK
        for (int rep = 0; rep < 2; ++rep)
#endif
        {
            const int nmax = (4 * i + 3) < 254 ? (4 * i + 3) : 254;
            const unsigned long long validbits = (i >= 63) ? ~0ull : ((1ull << (i + 1)) - 1ull);
            const bool forced = (lane == 0) || (lane == i) || (lane == i - 1);
            LAS unsigned* KEYS = (LAS unsigned*)(lds + AT_KEYS) + wave * 64;
            if (i < 16) { mymask = validbits; wunion = validbits; }
            else
#pragma unroll 1
            for (int t8 = 0; t8 < 8; ++t8) {
                const LAS float* ps = PS + (8 * wave + t8) * PS_PITCH;
                float imp = 0.f;
#pragma unroll
                for (int dn = -1; dn <= 3; ++dn) { const int n = 4 * lane + dn; if (n >= 0 && n <= nmax) imp += ps[n]; }
                unsigned key = (lane <= i) ? (((__builtin_bit_cast(unsigned, imp) & ~63u) + 64u) | (unsigned)(63 - lane)) : (unsigned)(63 - lane);
                key = forced ? (0xFFFFFFC0u | (unsigned)(63 - lane)) : key;
                KEYS[lane] = key;
                LDS_WAIT(); asm volatile("" ::: "memory");
                int cnt = 0;
#pragma unroll
                for (int k4 = 0; k4 < 16; ++k4) { const v4u kk = *(const LAS v4u*)(KEYS + 4 * k4);
                    cnt += (kk.x > key) ? 1 : 0; cnt += (kk.y > key) ? 1 : 0; cnt += (kk.z > key) ? 1 : 0; cnt += (kk.w > key) ? 1 : 0; }
                LDS_WAIT(); asm volatile("" ::: "memory");
                const unsigned long long msk = __ballot(cnt < 16) & validbits;
                wunion |= msk;
                if (tl == t8) mymask = msk;
            }
            if (lane == 0) WU[wave] = wunion;
        }
        __syncthreads();
        unsigned long long uni = 0ull;
#pragma unroll
        for (int w = 0; w < 8; ++w) uni |= WU[w];
        {
            const unsigned lo = __builtin_amdgcn_readfirstlane((unsigned)uni), hi = __builtin_amdgcn_readfirstlane((unsigned)(uni >> 32));
            uni = ((unsigned long long)hi << 32) | lo;
        }
        LAS float* OF = (LAS float*)(lds + AT_OF) + tid;
#pragma unroll
        for (int dt = 0; dt < 2; ++dt)
#pragma unroll
            for (int e = 0; e < 16; ++e) OF[(dt * 16 + e) * 512] = ofin[dt][e];
        {
            float l = 0.f; f32x16 o[2];
#pragma unroll
            for (int dt = 0; dt < 2; ++dt)
#pragma unroll
                for (int e = 0; e < 16; ++e) o[dt][e] = 0.f;
            attn_blocks<2>(lds, uni, wunion, i, (const bf16*)(ws + WS_KSN) + (size_t)bg * SEQ * 64, (const bf16*)(ws + WS_PROJ) + ((size_t)(b * NSEG + 14 + g) * SEQ) * 64, qf, r, h2, slope2, smax_s, tpos, mymask, l, o);
            const float lt = l + __shfl_xor(l, 32);
            const float sc = lt > 0.f ? g_s / lt : 0.f;
#pragma unroll
            for (int dt = 0; dt < 2; ++dt)
#pragma unroll
                for (int e = 0; e < 16; ++e) OF[(dt * 16 + e) * 512] += sc * o[dt][e];
        }
        {
            float l = 0.f; f32x16 o[2];
#pragma unroll
            for (int dt = 0; dt < 2; ++dt)
#pragma unroll
                for (int e = 0; e < 16; ++e) o[dt][e] = 0.f;
            const int jlo = i - 8 < 0 ? 0 : i - 8;
            const unsigned long long upto = (i >= 63) ? ~0ull : ((1ull << (i + 1)) - 1ull);
            const unsigned long long wb = upto & ~((1ull << jlo) - 1ull);
            attn_blocks<3>(lds, wb, ~0ull, i, (const bf16*)(ws + WS_KWN) + (size_t)bg * SEQ * 64, (const bf16*)(ws + WS_PROJ) + ((size_t)(b * NSEG + 18 + g) * SEQ) * 64, qf, r, h2, slope2, smax_w, tpos, ~0ull, l, o);
            const float lt = l + __shfl_xor(l, 32);
            const float sc = lt > 0.f ? g_w / lt : 0.f;
#pragma unroll
            for (int dt = 0; dt < 2; ++dt)
#pragma unroll
                for (int e = 0; e < 16; ++e) ofin[dt][e] = OF[(dt * 16 + e) * 512] + sc * o[dt][e];
        }
        {
            float ss = 0.f;
#pragma unroll
            for (int dt = 0; dt < 2; ++dt)
#pragma unroll
                for (int e = 0; e < 16; ++e) ss += ofin[dt][e] * ofin[dt][e];
            ss += __shfl_xor(ss, 32);
            const float rs = rsqrtf(ss * (1.0f / 64.0f) + EPS);
            const float* og = a.in[18] + head * 64;
            LAS unsigned char* ob = lds + AT_CK + (wave * 32 + r) * 144;
#pragma unroll
            for (int dt = 0; dt < 2; ++dt)
#pragma unroll
                for (int i4 = 0; i4 < 4; ++i4) { const int d0 = 32 * dt + 8 * i4 + 4 * h2; const f32x4 gv = *(const f32x4*)(og + d0);
                    v2u w; w.x = pk2(ofin[dt][4 * i4 + 0] * rs * gv[0], ofin[dt][4 * i4 + 1] * rs * gv[1]); w.y = pk2(ofin[dt][4 * i4 + 2] * rs * gv[2], ofin[dt][4 * i4 + 3] * rs * gv[3]);
                    *(LAS v2u*)(ob + d0 * 2) = w; }
            __syncthreads();
#pragma unroll
            for (int q = 0; q < 4; ++q) { const int idx = q * 512 + tid, row = idx >> 3, chunk = idx & 7;
                const v4u v = *(const LAS v4u*)(lds + AT_CK + row * 144 + chunk * 16);
                *(v4u*)(mixed + ((size_t)b * SEQ + T0 + (row >> 2)) * DM + (4 * g + (row & 3)) * 64 + chunk * 8) = v; }
            __syncthreads();
        }
    }
}

__device__ __forceinline__ void phase8b(const Args& a) {
    unsigned char* ws = a.ws;
    const float* gtail = (const float*)(ws + WS_GTAIL); const float* ghead = (const float*)(ws + WS_GHEAD); const float* uhead = (const float*)(ws + WS_UHEAD);
    const float* cw = a.in[24]; bf16* H = (bf16*)(ws + WS_H);
    for (int e = blockIdx.x * NTHREADS + threadIdx.x; e < 128 * DFF; e += gridDim.x * NTHREADS) {
        const int pm = e / DFF, ch = e % DFF;
        float t0 = 0.f, t1 = 0.f;
        if (pm & 15) { t0 = gtail[((size_t)(pm - 1) * 2 + 0) * DFF + ch]; t1 = gtail[((size_t)(pm - 1) * 2 + 1) * DFF + ch]; }
        const float g0 = ghead[((size_t)pm * 2 + 0) * DFF + ch], g1 = ghead[((size_t)pm * 2 + 1) * DFF + ch];
        const float u0 = uhead[((size_t)pm * 2 + 0) * DFF + ch], u1 = uhead[((size_t)pm * 2 + 1) * DFF + ch];
        const float w0 = cw[ch], w1 = cw[DFF + ch], w2 = cw[2 * DFF + ch];
        H[((size_t)pm * 256 + 0) * DFF + ch] = (bf16)f2bf(silu_f(w0 * t0 + w1 * t1 + w2 * g0) * u0);
        H[((size_t)pm * 256 + 1) * DFF + ch] = (bf16)f2bf(silu_f(w0 * t1 + w1 * g0 + w2 * g1) * u1);
    }
}

__global__ void __launch_bounds__(NTHREADS) nsa_layer_fwd(Args a) {
    extern __shared__ __attribute__((aligned(16))) unsigned char smem[];
    LAS unsigned char* lds = (LAS unsigned char*)smem;
    cg::grid_group grid = cg::this_grid();
    unsigned char* ws = a.ws;
    const int G = gridDim.x, c = blockIdx.x;
    const float* mod = (const float*)(ws + WS_MOD);

    if (threadIdx.x < 2) ((volatile LAS unsigned*)(lds + XB_LDS_OFF))[threadIdx.x] = 0u;
    __syncthreads();
    const XcdBarrier xbar = xcd_barrier_post((unsigned*)(ws + WS_BAR), (volatile LAS unsigned*)(lds + XB_LDS_OFF));
    if (a.ws == nullptr) grid.sync();
    phase0(a, lds);
    xcd_barrier(xbar);
    norm_rows(a.in[0], a.in[4], mod, 0, 1024, (bf16*)(ws + WS_XN));
    weight_copies(a, lds);
    xcd_barrier(xbar);
    {
        pg8::Gemm g{(const bf16*)(ws + WS_XN), (const bf16*)(ws + WS_BT_IN), MTOK, NINP, 1024, 1024};
        pg8::StaticOrder S; S.init(MTOK, NINP, G, c);
        EpiProj E{(bf16*)(ws + WS_PROJ), (bf16*)(ws + WS_QN), (bf16*)(ws + WS_KSN), (bf16*)(ws + WS_KWN), (float*)(ws + WS_GATES), a.in[7], a.in[9], a.in[10], a.in[6]};
        pg8::gemm_phase<EpiProj, pg8::StaticOrder, true, true>(lds, g, S, E);
    }
    xcd_barrier(xbar);
    if (c < 32) {
        pg8::Gemm g{(const bf16*)(ws + WS_PROJ), (const bf16*)(ws + WS_BT_C1), 4096, 256, 2048, 1024};
        CmpOrder S{c, (const bf16*)(ws + WS_PROJ), (const bf16*)(ws + WS_BT_C1)};
        EpiCmp E{(float*)(ws + WS_HID), (const float*)(ws + WS_BIAS1)};
        pg8::gemm_phase<EpiCmp, CmpOrder, true, true>(lds, g, S, E);
    } else {
        phase3_prep(a, lds, (c - 32) * NWAVES + (int)(threadIdx.x >> 6), (G - 32) * NWAVES);
    }
    xcd_barrier(xbar);
    phase4(a, lds);
    xcd_barrier(xbar);
    phase5(a, lds);
    xcd_barrier(xbar);
    {
        pg8::Gemm g{(const bf16*)(ws + WS_MIXED), (const bf16*)(ws + WS_BT_OUT), MTOK, 1024, 1024, 1024};
        pg8::StaticOrder S; S.init(MTOK, 1024, G, c);
        EpiResB E{a.in[0], (bf16*)(ws + WS_X1B), mod, 2048};
        pg8::gemm_phase<EpiResB, pg8::StaticOrder, true, true>(lds, g, S, E);
    }
    xcd_barrier(xbar);
    norm_rows_b((const bf16*)(ws + WS_X1B), a.in[21], mod, 3072, 4096, (bf16*)(ws + WS_XN));
    xcd_barrier(xbar);
    {
        pg8::Gemm g{(const bf16*)(ws + WS_XN), (const bf16*)(ws + WS_BT_GU), MTOK, NGU, 1024, 1024};
        pg8::StaticOrder S; S.init(MTOK, NGU, G, c);
        EpiFfn E{(bf16*)(ws + WS_H), a.in[24], (float*)(ws + WS_GTAIL), (float*)(ws + WS_GHEAD), (float*)(ws + WS_UHEAD), (LAS float*)(lds + HB_OFF)};
        pg8::gemm_phase<EpiFfn, pg8::StaticOrder, true, true>(lds, g, S, E);
    }
    xcd_barrier(xbar);
    phase8b(a);
    xcd_barrier(xbar);
    {
        pg8::Gemm g{(const bf16*)(ws + WS_H), (const bf16*)(ws + WS_BT_DN), MTOK, 1024, DFF, DFF};
        pg8::StaticOrder S; S.init(MTOK, 1024, G, c);
        EpiResF E{(const bf16*)(ws + WS_X1B), a.out, mod, 5120};
        pg8::gemm_phase<EpiResF, pg8::StaticOrder, true, true>(lds, g, S, E);
    }
}

extern "C" void kernel_launch(void* const* d_in, const int* in_sizes, int n_in, void* d_out, int out_size, void* d_ws, size_t ws_size, hipStream_t stream) {
    static int grid = 0;
    if (grid == 0) {
        if (n_in != 26 || out_size != MTOK * DM || ws_size < WS_END) { fprintf(stderr, "kernel_launch: unexpected problem (n_in %d, out %d, ws %zu)\n", n_in, out_size, ws_size); grid = -1; return; }
        int dev = 0, cus = 0, per_cu = 0;
        (void)hipGetDevice(&dev);
        (void)hipDeviceGetAttribute(&cus, hipDeviceAttributeMultiprocessorCount, dev);
        if (hipFuncSetAttribute((const void*)nsa_layer_fwd, hipFuncAttributeMaxDynamicSharedMemorySize, LDS_BYTES) != hipSuccess) { fprintf(stderr, "kernel_launch: hipFuncSetAttribute failed\n"); grid = -1; return; }
        if (hipOccupancyMaxActiveBlocksPerMultiprocessor(&per_cu, (const void*)nsa_layer_fwd, NTHREADS, LDS_BYTES) != hipSuccess || per_cu < 1) { fprintf(stderr, "kernel_launch: occupancy query says %d\n", per_cu); per_cu = 1; }
        (void)hipGetLastError();
        grid = cus * per_cu;
        if (grid > 1024) grid = 1024;
    }
    if (grid < 0) return;
    if (hipMemsetAsync((char*)d_ws + WS_BAR, 0, BAR_BYTES, stream) != hipSuccess) { fprintf(stderr, "kernel_launch: memset of the barrier words failed\n"); return; }
    Args a{};
    for (int i = 0; i < 26; ++i) a.in[i] = (const float*)d_in[i];
    a.out = (float*)d_out; a.ws = (unsigned char*)d_ws;
    void* args[] = {&a};
    hipError_t e = hipLaunchCooperativeKernel((const void*)nsa_layer_fwd, dim3(grid), dim3(NTHREADS), args, LDS_BYTES, stream);
    if (e != hipSuccess) fprintf(stderr, "cooperative launch failed: %s (grid %d)\n", hipGetErrorString(e), grid);
}
```

```cpp
#include <hip/hip_runtime.h>
#include <hip/hip_cooperative_groups.h>
#include <cstdio>
#include <cstdint>
namespace cg = cooperative_groups;

namespace pg8 {
#define PG8_LAS __attribute__((address_space(3)))
typedef unsigned short bf16_t;
typedef short bf16x8 __attribute__((ext_vector_type(8)));
typedef float f32x4 __attribute__((ext_vector_type(4)));
typedef unsigned u32x4 __attribute__((ext_vector_type(4)));
constexpr int BM = 256, BK = 64, HALF = 128, HTB = HALF * BK * 2, STAGE_BYTES = 8 * HTB, NXCD = 8, WGM = 8;

__host__ __device__ __forceinline__ int lds_byte(int r, int c) { const int st = (r >> 4) * 2 + (c >> 5), rr = r & 15, cc = c & 31, ob = rr * 64 + cc * 2; return st * 1024 + (ob ^ (((ob >> 9) & 1) << 5)); }
__host__ __device__ __forceinline__ void stage_rc(int b, int& R, int& C) { const int st = b / 1024, sb = b % 1024, swz = sb ^ (((sb >> 9) & 1) << 5); R = (st >> 1) * 16 + swz / 64; C = (st & 1) * 32 + (swz % 64) / 2; }
__host__ __device__ __forceinline__ int perm32(int rho) { const int n = rho >> 4, i = rho & 15; return 8 * (i >> 2) + 4 * n + (i & 3); }

struct Unit { int pm, pn; };
struct Gemm { const bf16_t* A; const bf16_t* Bt; int M, N, K, lda; };

struct StaticOrder {
    int nM, nN, nwg, G, c;
    __device__ void init(int M, int N, int G_, int c_) { nM = M / BM; nN = N / BM; nwg = nM * nN; G = G_; c = c_; }
    __device__ bool next(int i, Unit& u) const {
        const long L = (long)i * G + c; if (L >= nwg) return false;
        int wgid = (int)L; { const int q = nwg / NXCD, r = nwg % NXCD, xcd = wgid % NXCD, off = wgid / NXCD; wgid = (xcd < r ? xcd * (q + 1) : r * (q + 1) + (xcd - r) * q) + off; }
        const int nig = WGM * nN, gid = wgid / nig, fm = gid * WGM, gsz = (nM - fm) < WGM ? (nM - fm) : WGM;
        u.pm = fm + ((wgid % nig) % gsz); u.pn = (wgid % nig) / gsz; return true;
    }
    __device__ __forceinline__ const char* a_ptr(const Gemm& g, const Unit& u) const { return (const char*)g.A + (size_t)u.pm * (size_t)(BM * 2) * (size_t)g.lda; }
    __device__ __forceinline__ const char* b_ptr(const Gemm& g, const Unit& u) const { return (const char*)g.Bt + (size_t)u.pn * (size_t)(BM * 2) * (size_t)g.K; }
    __device__ __forceinline__ void a_ready(const Unit&) const {}
    __device__ __forceinline__ void done(const Unit&) const {}
};

template <class Epi, class Sched, bool ALIGN_EPI = false, bool SP2 = false>
__device__ __forceinline__ void gemm_phase(PG8_LAS unsigned char* lds, const Gemm g, const Sched& S, const Epi& E) {
    int tid_ = threadIdx.x; asm volatile("" : "+v"(tid_));
    const int tid = tid_, wid = __builtin_amdgcn_readfirstlane(tid >> 6), lane = tid & 63, wr = wid >> 2, wc = wid & 3, fr = lane & 15, fq = lane >> 4;
    const int K = g.K, nt = K / BK;
    unsigned voffA[2], voffB[2];
#pragma unroll
    for (int i = 0; i < 2; ++i) { int R, C; stage_rc(tid * 16 + i * 8192, R, C); const int Rb = Epi::PERM2 ? (64 * (R >> 5) + perm32(R & 31)) : (Epi::PERM ? ((R & ~31) + perm32(R & 31)) : R);
        voffA[i] = (unsigned)(R * g.lda + C) * 2u; voffB[i] = (unsigned)(Rb * K + C) * 2u; }
    const size_t kstep = (size_t)(BK * 2);
    const size_t hsA = (size_t)HALF * g.lda * 2, hsB = (size_t)(Epi::PERM2 ? 32 : HALF) * K * 2;
    const unsigned ldsw = (unsigned)wid * 1024u;
    const int aoff = lds_byte(wr * 64 + fr, fq * 8), boff = lds_byte(wc * 32 + fr, fq * 8);
#define PG8_SA(b, h) (((b) * 2 + (h)) * HTB)
#define PG8_SB(b, h) ((4 + (b) * 2 + (h)) * HTB)
#define PG8_STAGE(bufoff, gbase, voff) do { _Pragma("unroll") for (int _i = 0; _i < 2; ++_i) \
        __builtin_amdgcn_global_load_lds((const unsigned*)((const char*)(gbase) + (voff)[_i]), (PG8_LAS unsigned*)(lds + (bufoff) + ldsw + _i * 8192), 16, 0, 0); } while (0)
#define PG8_LDA(dst, b, h) do { _Pragma("unroll") for (int m = 0; m < 4; ++m) _Pragma("unroll") for (int k = 0; k < 2; ++k) dst[m][k] = *(const PG8_LAS bf16x8*)(lds + PG8_SA(b, h) + aoff + m * 2048 + k * 1024); } while (0)
#define PG8_LDB(dst, b, h) do { _Pragma("unroll") for (int n = 0; n < 2; ++n) _Pragma("unroll") for (int k = 0; k < 2; ++k) dst[n][k] = *(const PG8_LAS bf16x8*)(lds + PG8_SB(b, h) + boff + n * 2048 + k * 1024); } while (0)
#define PG8_MMA(ai, bj, At, Bt) do { __builtin_amdgcn_s_setprio(1); _Pragma("unroll") for (int m = 0; m < 4; ++m) _Pragma("unroll") for (int n = 0; n < 2; ++n) _Pragma("unroll") for (int k = 0; k < 2; ++k) \
        acc[ai][bj][m][n] = __builtin_amdgcn_mfma_f32_16x16x32_bf16(Bt[n][k], At[m][k], acc[ai][bj][m][n], 0, 0, 0); __builtin_amdgcn_s_setprio(0); } while (0)
#define PG8_WAIT_V(n) asm volatile("s_waitcnt vmcnt(" #n ")" ::: "memory")
#define PG8_WAIT_L(n) asm volatile("s_waitcnt lgkmcnt(" #n ")" ::: "memory")
#define PG8_BAR __builtin_amdgcn_s_barrier()
#define PG8_SCHED __builtin_amdgcn_sched_barrier(0)
    Unit cur, nxt; int ui = 0;
    if (!S.next(0, cur)) return;
    f32x4 acc[2][2][4][2];
#pragma unroll
    for (int a = 0; a < 2; ++a)
#pragma unroll
        for (int b = 0; b < 2; ++b)
#pragma unroll
            for (int m = 0; m < 4; ++m)
#pragma unroll
                for (int n = 0; n < 2; ++n) acc[a][b][m][n] = (f32x4){0.f, 0.f, 0.f, 0.f};
    bf16x8 At[4][2], B0[2][2], B1[2][2];
    const char* cA = S.a_ptr(g, cur); const char* cB = S.b_ptr(g, cur);
    S.a_ready(cur);
    if constexpr (SP2) {
        PG8_STAGE(PG8_SB(0, 0), cB, voffB); PG8_STAGE(PG8_SB(0, 1), cB + hsB, voffB); PG8_STAGE(PG8_SA(0, 0), cA, voffA); PG8_STAGE(PG8_SA(0, 1), cA + hsA, voffA);
        if (wr == 1) PG8_BAR;
        PG8_WAIT_V(2); PG8_BAR;
        PG8_STAGE(PG8_SB(1, 0), cB + kstep, voffB); PG8_STAGE(PG8_SA(1, 0), cA + kstep, voffA); PG8_STAGE(PG8_SB(1, 1), cB + hsB + kstep, voffB);
        PG8_WAIT_V(6); PG8_BAR;
    } else {
        PG8_STAGE(PG8_SB(0, 0), cB, voffB); PG8_STAGE(PG8_SA(0, 0), cA, voffA); PG8_STAGE(PG8_SB(0, 1), cB + hsB, voffB); PG8_STAGE(PG8_SA(0, 1), cA + hsA, voffA);
        if (wr == 1) PG8_BAR;
        PG8_WAIT_V(4); PG8_BAR;
        PG8_STAGE(PG8_SB(1, 0), cB + kstep, voffB); PG8_STAGE(PG8_SA(1, 0), cA + kstep, voffA); PG8_STAGE(PG8_SB(1, 1), cB + hsB + kstep, voffB);
        PG8_WAIT_V(6); PG8_BAR;
    }
    for (;;) {
        const bool has_next = S.next(ui + 1, nxt);
        const char* nA = has_next ? S.a_ptr(g, nxt) : cA; const char* nB = has_next ? S.b_ptr(g, nxt) : cB;
        for (int t = 0; t < nt; t += 2) {
            const bool last = (t == nt - 2);
            const char* a1 = cA + (size_t)(t + 1) * kstep;
            const char* a2 = last ? nA : cA + (size_t)(t + 2) * kstep; const char* b2 = last ? nB : cB + (size_t)(t + 2) * kstep;
            const char* a3 = a2 + kstep; const char* b3 = b2 + kstep;
            if (last && has_next) S.a_ready(nxt);
            if constexpr (SP2) {
            PG8_LDB(B0, 0, 0); PG8_LDB(B1, 0, 1); PG8_SCHED; PG8_LDA(At, 0, 0); PG8_STAGE(PG8_SA(1, 1), a1 + hsA, voffA);
            PG8_WAIT_V(8); PG8_WAIT_L(0); PG8_BAR; PG8_MMA(0, 0, At, B0); PG8_MMA(0, 1, At, B1); PG8_BAR; PG8_SCHED;
            PG8_LDA(At, 0, 1); PG8_STAGE(PG8_SB(0, 0), b2, voffB); PG8_STAGE(PG8_SB(0, 1), b2 + hsB, voffB); PG8_STAGE(PG8_SA(0, 0), a2, voffA);
            PG8_WAIT_V(8); PG8_WAIT_L(0); PG8_BAR; PG8_MMA(1, 0, At, B0); PG8_MMA(1, 1, At, B1); PG8_BAR; PG8_SCHED;
            PG8_LDB(B0, 1, 0); PG8_LDB(B1, 1, 1); PG8_SCHED; PG8_LDA(At, 1, 0); PG8_STAGE(PG8_SA(0, 1), a2 + hsA, voffA);
            PG8_WAIT_V(8); PG8_WAIT_L(0); PG8_BAR; PG8_MMA(0, 0, At, B0); PG8_MMA(0, 1, At, B1); PG8_BAR; PG8_SCHED;
            PG8_LDA(At, 1, 1); PG8_STAGE(PG8_SB(1, 0), b3, voffB); PG8_STAGE(PG8_SB(1, 1), b3 + hsB, voffB); PG8_STAGE(PG8_SA(1, 0), a3, voffA);
            PG8_WAIT_V(8); PG8_WAIT_L(0); PG8_BAR; PG8_MMA(1, 0, At, B0); PG8_MMA(1, 1, At, B1); PG8_BAR; PG8_SCHED;
            } else {
            PG8_LDB(B0, 0, 0); PG8_SCHED; PG8_LDA(At, 0, 0); PG8_STAGE(PG8_SA(1, 1), a1 + hsA, voffA);
            PG8_WAIT_L(8); PG8_BAR; PG8_WAIT_L(0); PG8_MMA(0, 0, At, B0); PG8_BAR; PG8_SCHED;
            PG8_LDB(B1, 0, 1); PG8_STAGE(PG8_SB(0, 0), b2, voffB);
            PG8_BAR; PG8_WAIT_L(0); PG8_MMA(0, 1, At, B1); PG8_BAR;
            PG8_LDA(At, 0, 1); PG8_STAGE(PG8_SA(0, 0), a2, voffA);
            PG8_BAR; PG8_WAIT_L(0); PG8_MMA(1, 0, At, B0); PG8_BAR; PG8_SCHED;
            PG8_STAGE(PG8_SB(0, 1), b2 + hsB, voffB);
            PG8_WAIT_V(6); PG8_BAR; PG8_MMA(1, 1, At, B1); PG8_BAR;
            PG8_LDB(B0, 1, 0); PG8_SCHED; PG8_LDA(At, 1, 0); PG8_STAGE(PG8_SA(0, 1), a2 + hsA, voffA);
            PG8_WAIT_L(8); PG8_BAR; PG8_WAIT_L(0); PG8_MMA(0, 0, At, B0); PG8_BAR; PG8_SCHED;
            PG8_LDB(B1, 1, 1); PG8_STAGE(PG8_SB(1, 0), b3, voffB);
            PG8_BAR; PG8_WAIT_L(0); PG8_MMA(0, 1, At, B1); PG8_BAR;
            PG8_LDA(At, 1, 1); PG8_STAGE(PG8_SA(1, 0), a3, voffA);
            PG8_BAR; PG8_WAIT_L(0); PG8_MMA(1, 0, At, B0); PG8_BAR; PG8_SCHED;
            PG8_STAGE(PG8_SB(1, 1), b3 + hsB, voffB);
            PG8_WAIT_V(6); PG8_BAR; PG8_MMA(1, 1, At, B1); PG8_BAR;
            }
        }
        if constexpr (ALIGN_EPI) { if (wr == 0) PG8_BAR; }
        if constexpr (!Epi::AFTER_DRAIN) { E(acc, cur, wr, wc, fr, fq); S.done(cur); }
        if (!has_next) break;
#pragma unroll
        for (int a = 0; a < 2; ++a)
#pragma unroll
            for (int b = 0; b < 2; ++b)
#pragma unroll
                for (int m = 0; m < 4; ++m)
#pragma unroll
                    for (int n = 0; n < 2; ++n) acc[a][b][m][n] = (f32x4){0.f, 0.f, 0.f, 0.f};
        cur = nxt; cA = nA; cB = nB; ++ui;
        if constexpr (ALIGN_EPI) { if (wr == 1) PG8_BAR; }
    }
    PG8_WAIT_V(0);
    if constexpr (!ALIGN_EPI) { if (wr == 0) PG8_BAR; }
    PG8_BAR;
    if constexpr (Epi::AFTER_DRAIN) { E.fused(acc, cur, wr, wc, fr, fq, lds, wid, lane); S.done(cur); }
#undef PG8_SA
#undef PG8_SB
#undef PG8_STAGE
#undef PG8_LDA
#undef PG8_LDB
#undef PG8_MMA
#undef PG8_WAIT_V
#undef PG8_WAIT_L
#undef PG8_BAR
#undef PG8_SCHED
}
}


#define LAS __attribute__((address_space(3)))
typedef unsigned short bf16;
typedef unsigned v4u __attribute__((ext_vector_type(4)));
typedef unsigned v2u __attribute__((ext_vector_type(2)));
typedef float f32x4 __attribute__((ext_vector_type(4)));
typedef float f32x2 __attribute__((ext_vector_type(2)));
typedef float f32x16 __attribute__((ext_vector_type(16)));
typedef short bf16x8 __attribute__((ext_vector_type(8)));
typedef short s16x4 __attribute__((ext_vector_type(4)));
typedef __bf16 bf16x2_t __attribute__((ext_vector_type(2)));

constexpr int NB = 8, SEQ = 4096, DM = 1024, MTOK = NB * SEQ;
constexpr int NIN = 2840, NINP = 3072, NSEG = NINP / 64, DFF = 2816, NGU = 2 * DFF;
constexpr float EPS = 1e-6f;
constexpr float LOG2E = 1.4426950408889634f;
constexpr int NTHREADS = 512, NWAVES = 8;
constexpr int LDS_BYTES = 147456 + 256;
constexpr int XB_LDS_OFF = 147456;
constexpr int HB_OFF = 131072;

constexpr size_t MiB = 1u << 20;
constexpr size_t WS_MOD = 0, WS_BIAS1 = 256 * 1024, WS_BAR = 512 * 1024, BAR_BYTES = 16384;
constexpr size_t WS_BT_IN = 1 * MiB, WS_BT_OUT = 7 * MiB, WS_BT_GU = 9 * MiB, WS_BT_DN = 20 * MiB, WS_BT_C1 = 26 * MiB;
constexpr size_t WS_HID = 28 * MiB, WS_KCN = 36 * MiB, WS_VCT = 36 * MiB + 512 * 1024, WS_GATES = 37 * MiB;
constexpr size_t WS_GTAIL = 40 * MiB, WS_GHEAD = 43 * MiB, WS_UHEAD = 46 * MiB;
constexpr size_t WS_KSN = 50 * MiB, WS_KWN = 58 * MiB, WS_VST = 66 * MiB, WS_VWT = 74 * MiB, WS_QN = 82 * MiB;
constexpr size_t WS_X1B = 50 * MiB;
constexpr size_t WS_XN = 114 * MiB, WS_MIXED = 178 * MiB, WS_PROJ = 242 * MiB, WS_H = WS_PROJ, WS_END = 434 * MiB;

struct Args { const float* in[26]; float* out; unsigned char* ws; };

#define LDS_WAIT() asm volatile("s_waitcnt lgkmcnt(0)" ::: "memory")
__device__ __forceinline__ unsigned f2bf(float f) { unsigned u = __builtin_bit_cast(unsigned, f); return (u + 0x7fffu + ((u >> 16) & 1u)) >> 16; }
__device__ __forceinline__ unsigned pk2(float lo, float hi) { f32x2 v = {lo, hi}; bf16x2_t b = __builtin_convertvector(v, bf16x2_t); return __builtin_bit_cast(unsigned, b); }
__device__ __forceinline__ float bf2f(unsigned short h) { return __builtin_bit_cast(float, (unsigned)h << 16); }
__device__ __forceinline__ float bflo(unsigned w) { return __builtin_bit_cast(float, w << 16); }
__device__ __forceinline__ float bfhi(unsigned w) { return __builtin_bit_cast(float, w & 0xffff0000u); }
__device__ __forceinline__ float wave_sum(float v) {
#pragma unroll
    for (int o = 1; o < 64; o <<= 1) v += __shfl_xor(v, o);
    return v;
}
__device__ __forceinline__ float silu_f(float x) { return x * __builtin_amdgcn_rcpf(1.0f + __builtin_amdgcn_exp2f(-LOG2E * x)); }
__device__ __forceinline__ float gelu_tanh_f(float x) { const float y = 0.7978845608028654f * (x + 0.044715f * x * x * x); const float t = 1.0f - 2.0f * __builtin_amdgcn_rcpf(__builtin_amdgcn_exp2f(2.0f * LOG2E * y) + 1.0f); return 0.5f * x * (1.0f + t); }

#define XB_TMO      128
#define XB_XCNT(j)  (256  + 64 * (j))
#define XB_XSUB(j)  (1280 + 64 * (j))
#define XB_XGEN(j)  (2304 + 64 * (j))
#define XB_TOP      3328
#define XB_TOPGEN   3392
#define XCD_BAR_WORDS 3456
#define XB_SPIN_CAP (1u << 18)

__device__ __forceinline__ unsigned xb_ld(unsigned* p)              { return __hip_atomic_load(p, __ATOMIC_RELAXED, __HIP_MEMORY_SCOPE_AGENT); }
__device__ __forceinline__ unsigned xb_add(unsigned* p, unsigned v) { return __hip_atomic_fetch_add(p, v, __ATOMIC_RELAXED, __HIP_MEMORY_SCOPE_AGENT); }
__device__ __forceinline__ unsigned xb_xcc_id() { return (unsigned)__builtin_amdgcn_s_getreg((3 << 11) | 20) & 0xFu; }
#define XB_SPIN(cond, bar) do { unsigned _sp = 0; while (cond) { __builtin_amdgcn_s_sleep(1); \
    if ((++_sp & 255u) == 0u) { if (xb_ld(&(bar)[XB_TMO])) break; if (_sp > XB_SPIN_CAP) { atomicAdd(&(bar)[XB_TMO], 1u); break; } } } } while (0)

struct XcdBarrier {
    unsigned* bar; unsigned x;
    volatile LAS unsigned* st;
};

__device__ __forceinline__ XcdBarrier xcd_barrier_post(unsigned* bar, volatile LAS unsigned* st) {
    XcdBarrier b; b.bar = bar; b.x = xb_xcc_id(); b.st = st;
    if (threadIdx.x == 0) (void)xb_add(&bar[XB_XCNT(b.x)], 1u);
    return b;
}
__device__ __forceinline__ void xcd_barrier_complete(unsigned* bar, unsigned x, unsigned& nloc, unsigned& nx) {
    const unsigned G = gridDim.x * gridDim.y * gridDim.z;
    unsigned sum, cnt, mine, sp = 0u;
    for (;;) {
        sum = 0u; cnt = 0u; mine = 0u;
#pragma unroll
        for (unsigned j = 0; j < 16; ++j) { const unsigned c = xb_ld(&bar[XB_XCNT(j)]); sum += c; cnt += (c > 0u) ? 1u : 0u; mine = (j == x) ? c : mine; }
        if (sum == G) break;
        __builtin_amdgcn_s_sleep(1);
        if ((++sp & 255u) == 0u) { if (xb_ld(&bar[XB_TMO])) break; if (sp > XB_SPIN_CAP) { atomicAdd(&bar[XB_TMO], 1u); break; } }
    }
    nloc = mine > 0u ? mine : 1u; nx = cnt > 0u ? cnt : 1u;
}

__device__ __forceinline__ void xcd_barrier(const XcdBarrier& b) {
    asm volatile("s_waitcnt vmcnt(0)" ::: "memory");
    __syncthreads();
    if (threadIdx.x == 0) {
        unsigned* bar = b.bar;
        __builtin_amdgcn_s_waitcnt(0);
        unsigned nloc = b.st[0], nx = b.st[1];
        if (nloc == 0u) { xcd_barrier_complete(bar, b.x, nloc, nx); b.st[0] = nloc; b.st[1] = nx; }
        const unsigned old = xb_add(&bar[XB_XSUB(b.x)], 1u);
        const unsigned gen = old / nloc;
        if (old + 1u == (gen + 1u) * nloc) {
            __builtin_amdgcn_fence(__ATOMIC_RELEASE, "agent");
            asm volatile("s_waitcnt vmcnt(0)" ::: "memory");
            const unsigned og = xb_add(&bar[XB_TOP], 1u);
            const unsigned tg = og / nx;
            if (og + 1u == (tg + 1u) * nx) xb_add(&bar[XB_TOPGEN], 1u);
            else XB_SPIN(xb_ld(&bar[XB_TOPGEN]) == tg, bar);
            __builtin_amdgcn_fence(__ATOMIC_ACQUIRE, "agent");
            xb_add(&bar[XB_XGEN(b.x)], 1u);
            asm volatile("s_waitcnt vmcnt(0)" ::: "memory");
        } else {
            XB_SPIN(xb_ld(&bar[XB_XGEN(b.x)]) == gen, bar);
            __builtin_amdgcn_fence(__ATOMIC_ACQUIRE, "agent");
            asm volatile("s_waitcnt vmcnt(0)" ::: "memory");
        }
    }
    __syncthreads();
}


__device__ __forceinline__ void transpose_item(const float* __restrict__ W, int K, int N, bf16* WT, int k0, int n0, int drow0, LAS float* scr, int lane) {
    const int nn = n0 + (lane & 31);
#pragma unroll 8
    for (int i = 0; i < 32; ++i) { const int kk = 2 * i + (lane >> 5); scr[kk * 33 + (lane & 31)] = (nn < N) ? W[(size_t)(k0 + kk) * N + nn] : 0.0f; }
    LDS_WAIT(); asm volatile("" ::: "memory");
    const int c = lane & 7;
#pragma unroll
    for (int j = 0; j < 4; ++j) { const int n = (lane >> 3) + 8 * j; const LAS float* s = scr + (8 * c) * 33 + n;
        v4u o; o.x = pk2(s[0 * 33], s[1 * 33]); o.y = pk2(s[2 * 33], s[3 * 33]); o.z = pk2(s[4 * 33], s[5 * 33]); o.w = pk2(s[6 * 33], s[7 * 33]);
        *(v4u*)(WT + (size_t)(drow0 + n) * K + k0 + 8 * c) = o; }
    LDS_WAIT(); asm volatile("" ::: "memory");
}

__device__ __forceinline__ void phase0(const Args& a, LAS unsigned char* lds) {
    int tid_ = threadIdx.x; asm volatile("" : "+v"(tid_)); const int tid = tid_, lane = tid & 63, wave = tid >> 6, G = gridDim.x;
    unsigned char* ws = a.ws;
    LAS float* SC = (LAS float*)lds;
    LAS float* RED = (LAS float*)(lds + 32768);
    float* mod = (float*)(ws + WS_MOD);
    float* bias1 = (float*)(ws + WS_BIAS1);
    for (int it = blockIdx.x; it < 208; it += G) {
        const int cl = tid & 31, sl = tid >> 5;
        if (it < 192) {
            const float* c = a.in[1]; const float* w_ada = a.in[2]; const float* b_ada = a.in[3];
            for (int i = tid; i < 8192; i += NTHREADS) { const float v = c[i]; SC[i] = silu_f(v); }
            __syncthreads();
            float acc[8];
#pragma unroll
            for (int b = 0; b < 8; ++b) acc[b] = 0.f;
            const int col = it * 32 + cl;
#pragma unroll 8
            for (int k = sl * 64; k < sl * 64 + 64; ++k) {
                const float w = w_ada[(size_t)k * 6144 + col];
#pragma unroll
                for (int b = 0; b < 8; ++b) acc[b] += SC[b * 1024 + k] * w;
            }
#pragma unroll
            for (int b = 0; b < 8; ++b) RED[(sl * 8 + b) * 32 + cl] = acc[b];
            __syncthreads();
            if (tid < 256) { const int b = tid >> 5; float s = 0.f;
#pragma unroll
              for (int w = 0; w < 16; ++w) s += RED[(w * 8 + b) * 32 + cl];
              mod[b * 6144 + it * 32 + cl] = s + b_ada[it * 32 + cl]; }
            __syncthreads();
        } else {
            const int q = it - 192, kv = q >> 3, cgp = q & 7;
            const float* pos = a.in[11 + kv]; const float* w1 = a.in[13 + 2 * kv];
            float acc = 0.f;
#pragma unroll 8
            for (int k = sl * 128; k < sl * 128 + 128; ++k) acc += pos[k] * w1[(size_t)k * 256 + cgp * 32 + cl];
            RED[sl * 32 + cl] = acc;
            __syncthreads();
            if (tid < 32) { float s = 0.f;
#pragma unroll
                for (int w = 0; w < 16; ++w) s += RED[w * 32 + tid];
                bias1[kv * 256 + cgp * 32 + tid] = s; }
            __syncthreads();
        }
    }
}

__device__ __forceinline__ void weight_copies(const Args& a, LAS unsigned char* lds) {
    int tid_ = threadIdx.x; asm volatile("" : "+v"(tid_)); const int tid = tid_, lane = tid & 63, wave = tid >> 6, G = gridDim.x;
    unsigned char* ws = a.ws;
    LAS float* scr = (LAS float*)(lds + 49152 + wave * 8448);
    const int gw = blockIdx.x * NWAVES + wave, NGW = G * NWAVES;
    constexpr int I_IN = 16 * 96, I_OUT = 16 * 32, I_G = 16 * 88, I_D = 44 * 32, I_C = 32 * 8;
    constexpr int TOT = I_IN + I_OUT + 2 * I_G + I_D + 2 * I_C;
    for (int it = gw; it < TOT; it += NGW) {
        int r = it;
        if (r < I_IN) { const int kb = r / 96, nb = r % 96; transpose_item(a.in[5], 1024, NIN, (bf16*)(ws + WS_BT_IN), 64 * kb, 32 * nb, 32 * nb, scr, lane); continue; } r -= I_IN;
        if (r < I_OUT) { const int kb = r / 32, nb = r % 32; transpose_item(a.in[20], 1024, 1024, (bf16*)(ws + WS_BT_OUT), 64 * kb, 32 * nb, 32 * nb, scr, lane); continue; } r -= I_OUT;
        if (r < I_G) { const int kb = r / 88, nb = r % 88, n0 = 32 * nb; transpose_item(a.in[22], 1024, DFF, (bf16*)(ws + WS_BT_GU), 64 * kb, n0, 256 * (n0 >> 7) + (n0 & 127), scr, lane); continue; } r -= I_G;
        if (r < I_G) { const int kb = r / 88, nb = r % 88, n0 = 32 * nb; transpose_item(a.in[23], 1024, DFF, (bf16*)(ws + WS_BT_GU), 64 * kb, n0, 256 * (n0 >> 7) + (n0 & 127) + 128, scr, lane); continue; } r -= I_G;
        if (r < I_D) { const int kb = r / 32, nb = r % 32; transpose_item(a.in[25], DFF, 1024, (bf16*)(ws + WS_BT_DN), 64 * kb, 32 * nb, 32 * nb, scr, lane); continue; } r -= I_D;
        if (r < I_C) { const int kb = r / 8, nb = r % 8; transpose_item(a.in[13], 2048, 256, (bf16*)(ws + WS_BT_C1), 64 * kb, 32 * nb, 32 * nb, scr, lane); continue; } r -= I_C;
        { const int kb = r / 8, nb = r % 8; transpose_item(a.in[15], 2048, 256, (bf16*)(ws + WS_BT_C1) + 256 * 2048, 64 * kb, 32 * nb, 32 * nb, scr, lane); }
    }
}

__device__ __forceinline__ void norm_rows(const float* __restrict__ src, const float* __restrict__ gamma, const float* __restrict__ mod, int sh_off, int sc_off, bf16* dst) {
    int tid_ = threadIdx.x; asm volatile("" : "+v"(tid_)); const int tid = tid_, lane = tid & 63, wave = tid >> 6;
    const int gw = blockIdx.x * NWAVES + wave, NGW = gridDim.x * NWAVES;
    const int per = (MTOK + NGW - 1) / NGW;
    const int r0 = gw * per, r1 = (r0 + per) < MTOK ? (r0 + per) : MTOK;
    if (r0 >= r1) return;
    f32x4 ga[4], sh[4];
    int bcur = -1;
    f32x4 va[4], vb[4];
    { const f32x4* xr = (const f32x4*)(src + (size_t)r0 * DM) + lane;
#pragma unroll
      for (int j = 0; j < 4; ++j) va[j] = xr[64 * j]; }
    { const int rr = (r0 + 1 < r1) ? r0 + 1 : r0; const f32x4* xr = (const f32x4*)(src + (size_t)rr * DM) + lane;
#pragma unroll
      for (int j = 0; j < 4; ++j) vb[j] = xr[64 * j]; }
    for (int row = r0; row < r1; ++row) {
        f32x4 v[4];
#pragma unroll
        for (int j = 0; j < 4; ++j) { v[j] = va[j]; va[j] = vb[j]; }
        { const int rr = (row + 2 < r1) ? row + 2 : row; const f32x4* xr = (const f32x4*)(src + (size_t)rr * DM) + lane;
#pragma unroll
          for (int j = 0; j < 4; ++j) vb[j] = xr[64 * j]; }
        const int b = row >> 12;
        if (b != bcur) { bcur = b; const float* mb = mod + b * 6144;
#pragma unroll
            for (int j = 0; j < 4; ++j) { const int col = 4 * lane + 256 * j; const f32x4 gv = *(const f32x4*)(gamma + col), sc = *(const f32x4*)(mb + sc_off + col);
                sh[j] = *(const f32x4*)(mb + sh_off + col); ga[j] = gv * (1.0f + sc); } }
        float ss = 0.f;
#pragma unroll
        for (int j = 0; j < 4; ++j) ss += v[j][0] * v[j][0] + v[j][1] * v[j][1] + v[j][2] * v[j][2] + v[j][3] * v[j][3];
        ss = wave_sum(ss);
        const float rstd = rsqrtf(ss * (1.0f / DM) + EPS);
#pragma unroll
        for (int j = 0; j < 4; ++j) {
            const int col = 4 * lane + 256 * j;
            f32x4 y;
#pragma unroll
            for (int e = 0; e < 4; ++e) y[e] = (v[j][e] * rstd) * ga[j][e] + sh[j][e];
            v2u o; o.x = pk2(y[0], y[1]); o.y = pk2(y[2], y[3]);
            *(v2u*)(dst + (size_t)row * DM + col) = o;
        }
    }
}

__device__ __forceinline__ void norm_rows_b(const bf16* __restrict__ src, const float* __restrict__ gamma, const float* __restrict__ mod, int sh_off, int sc_off, bf16* dst) {
    int tid_ = threadIdx.x; asm volatile("" : "+v"(tid_)); const int tid = tid_, lane = tid & 63, wave = tid >> 6;
    const int gw = blockIdx.x * NWAVES + wave, NGW = gridDim.x * NWAVES;
    const int per = (MTOK + NGW - 1) / NGW;
    const int r0 = gw * per, r1 = (r0 + per) < MTOK ? (r0 + per) : MTOK;
    if (r0 >= r1) return;
    f32x4 ga[4], sh[4];
    int bcur = -1;
    v4u va[2], vb[2];
    { const v4u* xr = (const v4u*)(src + (size_t)r0 * DM) + lane; va[0] = xr[0]; va[1] = xr[64]; }
    { const int rr = (r0 + 1 < r1) ? r0 + 1 : r0; const v4u* xr = (const v4u*)(src + (size_t)rr * DM) + lane; vb[0] = xr[0]; vb[1] = xr[64]; }
    for (int row = r0; row < r1; ++row) {
        v4u raw[2]; raw[0] = va[0]; raw[1] = va[1]; va[0] = vb[0]; va[1] = vb[1];
        { const int rr = (row + 2 < r1) ? row + 2 : row; const v4u* xr = (const v4u*)(src + (size_t)rr * DM) + lane; vb[0] = xr[0]; vb[1] = xr[64]; }
        const int b = row >> 12;
        if (b != bcur) { bcur = b; const float* mb = mod + b * 6144;
#pragma unroll
            for (int j = 0; j < 4; ++j) { const int col = 512 * (j >> 1) + 8 * lane + 4 * (j & 1); const f32x4 gv = *(const f32x4*)(gamma + col), sc = *(const f32x4*)(mb + sc_off + col);
                sh[j] = *(const f32x4*)(mb + sh_off + col); ga[j] = gv * (1.0f + sc); } }
        f32x4 v[4];
#pragma unroll
        for (int h = 0; h < 2; ++h) { v[2 * h] = (f32x4){bflo(raw[h].x), bfhi(raw[h].x), bflo(raw[h].y), bfhi(raw[h].y)}; v[2 * h + 1] = (f32x4){bflo(raw[h].z), bfhi(raw[h].z), bflo(raw[h].w), bfhi(raw[h].w)}; }
        float ss = 0.f;
#pragma unroll
        for (int j = 0; j < 4; ++j) ss += v[j][0] * v[j][0] + v[j][1] * v[j][1] + v[j][2] * v[j][2] + v[j][3] * v[j][3];
        ss = wave_sum(ss);
        const float rstd = rsqrtf(ss * (1.0f / DM) + EPS);
#pragma unroll
        for (int h = 0; h < 2; ++h) {
            f32x4 y0, y1;
#pragma unroll
            for (int e = 0; e < 4; ++e) { y0[e] = (v[2 * h][e] * rstd) * ga[2 * h][e] + sh[2 * h][e]; y1[e] = (v[2 * h + 1][e] * rstd) * ga[2 * h + 1][e] + sh[2 * h + 1][e]; }
            v4u o; o.x = pk2(y0[0], y0[1]); o.y = pk2(y0[2], y0[3]); o.z = pk2(y1[0], y1[1]); o.w = pk2(y1[2], y1[3]);
            *(v4u*)(dst + (size_t)row * DM + 512 * h + 8 * lane) = o;
        }
    }
}

__device__ __forceinline__ float dpp_shr1(float v) { return __builtin_bit_cast(float, __builtin_amdgcn_update_dpp(0, __builtin_bit_cast(int, v), 0x111, 0xf, 0xf, true)); }
__device__ __forceinline__ float dpp_shr2(float v) { return __builtin_bit_cast(float, __builtin_amdgcn_update_dpp(0, __builtin_bit_cast(int, v), 0x112, 0xf, 0xf, true)); }
__device__ __forceinline__ unsigned dpp_ror8(unsigned v) { return (unsigned)__builtin_amdgcn_update_dpp(0, (int)v, 0x128, 0xf, 0xf, false); }
struct EpiProj {
    static constexpr bool PERM = true, PERM2 = true, AFTER_DRAIN = false;
    bf16* P; bf16* QN; bf16* KSN; bf16* KWN; float* gates; const float* gq; const float* gs; const float* gw; const float* bgate;
    __device__ __forceinline__ void operator()(const f32x4 (&acc)[2][2][4][2], const pg8::Unit& u, int wr, int wc, int fr, int fq) const {
        const bool lo = fr < 8;
        const int colb = u.pn * 256 + wc * 64, seg = colb >> 6, d = (lo ? 0 : 32) + 8 * fq;
        const bool keep = (colb + d) < NIN;
        const int rowb = u.pm * 256 + wr * 64 + (fr & 7);
        bf16* base = P; int ns = NSEG, sidx = seg; const float* gm = nullptr; float mult = 1.0f;
        if (seg < 8) { base = QN; ns = 8; gm = gq; mult = 0.125f * LOG2E; }
        else if (seg == 12 || seg == 13) { base = KSN; ns = 2; sidx = seg - 12; gm = gs; }
        else if (seg == 16 || seg == 17) { base = KWN; ns = 2; sidx = seg - 16; gm = gw; }
        f32x4 g00 = {1.f, 1.f, 1.f, 1.f}, g01 = g00, g10 = g00, g11 = g00;
        if (gm) { g00 = *(const f32x4*)(gm + 8 * fq); g01 = *(const f32x4*)(gm + 8 * fq + 4); g10 = *(const f32x4*)(gm + 32 + 8 * fq); g11 = *(const f32x4*)(gm + 32 + 8 * fq + 4); }
#pragma unroll
        for (int ai = 0; ai < 2; ++ai)
#pragma unroll
            for (int m = 0; m < 4; ++m) {
                f32x4 a0 = acc[ai][0][m][0], a1 = acc[ai][0][m][1], b0 = acc[ai][1][m][0], b1 = acc[ai][1][m][1];
                const int rown = u.pm * 256 + wr * 64 + ai * 128 + m * 16 + fr;
                if (gm) {
                    float ss = 0.f;
#pragma unroll
                    for (int e = 0; e < 4; ++e) ss += a0[e] * a0[e] + a1[e] * a1[e] + b0[e] * b0[e] + b1[e] * b1[e];
                    ss += __shfl_xor(ss, 16); ss += __shfl_xor(ss, 32);
                    const float rs = rsqrtf(ss * (1.0f / 64.0f) + EPS) * mult;
                    a0 = a0 * rs * g00; a1 = a1 * rs * g01; b0 = b0 * rs * g10; b1 = b1 * rs * g11;
                } else if (seg == 20 && fq < 3) {
                    const f32x4 bg0 = *(const f32x4*)(bgate + 8 * fq), bg1 = *(const f32x4*)(bgate + 8 * fq + 4);
                    f32x4 s0, s1;
#pragma unroll
                    for (int e = 0; e < 4; ++e) { s0[e] = __builtin_amdgcn_rcpf(1.0f + __builtin_amdgcn_exp2f(-LOG2E * (a0[e] + bg0[e]))); s1[e] = __builtin_amdgcn_rcpf(1.0f + __builtin_amdgcn_exp2f(-LOG2E * (a1[e] + bg1[e]))); }
                    *(f32x4*)(gates + (size_t)rown * 24 + 8 * fq) = s0; *(f32x4*)(gates + (size_t)rown * 24 + 8 * fq + 4) = s1;
                }
                v4u p0, p1; p0.x = pk2(a0[0], a0[1]); p0.y = pk2(a0[2], a0[3]); p0.z = pk2(a1[0], a1[1]); p0.w = pk2(a1[2], a1[3]);
                p1.x = pk2(b0[0], b0[1]); p1.y = pk2(b0[2], b0[3]); p1.z = pk2(b1[0], b1[1]); p1.w = pk2(b1[2], b1[3]);
                const unsigned sx = lo ? p1.x : p0.x, sy = lo ? p1.y : p0.y, sz = lo ? p1.z : p0.z, sw = lo ? p1.w : p0.w;
                v4u rc; rc.x = dpp_ror8(sx); rc.y = dpp_ror8(sy); rc.z = dpp_ror8(sz); rc.w = dpp_ror8(sw);
                v4u s1, s2;
                s1.x = lo ? p0.x : rc.x; s1.y = lo ? p0.y : rc.y; s1.z = lo ? p0.z : rc.z; s1.w = lo ? p0.w : rc.w;
                s2.x = lo ? rc.x : p1.x; s2.y = lo ? rc.y : p1.y; s2.z = lo ? rc.z : p1.z; s2.w = lo ? rc.w : p1.w;
                const int r = rowb + ai * 128 + m * 16, b = r >> 12, t = r & 4095;
                bf16* dst = base + ((size_t)(b * ns + sidx) * SEQ + t) * 64 + d;
                if (keep) { __builtin_nontemporal_store(s1, (v4u*)dst); __builtin_nontemporal_store(s2, (v4u*)(dst + 8 * 64)); }
            }
    }
};
struct EpiRes {
    static constexpr bool PERM = true, PERM2 = false, AFTER_DRAIN = false;
    const float* base; float* out; const float* mod; int goff;
    __device__ __forceinline__ void operator()(const f32x4 (&acc)[2][2][4][2], const pg8::Unit& u, int wr, int wc, int fr, int fq) const {
        const int row0 = u.pm * 256 + wr * 64 + fr, col0 = u.pn * 256 + wc * 32 + 8 * fq;
        const int b = (u.pm * 256) >> 12;
        f32x4 gv[2][2];
#pragma unroll
        for (int bj = 0; bj < 2; ++bj)
#pragma unroll
            for (int n = 0; n < 2; ++n) gv[bj][n] = *(const f32x4*)(mod + b * 6144 + goff + col0 + bj * 128 + n * 4);
#pragma unroll
        for (int ai = 0; ai < 2; ++ai) {
            f32x4 xv[4][2][2];
#pragma unroll
            for (int m = 0; m < 4; ++m) { const size_t r = (size_t)(row0 + ai * 128 + m * 16);
#pragma unroll
                for (int bj = 0; bj < 2; ++bj)
#pragma unroll
                    for (int n = 0; n < 2; ++n) xv[m][bj][n] = *(const f32x4*)(base + r * DM + col0 + bj * 128 + n * 4); }
#pragma unroll
            for (int m = 0; m < 4; ++m) { const size_t r = (size_t)(row0 + ai * 128 + m * 16);
#pragma unroll
                for (int bj = 0; bj < 2; ++bj)
#pragma unroll
                    for (int n = 0; n < 2; ++n) *(f32x4*)(out + r * DM + col0 + bj * 128 + n * 4) = xv[m][bj][n] + gv[bj][n] * acc[ai][bj][m][n]; }
        }
    }
};
struct EpiResB {
    static constexpr bool PERM = true, PERM2 = false, AFTER_DRAIN = false;
    const float* base; bf16* out; const float* mod; int goff;
    __device__ __forceinline__ void operator()(const f32x4 (&acc)[2][2][4][2], const pg8::Unit& u, int wr, int wc, int fr, int fq) const {
        const int row0 = u.pm * 256 + wr * 64 + fr, col0 = u.pn * 256 + wc * 32 + 8 * fq;
        const int b = (u.pm * 256) >> 12;
        f32x4 gv[2][2];
#pragma unroll
        for (int bj = 0; bj < 2; ++bj)
#pragma unroll
            for (int n = 0; n < 2; ++n) gv[bj][n] = *(const f32x4*)(mod + b * 6144 + goff + col0 + bj * 128 + n * 4);
#pragma unroll
        for (int ai = 0; ai < 2; ++ai) {
            f32x4 xv[4][2][2];
#pragma unroll
            for (int m = 0; m < 4; ++m) { const size_t r = (size_t)(row0 + ai * 128 + m * 16);
#pragma unroll
                for (int bj = 0; bj < 2; ++bj)
#pragma unroll
                    for (int n = 0; n < 2; ++n) xv[m][bj][n] = *(const f32x4*)(base + r * DM + col0 + bj * 128 + n * 4); }
#pragma unroll
            for (int m = 0; m < 4; ++m) { const size_t r = (size_t)(row0 + ai * 128 + m * 16);
#pragma unroll
                for (int bj = 0; bj < 2; ++bj) { const f32x4 v0 = xv[m][bj][0] + gv[bj][0] * acc[ai][bj][m][0], v1 = xv[m][bj][1] + gv[bj][1] * acc[ai][bj][m][1];
                    v4u w; w.x = pk2(v0[0], v0[1]); w.y = pk2(v0[2], v0[3]); w.z = pk2(v1[0], v1[1]); w.w = pk2(v1[2], v1[3]);
                    *(v4u*)(out + r * DM + col0 + bj * 128) = w; } }
        }
    }
};
struct EpiResF {
    static constexpr bool PERM = true, PERM2 = false, AFTER_DRAIN = false;
    const bf16* base; float* out; const float* mod; int goff;
    __device__ __forceinline__ void operator()(const f32x4 (&acc)[2][2][4][2], const pg8::Unit& u, int wr, int wc, int fr, int fq) const {
        const int row0 = u.pm * 256 + wr * 64 + fr, col0 = u.pn * 256 + wc * 32 + 8 * fq;
        const int b = (u.pm * 256) >> 12;
        f32x4 gv[2][2];
#pragma unroll
        for (int bj = 0; bj < 2; ++bj)
#pragma unroll
            for (int n = 0; n < 2; ++n) gv[bj][n] = *(const f32x4*)(mod + b * 6144 + goff + col0 + bj * 128 + n * 4);
#pragma unroll
        for (int ai = 0; ai < 2; ++ai) {
            v4u xv[4][2];
#pragma unroll
            for (int m = 0; m < 4; ++m) { const size_t r = (size_t)(row0 + ai * 128 + m * 16);
#pragma unroll
                for (int bj = 0; bj < 2; ++bj) xv[m][bj] = *(const v4u*)(base + r * DM + col0 + bj * 128); }
#pragma unroll
            for (int m = 0; m < 4; ++m) { const size_t r = (size_t)(row0 + ai * 128 + m * 16);
#pragma unroll
                for (int bj = 0; bj < 2; ++bj) { const v4u x = xv[m][bj];
                    const f32x4 x0 = {bflo(x.x), bfhi(x.x), bflo(x.y), bfhi(x.y)}, x1 = {bflo(x.z), bfhi(x.z), bflo(x.w), bfhi(x.w)};
                    *(f32x4*)(out + r * DM + col0 + bj * 128) = x0 + gv[bj][0] * acc[ai][bj][m][0];
                    *(f32x4*)(out + r * DM + col0 + bj * 128 + 4) = x1 + gv[bj][1] * acc[ai][bj][m][1]; } }
        }
    }
};
struct EpiCmp {
    static constexpr bool PERM = false, PERM2 = false, AFTER_DRAIN = false;
    float* hid; const float* bias1;
    __device__ __forceinline__ void operator()(const f32x4 (&acc)[2][2][4][2], const pg8::Unit& u, int wr, int wc, int fr, int fq) const {
        const int row0 = wr * 64 + fr, col0 = wc * 32 + 4 * fq;
        float* hb = hid + ((size_t)u.pn * 4096 + (size_t)u.pm * 256) * 256;
#pragma unroll
        for (int ai = 0; ai < 2; ++ai)
#pragma unroll
            for (int m = 0; m < 4; ++m) { const int r = row0 + ai * 128 + m * 16;
#pragma unroll
                for (int bj = 0; bj < 2; ++bj)
#pragma unroll
                    for (int n = 0; n < 2; ++n) { const int c = col0 + bj * 128 + n * 16;
                        const f32x4 bv = *(const f32x4*)(bias1 + u.pn * 256 + c); f32x4 v = acc[ai][bj][m][n] + bv;
#pragma unroll
                        for (int e = 0; e < 4; ++e) v[e] = gelu_tanh_f(v[e]);
                        *(f32x4*)(hb + (size_t)r * 256 + c) = v; } }
    }
};
struct CmpOrder {
    int c; const bf16* proj; const bf16* btc1;
    __device__ bool next(int i, pg8::Unit& u) const { if (i > 0 || c >= 32) return false; u.pm = c & 15; u.pn = c >> 4; return true; }
    __device__ __forceinline__ const char* a_ptr(const pg8::Gemm&, const pg8::Unit& u) const { const int b = u.pm >> 1, g = u.pm & 1; return (const char*)(proj + ((size_t)(b * NSEG + 8 + 2 * u.pn + g) * SEQ) * 64); }
    __device__ __forceinline__ const char* b_ptr(const pg8::Gemm&, const pg8::Unit& u) const { return (const char*)(btc1 + (size_t)u.pn * 256 * 2048); }
    __device__ __forceinline__ void a_ready(const pg8::Unit&) const {}
    __device__ __forceinline__ void done(const pg8::Unit&) const {}
};
struct EpiFfn {
    static constexpr bool PERM = true, PERM2 = false, AFTER_DRAIN = false;
    bf16* H; const float* cw; float* gtail; float* ghead; float* uhead; LAS float* hb;
    __device__ __forceinline__ void operator()(const f32x4 (&acc)[2][2][4][2], const pg8::Unit& u, int wr, int wc, int fr, int fq) const {
        int cl_ = wc * 32 + 8 * fq; asm volatile("" : "+v"(cl_));
        const int cl = cl_, ch0 = u.pn * 128 + cl;
        if (fr >= 14) {
#pragma unroll
            for (int ai = 0; ai < 2; ++ai)
#pragma unroll
                for (int m = 0; m < 4; ++m) { const int kk = 8 * ai + 4 * wr + m;
#pragma unroll
                    for (int n = 0; n < 2; ++n) *(LAS f32x4*)(hb + ((kk * 2 + (fr - 14)) * 128 + cl + 4 * n)) = acc[ai][0][m][n]; }
        }
        asm volatile("s_waitcnt lgkmcnt(0)" ::: "memory"); __builtin_amdgcn_s_barrier(); asm volatile("" ::: "memory");
        f32x4 w0[2], w1[2], w2[2];
#pragma unroll
        for (int n = 0; n < 2; ++n) { w0[n] = *(const f32x4*)(cw + ch0 + 4 * n); w1[n] = *(const f32x4*)(cw + DFF + ch0 + 4 * n); w2[n] = *(const f32x4*)(cw + 2 * DFF + ch0 + 4 * n); }
#pragma unroll
        for (int ai = 0; ai < 2; ++ai)
#pragma unroll
            for (int m = 0; m < 4; ++m) { const int kk = 8 * ai + 4 * wr + m; const int rl = 128 * ai + 64 * wr + 16 * m + fr; const size_t r = (size_t)u.pm * 256 + rl;
                f32x4 hv[2];
#pragma unroll
                for (int n = 0; n < 2; ++n) { const f32x4 g0 = acc[ai][0][m][n]; f32x4 g1, g2;
                    g1[0] = dpp_shr1(g0[0]); g1[1] = dpp_shr1(g0[1]); g1[2] = dpp_shr1(g0[2]); g1[3] = dpp_shr1(g0[3]);
                    g2[0] = dpp_shr2(g0[0]); g2[1] = dpp_shr2(g0[1]); g2[2] = dpp_shr2(g0[2]); g2[3] = dpp_shr2(g0[3]);
                    if (fr < 2) { const f32x4 z = {0.f, 0.f, 0.f, 0.f};
                        const f32x4 p15 = kk > 0 ? *(const LAS f32x4*)(hb + (((kk - 1) * 2 + 1) * 128 + cl + 4 * n)) : z;
                        const f32x4 p14 = kk > 0 ? *(const LAS f32x4*)(hb + (((kk - 1) * 2 + 0) * 128 + cl + 4 * n)) : z;
                        if (fr == 0) { g1 = p15; g2 = p14; } else { g2 = p15; } }
                    const f32x4 pre = w0[n] * g2 + w1[n] * g1 + w2[n] * g0; const f32x4 up = acc[ai][1][m][n];
#pragma unroll
                    for (int e = 0; e < 4; ++e) hv[n][e] = silu_f(pre[e]) * up[e];
                    if (kk == 0 && fr < 2) { *(f32x4*)(ghead + ((size_t)u.pm * 2 + fr) * DFF + ch0 + 4 * n) = g0; *(f32x4*)(uhead + ((size_t)u.pm * 2 + fr) * DFF + ch0 + 4 * n) = up; }
                    if (kk == 15 && fr >= 14) *(f32x4*)(gtail + ((size_t)u.pm * 2 + (fr - 14)) * DFF + ch0 + 4 * n) = g0;
                }
                v4u w; w.x = pk2(hv[0][0], hv[0][1]); w.y = pk2(hv[0][2], hv[0][3]); w.z = pk2(hv[1][0], hv[1][1]); w.w = pk2(hv[1][2], hv[1][3]);
                __builtin_nontemporal_store(w, (v4u*)(H + r * DFF + ch0)); }
    }
};

__device__ __forceinline__ void phase3_prep(const Args& a, LAS unsigned char* lds, int pw, int PW) {
    int tid_ = threadIdx.x; asm volatile("" : "+v"(tid_)); const int tid = tid_, lane = tid & 63, wave = tid >> 6;
    unsigned char* ws = a.ws;
    const bf16* __restrict__ proj = (const bf16*)(ws + WS_PROJ);
    {
        bf16* mixed = (bf16*)(ws + WS_MIXED);
        const float* cw = a.in[17]; const float* cg_g = a.in[19];
        const int sub = lane & 7;
        constexpr int NST = NB * 8 * SEQ / 8;
        for (int st0 = pw; st0 < NST; st0 += 2 * PW) {
            v4u rb[2], rc0[2], rx0[2], rc1[2], rx1[2], rc2[2], rx2[2];
#pragma unroll
            for (int u = 0; u < 2; ++u) { const int st1 = st0 + u * PW, st = st1 < NST ? st1 : NST - 1;
                {
                    const int b = st >> 12, cgp = (st >> 9) & 7, t = (st & 511) * 8 + (lane >> 3);
                    const int c = cgp * 64 + sub * 8;
                    const int colB = 1304 + c, colC = 1816 + c, colX = 2328 + c;
                    const bf16* pB = proj + ((size_t)(b * NSEG + (colB >> 6)) * SEQ + t) * 64 + (colB & 63);
                    const bf16* pC = proj + ((size_t)(b * NSEG + (colC >> 6)) * SEQ + t) * 64 + (colC & 63);
                    const bf16* pX = proj + ((size_t)(b * NSEG + (colX >> 6)) * SEQ + t) * 64 + (colX & 63);
                    const v4u z = {0u, 0u, 0u, 0u};
                    rb[u] = *(const v4u*)pB; rc0[u] = *(const v4u*)pC; rx0[u] = *(const v4u*)pX;
                    rc1[u] = t >= 1 ? *(const v4u*)(pC - 64) : z; rx1[u] = t >= 1 ? *(const v4u*)(pX - 64) : z;
                    rc2[u] = t >= 2 ? *(const v4u*)(pC - 128) : z; rx2[u] = t >= 2 ? *(const v4u*)(pX - 128) : z; } }
#pragma unroll
            for (int u = 0; u < 2; ++u) { const int st1 = st0 + u * PW, st = st1 < NST ? st1 : NST - 1;
                {
                    const int b = st >> 12, cgp = (st >> 9) & 7, t = (st & 511) * 8 + (lane >> 3);
                    const int c = cgp * 64 + sub * 8;
                    const f32x4 w0a = *(const f32x4*)(cw + c), w0b = *(const f32x4*)(cw + c + 4), w1a = *(const f32x4*)(cw + 512 + c), w1b = *(const f32x4*)(cw + 512 + c + 4);
                    const f32x4 w2a = *(const f32x4*)(cw + 1024 + c), w2b = *(const f32x4*)(cw + 1024 + c + 4), ga = *(const f32x4*)(cg_g + c), gb = *(const f32x4*)(cg_g + c + 4);
                    float v[8];
#define CONV_E(e, RW, W0, W1, W2, LOHI) v[e] = LOHI(rb[u].RW) * (W0 * (LOHI(rc2[u].RW) * LOHI(rx2[u].RW)) + W1 * (LOHI(rc1[u].RW) * LOHI(rx1[u].RW)) + W2 * (LOHI(rc0[u].RW) * LOHI(rx0[u].RW)))
                    CONV_E(0, x, w0a[0], w1a[0], w2a[0], bflo); CONV_E(1, x, w0a[1], w1a[1], w2a[1], bfhi); CONV_E(2, y, w0a[2], w1a[2], w2a[2], bflo); CONV_E(3, y, w0a[3], w1a[3], w2a[3], bfhi);
                    CONV_E(4, z, w0b[0], w1b[0], w2b[0], bflo); CONV_E(5, z, w0b[1], w1b[1], w2b[1], bfhi); CONV_E(6, w, w0b[2], w1b[2], w2b[2], bflo); CONV_E(7, w, w0b[3], w1b[3], w2b[3], bfhi);
#undef CONV_E
                    float ss = 0.f;
#pragma unroll
                    for (int e = 0; e < 8; ++e) ss += v[e] * v[e];
                    ss += __shfl_xor(ss, 1); ss += __shfl_xor(ss, 2); ss += __shfl_xor(ss, 4);
                    const float rs = rsqrtf(ss * (1.0f / 64.0f) + EPS);
                    v4u o; o.x = pk2(v[0] * rs * ga[0], v[1] * rs * ga[1]); o.y = pk2(v[2] * rs * ga[2], v[3] * rs * ga[3]);
                    o.z = pk2(v[4] * rs * gb[0], v[5] * rs * gb[1]); o.w = pk2(v[6] * rs * gb[2], v[7] * rs * gb[3]);
                    if (st1 < NST) *(v4u*)(mixed + ((size_t)b * SEQ + t) * DM + 512 + c) = o;
                } }
        }
    }
}

__device__ __forceinline__ void phase4(const Args& a, LAS unsigned char* lds) {
    int tid_ = threadIdx.x; asm volatile("" : "+v"(tid_)); const int tid = tid_, lane = tid & 63, wave = tid >> 6;
    unsigned char* ws = a.ws;
    const float* hid = (const float*)(ws + WS_HID);
    const int G = gridDim.x, half = G >> 1;
    const int kv = (int)blockIdx.x >= half ? 1 : 0;
    const int bl = (int)blockIdx.x - kv * half, nb = kv ? (G - half) : half;
    LAS float* W2 = (LAS float*)lds;
    LAS float* scr = (LAS float*)(lds + 65536 + wave * 4096);
    { const float* w2 = a.in[14 + 2 * kv];
#pragma unroll
      for (int q = 0; q < 8; ++q) { const int idx = q * 512 + tid; *(LAS f32x4*)(W2 + idx * 4) = *(const f32x4*)(w2 + idx * 4); } }
    __syncthreads();
    for (int it = bl * NWAVES + wave; it < 1024; it += nb * NWAVES) {
        const int r4 = it * 4;
#pragma unroll
        for (int j = 0; j < 4; ++j)
#pragma unroll
            for (int q = 0; q < 4; ++q) scr[(q * 64 + lane) * 4 + j] = hid[((size_t)kv * 4096 + r4 + j) * 256 + q * 64 + lane];
        LDS_WAIT(); asm volatile("" ::: "memory");
        f32x4 acc = {0.f, 0.f, 0.f, 0.f};
#pragma unroll 16
        for (int k = 0; k < 256; ++k) { const float w = W2[k * 64 + lane]; const f32x4 h = *(const LAS f32x4*)(scr + k * 4); acc += h * w; }
        LDS_WAIT(); asm volatile("" ::: "memory");
#pragma unroll
        for (int j = 0; j < 4; ++j) {
            const int row = r4 + j, pair = row >> 8, n = row & 255;
            if (kv == 0) {
                const float ss = wave_sum(acc[j] * acc[j]);
                const float y = acc[j] * rsqrtf(ss * (1.0f / 64.0f) + EPS) * a.in[8][lane];
                ((bf16*)(ws + WS_KCN))[((size_t)pair * 256 + n) * 64 + lane] = (n < 255) ? (bf16)f2bf(y) : (bf16)0;
            } else {
                ((bf16*)(ws + WS_VCT))[((size_t)pair * 64 + lane) * 256 + n] = (n < 255) ? (bf16)f2bf(acc[j]) : (bf16)0;
            }
        }
    }
}

#ifndef PROBE_CMP
#define PROBE_CMP 0
#endif
#ifndef PROBE_TOPK
#define PROBE_TOPK 0
#endif
#ifndef PROBE_SEL
#define PROBE_SEL 0
#endif
#ifndef PROBE_WIN
#define PROBE_WIN 0
#endif
#define MFMA32(a, b, c) __builtin_amdgcn_mfma_f32_32x32x16_bf16((a), (b), (c), 0, 0, 0)
constexpr int AT_CK = 0, AT_CV = 36864, AT_PS = 70656, AT_SLOT = 0, AT_OF = 73728, AT_WU = 139264, AT_KEYS = 139392, PS_PITCH = 260;
constexpr int QCTR_WORD = 3584;
constexpr int AT_KB0 = 0, AT_KB1 = 9216, AT_VB0 = 18432, AT_VB1 = 27648;
constexpr float NEG_BIG = -1.0e30f;

__device__ __forceinline__ float quad_sum(float t) {
    t += __builtin_bit_cast(float, __builtin_amdgcn_mov_dpp(__builtin_bit_cast(int, t), 0xB1, 0xf, 0xf, true));
    t += __builtin_bit_cast(float, __builtin_amdgcn_mov_dpp(__builtin_bit_cast(int, t), 0x4E, 0xf, 0xf, true));
    return t;
}
__device__ __forceinline__ s16x4 vtr(const LAS unsigned char* p) { return __builtin_amdgcn_ds_read_tr16_b64_v4i16((LAS s16x4*)p); }
template <int MODE, bool DIAG, bool VTR = false>
__device__ __forceinline__ void attn_tile(const LAS unsigned char* Kt, const LAS unsigned char* Vt, int vpitch, int vkoff, const bf16x8 (&qf)[4], int r, int h2,
                                          float cs, float A, int lo, int hi, float& m, float& l, f32x16 (&o)[2], float inv_l, LAS float* psrow) {
    float rowsum = 0.f;
#pragma unroll
    for (int sub = 0; sub < 2; ++sub) {
        f32x16 s;
#pragma unroll
        for (int i = 0; i < 16; ++i) s[i] = __builtin_fmaf(cs, (float)(32 * sub + (i & 3) + 8 * (i >> 2)), A);
#pragma unroll
        for (int ks = 0; ks < 4; ++ks) { const bf16x8 kf = *(const LAS bf16x8*)(Kt + (32 * sub + r) * 144 + (16 * ks + 8 * h2) * 2); s = MFMA32(kf, qf[ks], s); }
        if (DIAG) {
#pragma unroll
            for (int i = 0; i < 16; ++i) { const int ci = 32 * sub + (i & 3) + 8 * (i >> 2); s[i] = (ci >= lo && ci <= hi) ? s[i] : -INFINITY; }
        }
        if (MODE == 0) {
            float mx = s[0];
#pragma unroll
            for (int i = 1; i < 16; ++i) mx = fmaxf(mx, s[i]);
            mx = fmaxf(mx, __shfl_xor(mx, 32));
            const float mn = fmaxf(m, mx); l *= __builtin_amdgcn_exp2f(m - mn); m = mn;
            float rs = 0.f;
#pragma unroll
            for (int i = 0; i < 16; ++i) rs += __builtin_amdgcn_exp2f(s[i] - mn);
            l += rs;
            continue;
        }
#pragma unroll
        for (int i = 0; i < 16; ++i) {
            float p;
            if (MODE == 1) p = __builtin_amdgcn_exp2f(s[i] - m) * inv_l; else p = __builtin_amdgcn_exp2f(s[i]);
            rowsum += p; s[i] = p;
        }
        if (MODE == 1) {
#pragma unroll
            for (int i = 0; i < 16; ++i) { const float t = quad_sum(s[i]);
                if ((r & 3) == 0) psrow[32 * sub + (i & 3) + 8 * (i >> 2) + 4 * h2] = t; }
        }
#pragma unroll
        for (int st = 0; st < 2; ++st) {
            v4u pw; pw.x = pk2(s[8 * st + 0], s[8 * st + 1]); pw.y = pk2(s[8 * st + 2], s[8 * st + 3]);
            pw.z = pk2(s[8 * st + 4], s[8 * st + 5]); pw.w = pk2(s[8 * st + 6], s[8 * st + 7]);
            const bf16x8 pf = __builtin_bit_cast(bf16x8, pw);
#pragma unroll
            for (int dt = 0; dt < 2; ++dt) {
                s16x4 lo4, hi4;
                if (VTR) {
                    const LAS unsigned char* vp = Vt + (32 * sub + 16 * st + 4 * h2 + ((r & 15) >> 2)) * vpitch + (32 * dt + 16 * (r >> 4)) * 2 + 8 * (r & 3);
                    lo4 = vtr(vp); hi4 = vtr(vp + 8 * vpitch);
                } else {
                    const LAS unsigned char* vp = Vt + (32 * dt + r) * vpitch + vkoff + (32 * sub + 16 * st + 4 * h2) * 2;
                    lo4 = *(const LAS s16x4*)(vp); hi4 = *(const LAS s16x4*)(vp + 16);
                }
                const bf16x8 vf = __builtin_shufflevector(lo4, hi4, 0, 1, 2, 3, 4, 5, 6, 7);
                o[dt] = MFMA32(vf, pf, o[dt]);
            }
        }
    }
    if (MODE >= 2) l += rowsum;
}

template <int MODE>
__device__ __forceinline__ void attn_blocks(LAS unsigned char* lds, unsigned long long blocks, unsigned long long wmask, int iq, const bf16* Kg, const bf16* Vtg, const bf16x8 (&qf)[4], int r, int h2,
                                            float slope2, float smax2, int tpos, unsigned long long mymask, float& l, f32x16 (&o)[2]) {
    int tid_ = threadIdx.x; asm volatile("" : "+v"(tid_)); const int tid = tid_;
    const int lrow = tid >> 3, lch = tid & 7;
    const int loff = lrow * 144 + lch * 16;
    const unsigned char* kgp = (const unsigned char*)Kg + tid * 16;
    const unsigned char* vgp = (const unsigned char*)Vtg + tid * 16;
    float mdummy = 0.f;
    unsigned long long rem = blocks;
    int j0 = __builtin_ctzll(rem); rem &= rem - 1;
    int j1 = rem ? __builtin_ctzll(rem) : -1; if (rem) rem &= rem - 1;
    v4u k0, v0, k1 = {0u, 0u, 0u, 0u}, v1 = {0u, 0u, 0u, 0u};
    k0 = *(const v4u*)(kgp + (size_t)j0 * 8192); v0 = *(const v4u*)(vgp + (size_t)j0 * 8192);
    if (j1 >= 0) { k1 = *(const v4u*)(kgp + (size_t)j1 * 8192); v1 = *(const v4u*)(vgp + (size_t)j1 * 8192); }
    *(LAS v4u*)(lds + AT_SLOT + loff) = k0; *(LAS v4u*)(lds + AT_SLOT + 9216 + loff) = v0;
    *(LAS v4u*)(lds + AT_SLOT + 18432 + loff) = k1; *(LAS v4u*)(lds + AT_SLOT + 27648 + loff) = v1;
    __syncthreads();
    int cur = 0;
    for (;;) {
        const int n0 = rem ? __builtin_ctzll(rem) : -1; if (rem) rem &= rem - 1;
        const int n1 = rem ? __builtin_ctzll(rem) : -1; if (rem) rem &= rem - 1;
        if (n0 >= 0) { k0 = *(const v4u*)(kgp + (size_t)n0 * 8192); v0 = *(const v4u*)(vgp + (size_t)n0 * 8192); }
        if (n1 >= 0) { k1 = *(const v4u*)(kgp + (size_t)n1 * 8192); v1 = *(const v4u*)(vgp + (size_t)n1 * 8192); }
        const LAS unsigned char* sb = lds + AT_SLOT + cur * 36864;
#pragma unroll
        for (int u = 0; u < 2; ++u) {
            const int j = u ? j1 : j0;
            if (j >= 0 && ((wmask >> j) & 1ull)) {
                int rr = r, hh = h2; asm volatile("" : "+v"(rr), "+v"(hh));
                const bool on = (mymask >> j) & 1ull;
                const int rel = tpos - 64 * j - 4 * h2;
                float A = -slope2 * (float)rel - smax2;
                if (MODE == 2 && !on) A = -INFINITY;
                const LAS unsigned char* kb = sb + u * 18432; const LAS unsigned char* vb = kb + 9216;
                if (j == iq || (MODE == 3 && j == iq - 8)) attn_tile<MODE, true, true>(kb, vb, 144, 0, qf, rr, hh, slope2, A, (MODE == 3) ? rel - 511 : -100000, rel, mdummy, l, o, 0.f, nullptr);
                else attn_tile<MODE, false, true>(kb, vb, 144, 0, qf, rr, hh, slope2, A, 0, 0, mdummy, l, o, 0.f, nullptr);
            }
        }
        if (n0 >= 0) {
            LAS unsigned char* nb = lds + AT_SLOT + (cur ^ 1) * 36864;
            *(LAS v4u*)(nb + loff) = k0; *(LAS v4u*)(nb + 9216 + loff) = v0;
            if (n1 >= 0) { *(LAS v4u*)(nb + 18432 + loff) = k1; *(LAS v4u*)(nb + 27648 + loff) = v1; }
        }
        __syncthreads();
        if (n0 < 0) break;
        j0 = n0; j1 = n1; cur ^= 1;
    }
}

__device__ __forceinline__ float max_abs64(const float* g) {
    float m = fabsf(g[threadIdx.x & 63]);
#pragma unroll
    for (int o = 1; o < 64; o <<= 1) m = fmaxf(m, __shfl_xor(m, o));
    return m; }

__device__ __forceinline__ void phase5(const Args& a, LAS unsigned char* lds) {
    int tid_ = threadIdx.x; asm volatile("" : "+v"(tid_)); const int tid = tid_, lane = tid & 63, wave = tid >> 6, G = gridDim.x, c = blockIdx.x;
    unsigned char* ws = a.ws;
    const bf16* QN = (const bf16*)(ws + WS_QN);
    const float* gates = (const float*)(ws + WS_GATES);
    bf16* mixed = (bf16*)(ws + WS_MIXED);
    LAS float* PS = (LAS float*)(lds + AT_PS);
    LAS unsigned long long* WU = (LAS unsigned long long*)(lds + AT_WU);
    const float qb = max_abs64(a.in[7]) * (64.0f * 0.125f * LOG2E * 1.02f);
    const float smax_s = qb * max_abs64(a.in[9]), smax_w = qb * max_abs64(a.in[10]);
    for (int rd = 0;; ++rd) {
        const int rank = rd * G + ((rd & 1) ? (G - 1 - c) : c);
        if (rd * G >= 1024) break;
        if (rank >= 1024) continue;
        int ln_ = lane; asm volatile("" : "+v"(ln_));
        const int r = ln_ & 31, h2 = ln_ >> 5, hq = r & 3, tl = r >> 2;
        const int i = 63 - (rank >> 4), bg = rank & 15, b = bg >> 1, g = bg & 1;
        const int T0 = 64 * i, tpos = T0 + 8 * wave + tl;
        const int head = 4 * g + hq;
        const float slope2 = exp2f(-(float)(head + 1)) * LOG2E;
        const size_t mrow = (size_t)b * SEQ + tpos;
        {
            const unsigned char* kc = (const unsigned char*)((const bf16*)(ws + WS_KCN) + (size_t)bg * 256 * 64);
            const unsigned char* vc = (const unsigned char*)((const bf16*)(ws + WS_VCT) + (size_t)bg * 64 * 256);
#pragma unroll
            for (int q = 0; q < 4; ++q) { const int idx = q * 512 + tid;
                const v4u kv_ = *(const v4u*)(kc + (size_t)idx * 16); *(LAS v4u*)(lds + AT_CK + (idx >> 3) * 144 + (idx & 7) * 16) = kv_;
                const v4u vv_ = *(const v4u*)(vc + (size_t)idx * 16); *(LAS v4u*)(lds + AT_CV + (idx >> 5) * 528 + (idx & 31) * 16) = vv_; }
        }
        bf16x8 qf[4];
        { const bf16* qp = QN + ((size_t)(b * 8 + head) * SEQ + tpos) * 64 + 8 * h2;
#pragma unroll
          for (int ks = 0; ks < 4; ++ks) qf[ks] = *(const bf16x8*)(qp + 16 * ks); }
        __syncthreads();
        f32x16 ofin[2];
        const int KT = ((4 * i + 2) >> 6) + 1;
        float g_c, g_s, g_w;
        { const float* gp = gates + mrow * 24 + head * 3; g_c = gp[0]; g_s = gp[1]; g_w = gp[2]; }
#if PROBE_CMP
        for (int rep = 0; rep < 2; ++rep)
#endif
        {
            float m = NEG_BIG, l = 0.f; f32x16 o[2];
#pragma unroll
            for (int dt = 0; dt < 2; ++dt)
#pragma unroll
                for (int e = 0; e < 16; ++e) o[dt][e] = 0.f;
            const float cs = 16.0f * slope2;
            for (int kt = 0; kt < KT; ++kt) {
                const int rel = tpos - 31 - 1024 * kt;
                attn_tile<0, true>(lds + AT_CK + kt * 64 * 144, lds + AT_CV, 528, kt * 128, qf, r, h2, cs, -slope2 * (float)(rel - 64 * h2), -100000, (rel >> 4) - 4 * h2, m, l, o, 0.f, nullptr);
            }
            const float lt = l + __shfl_xor(l, 32);
            const float inv_l = lt > 0.f ? 1.0f / lt : 0.f;
            LAS float* psrow = PS + (8 * wave + tl) * PS_PITCH;
            for (int kt = 0; kt < KT; ++kt) {
                const int rel = tpos - 31 - 1024 * kt;
                attn_tile<1, true>(lds + AT_CK + kt * 64 * 144, lds + AT_CV, 528, kt * 128, qf, r, h2, cs, -slope2 * (float)(rel - 64 * h2), -100000, (rel >> 4) - 4 * h2, m, l, o, inv_l, psrow + 64 * kt);
            }
#pragma unroll
            for (int dt = 0; dt < 2; ++dt)
#pragma unroll
                for (int e = 0; e < 16; ++e) ofin[dt][e] = g_c * o[dt][e];
        }
        LDS_WAIT(); asm volatile("" ::: "memory");
        unsigned long long mymask = 0ull, wunion = 0ull;
#if PROBE_TOPK
        for (int rep = 0; rep < 2; ++rep)
#endif
        {
            const int nmax = (4 * i + 3) < 254 ? (4 * i + 3) : 254;
            const unsigned long long validbits = (i >= 63) ? ~0ull : ((1ull << (i + 1)) - 1ull);
            const bool forced = (lane == 0) || (lane == i) || (lane == i - 1);
            LAS unsigned* KEYS = (LAS unsigned*)(lds + AT_KEYS) + wave * 128;
            if (i < 16) { mymask = validbits; wunion = validbits; }
            else
#pragma unroll 1
            for (int t8 = 0; t8 < 8; t8 += 2) {
                const LAS float* psa = PS + (8 * wave + t8) * PS_PITCH; const LAS float* psb = psa + PS_PITCH;
                float impa = 0.f, impb = 0.f;
#pragma unroll
                for (int dn = -1; dn <= 3; ++dn) { const int n = 4 * lane + dn; if (n >= 0 && n <= nmax) { impa += psa[n]; impb += psb[n]; } }
                unsigned keya = (lane <= i) ? (((__builtin_bit_cast(unsigned, impa) & ~63u) + 64u) | (unsigned)(63 - lane)) : (unsigned)(63 - lane);
                unsigned keyb = (lane <= i) ? (((__builtin_bit_cast(unsigned, impb) & ~63u) + 64u) | (unsigned)(63 - lane)) : (unsigned)(63 - lane);
                keya = forced ? (0xFFFFFFC0u | (unsigned)(63 - lane)) : keya; keyb = forced ? (0xFFFFFFC0u | (unsigned)(63 - lane)) : keyb;
                KEYS[lane] = keya; KEYS[64 + lane] = keyb;
                LDS_WAIT(); asm volatile("" ::: "memory");
                int cnta = 0, cntb = 0;
#pragma unroll
                for (int k4 = 0; k4 < 16; ++k4) { const v4u ka = *(const LAS v4u*)(KEYS + 4 * k4), kb = *(const LAS v4u*)(KEYS + 64 + 4 * k4);
                    cnta += (ka.x > keya) ? 1 : 0; cnta += (ka.y > keya) ? 1 : 0; cnta += (ka.z > keya) ? 1 : 0; cnta += (ka.w > keya) ? 1 : 0;
                    cntb += (kb.x > keyb) ? 1 : 0; cntb += (kb.y > keyb) ? 1 : 0; cntb += (kb.z > keyb) ? 1 : 0; cntb += (kb.w > keyb) ? 1 : 0; }
                LDS_WAIT(); asm volatile("" ::: "memory");
                const unsigned long long mska = __ballot(cnta < 16) & validbits, mskb = __ballot(cntb < 16) & validbits;
                wunion |= mska | mskb;
                if (tl == t8) mymask = mska;
                if (tl == t8 + 1) mymask = mskb;
            }
            if (lane == 0) WU[wave] = wunion;
        }
        __syncthreads();
        unsigned long long uni = 0ull;
#pragma unroll
        for (int w = 0; w < 8; ++w) uni |= WU[w];
        {
            const unsigned lo = __builtin_amdgcn_readfirstlane((unsigned)uni), hi = __builtin_amdgcn_readfirstlane((unsigned)(uni >> 32));
            uni = ((unsigned long long)hi << 32) | lo;
        }
        LAS float* OF = (LAS float*)(lds + AT_OF) + tid;
#pragma unroll
        for (int dt = 0; dt < 2; ++dt)
#pragma unroll
            for (int e = 0; e < 16; ++e) OF[(dt * 16 + e) * 512] = ofin[dt][e];
        {
            float l = 0.f; f32x16 o[2];
#pragma unroll
            for (int dt = 0; dt < 2; ++dt)
#pragma unroll
                for (int e = 0; e < 16; ++e) o[dt][e] = 0.f;
            attn_blocks<2>(lds, uni, wunion, i, (const bf16*)(ws + WS_KSN) + (size_t)bg * SEQ * 64, (const bf16*)(ws + WS_PROJ) + ((size_t)(b * NSEG + 14 + g) * SEQ) * 64, qf, r, h2, slope2, smax_s, tpos, mymask, l, o);
            const float lt = l + __shfl_xor(l, 32);
            const float sc = lt > 0.f ? g_s / lt : 0.f;
#pragma unroll
            for (int dt = 0; dt < 2; ++dt)
#pragma unroll
                for (int e = 0; e < 16; ++e) OF[(dt * 16 + e) * 512] += sc * o[dt][e];
        }
        {
            float l = 0.f; f32x16 o[2];
#pragma unroll
            for (int dt = 0; dt < 2; ++dt)
#pragma unroll
                for (int e = 0; e < 16; ++e) o[dt][e] = 0.f;
            const int jlo = i - 8 < 0 ? 0 : i - 8;
            const unsigned long long upto = (i >= 63) ? ~0ull : ((1ull << (i + 1)) - 1ull);
            const unsigned long long wb = upto & ~((1ull << jlo) - 1ull);
            attn_blocks<3>(lds, wb, ~0ull, i, (const bf16*)(ws + WS_KWN) + (size_t)bg * SEQ * 64, (const bf16*)(ws + WS_PROJ) + ((size_t)(b * NSEG + 18 + g) * SEQ) * 64, qf, r, h2, slope2, smax_w, tpos, ~0ull, l, o);
            const float lt = l + __shfl_xor(l, 32);
            const float sc = lt > 0.f ? g_w / lt : 0.f;
#pragma unroll
            for (int dt = 0; dt < 2; ++dt)
#pragma unroll
                for (int e = 0; e < 16; ++e) ofin[dt][e] = OF[(dt * 16 + e) * 512] + sc * o[dt][e];
        }
        {
            float ss = 0.f;
#pragma unroll
            for (int dt = 0; dt < 2; ++dt)
#pragma unroll
                for (int e = 0; e < 16; ++e) ss += ofin[dt][e] * ofin[dt][e];
            ss += __shfl_xor(ss, 32);
            const float rs = rsqrtf(ss * (1.0f / 64.0f) + EPS);
            const float* og = a.in[18] + head * 64;
            LAS unsigned char* ob = lds + AT_CK + (wave * 32 + r) * 144;
#pragma unroll
            for (int dt = 0; dt < 2; ++dt)
#pragma unroll
                for (int i4 = 0; i4 < 4; ++i4) { const int d0 = 32 * dt + 8 * i4 + 4 * h2; const f32x4 gv = *(const f32x4*)(og + d0);
                    v2u w; w.x = pk2(ofin[dt][4 * i4 + 0] * rs * gv[0], ofin[dt][4 * i4 + 1] * rs * gv[1]); w.y = pk2(ofin[dt][4 * i4 + 2] * rs * gv[2], ofin[dt][4 * i4 + 3] * rs * gv[3]);
                    *(LAS v2u*)(ob + d0 * 2) = w; }
            __syncthreads();
#pragma unroll
            for (int q = 0; q < 4; ++q) { const int idx = q * 512 + tid, row = idx >> 3, chunk = idx & 7;
                const v4u v = *(const LAS v4u*)(lds + AT_CK + row * 144 + chunk * 16);
                *(v4u*)(mixed + ((size_t)b * SEQ + T0 + (row >> 2)) * DM + (4 * g + (row & 3)) * 64 + chunk * 8) = v; }
            __syncthreads();
        }
    }
}

__device__ __forceinline__ void phase8b(const Args& a) {
    unsigned char* ws = a.ws;
    const float* gtail = (const float*)(ws + WS_GTAIL); const float* ghead = (const float*)(ws + WS_GHEAD); const float* uhead = (const float*)(ws + WS_UHEAD);
    const float* cw = a.in[24]; bf16* H = (bf16*)(ws + WS_H);
    for (int e = blockIdx.x * NTHREADS + threadIdx.x; e < 128 * DFF; e += gridDim.x * NTHREADS) {
        const int pm = e / DFF, ch = e % DFF;
        float t0 = 0.f, t1 = 0.f;
        if (pm & 15) { t0 = gtail[((size_t)(pm - 1) * 2 + 0) * DFF + ch]; t1 = gtail[((size_t)(pm - 1) * 2 + 1) * DFF + ch]; }
        const float g0 = ghead[((size_t)pm * 2 + 0) * DFF + ch], g1 = ghead[((size_t)pm * 2 + 1) * DFF + ch];
        const float u0 = uhead[((size_t)pm * 2 + 0) * DFF + ch], u1 = uhead[((size_t)pm * 2 + 1) * DFF + ch];
        const float w0 = cw[ch], w1 = cw[DFF + ch], w2 = cw[2 * DFF + ch];
        H[((size_t)pm * 256 + 0) * DFF + ch] = (bf16)f2bf(silu_f(w0 * t0 + w1 * t1 + w2 * g0) * u0);
        H[((size_t)pm * 256 + 1) * DFF + ch] = (bf16)f2bf(silu_f(w0 * t1 + w1 * g0 + w2 * g1) * u1);
    }
}

__global__ void __launch_bounds__(NTHREADS) nsa_layer_fwd(Args a) {
    extern __shared__ __attribute__((aligned(16))) unsigned char smem[];
    LAS unsigned char* lds = (LAS unsigned char*)smem;
    cg::grid_group grid = cg::this_grid();
    unsigned char* ws = a.ws;
    const int G = gridDim.x, c = blockIdx.x;
    const float* mod = (const float*)(ws + WS_MOD);

    if (threadIdx.x < 2) ((volatile LAS unsigned*)(lds + XB_LDS_OFF))[threadIdx.x] = 0u;
    __syncthreads();
    const XcdBarrier xbar = xcd_barrier_post((unsigned*)(ws + WS_BAR), (volatile LAS unsigned*)(lds + XB_LDS_OFF));
    if (a.ws == nullptr) grid.sync();
    phase0(a, lds);
    xcd_barrier(xbar);
    norm_rows(a.in[0], a.in[4], mod, 0, 1024, (bf16*)(ws + WS_XN));
    weight_copies(a, lds);
    xcd_barrier(xbar);
    {
        pg8::Gemm g{(const bf16*)(ws + WS_XN), (const bf16*)(ws + WS_BT_IN), MTOK, NINP, 1024, 1024};
        pg8::StaticOrder S; S.init(MTOK, NINP, G, c);
        EpiProj E{(bf16*)(ws + WS_PROJ), (bf16*)(ws + WS_QN), (bf16*)(ws + WS_KSN), (bf16*)(ws + WS_KWN), (float*)(ws + WS_GATES), a.in[7], a.in[9], a.in[10], a.in[6]};
        pg8::gemm_phase<EpiProj, pg8::StaticOrder, true, true>(lds, g, S, E);
    }
    xcd_barrier(xbar);
    if (c < 32) {
        pg8::Gemm g{(const bf16*)(ws + WS_PROJ), (const bf16*)(ws + WS_BT_C1), 4096, 256, 2048, 1024};
        CmpOrder S{c, (const bf16*)(ws + WS_PROJ), (const bf16*)(ws + WS_BT_C1)};
        EpiCmp E{(float*)(ws + WS_HID), (const float*)(ws + WS_BIAS1)};
        pg8::gemm_phase<EpiCmp, CmpOrder, true, true>(lds, g, S, E);
    } else {
        phase3_prep(a, lds, (c - 32) * NWAVES + (int)(threadIdx.x >> 6), (G - 32) * NWAVES);
    }
    xcd_barrier(xbar);
    phase4(a, lds);
    xcd_barrier(xbar);
    phase5(a, lds);
    xcd_barrier(xbar);
    {
        pg8::Gemm g{(const bf16*)(ws + WS_MIXED), (const bf16*)(ws + WS_BT_OUT), MTOK, 1024, 1024, 1024};
        pg8::StaticOrder S; S.init(MTOK, 1024, G, c);
        EpiResB E{a.in[0], (bf16*)(ws + WS_X1B), mod, 2048};
        pg8::gemm_phase<EpiResB, pg8::StaticOrder, true, true>(lds, g, S, E);
    }
    xcd_barrier(xbar);
    norm_rows_b((const bf16*)(ws + WS_X1B), a.in[21], mod, 3072, 4096, (bf16*)(ws + WS_XN));
    xcd_barrier(xbar);
    {
        pg8::Gemm g{(const bf16*)(ws + WS_XN), (const bf16*)(ws + WS_BT_GU), MTOK, NGU, 1024, 1024};
        pg8::StaticOrder S; S.init(MTOK, NGU, G, c);
        EpiFfn E{(bf16*)(ws + WS_H), a.in[24], (float*)(ws + WS_GTAIL), (float*)(ws + WS_GHEAD), (float*)(ws + WS_UHEAD), (LAS float*)(lds + HB_OFF)};
        pg8::gemm_phase<EpiFfn, pg8::StaticOrder, true, true>(lds, g, S, E);
    }
    xcd_barrier(xbar);
    phase8b(a);
    xcd_barrier(xbar);
    {
        pg8::Gemm g{(const bf16*)(ws + WS_H), (const bf16*)(ws + WS_BT_DN), MTOK, 1024, DFF, DFF};
        pg8::StaticOrder S; S.init(MTOK, 1024, G, c);
        EpiResF E{(const bf16*)(ws + WS_X1B), a.out, mod, 5120};
        pg8::gemm_phase<EpiResF, pg8::StaticOrder, true, true>(lds, g, S, E);
    }
}

extern "C" void kernel_launch(void* const* d_in, const int* in_sizes, int n_in, void* d_out, int out_size, void* d_ws, size_t ws_size, hipStream_t stream) {
    static int grid = 0;
    if (grid == 0) {
        if (n_in != 26 || out_size != MTOK * DM || ws_size < WS_END) { fprintf(stderr, "kernel_launch: unexpected problem (n_in %d, out %d, ws %zu)\n", n_in, out_size, ws_size); grid = -1; return; }
        int dev = 0, cus = 0, per_cu = 0;
        (void)hipGetDevice(&dev);
        (void)hipDeviceGetAttribute(&cus, hipDeviceAttributeMultiprocessorCount, dev);
        if (hipFuncSetAttribute((const void*)nsa_layer_fwd, hipFuncAttributeMaxDynamicSharedMemorySize, LDS_BYTES) != hipSuccess) { fprintf(stderr, "kernel_launch: hipFuncSetAttribute failed\n"); grid = -1; return; }
        if (hipOccupancyMaxActiveBlocksPerMultiprocessor(&per_cu, (const void*)nsa_layer_fwd, NTHREADS, LDS_BYTES) != hipSuccess || per_cu < 1) { fprintf(stderr, "kernel_launch: occupancy query says %d\n", per_cu); per_cu = 1; }
        (void)hipGetLastError();
        grid = cus * per_cu;
        if (grid > 1024) grid = 1024;
    }
    if (grid < 0) return;
    if (hipMemsetAsync((char*)d_ws + WS_BAR, 0, BAR_BYTES, stream) != hipSuccess) { fprintf(stderr, "kernel_launch: memset of the barrier words failed\n"); return; }
    Args a{};
    for (int i = 0; i < 26; ++i) a.in[i] = (const float*)d_in[i];
    a.out = (float*)d_out; a.ws = (unsigned char*)d_ws;
    void* args[] = {&a};
    hipError_t e = hipLaunchCooperativeKernel((const void*)nsa_layer_fwd, dim3(grid), dim3(NTHREADS), args, LDS_BYTES, stream);
    if (e != hipSuccess) fprintf(stderr, "cooperative launch failed: %s (grid %d)\n", hipGetErrorString(e), grid);
}
```

```cpp
#include <hip/hip_runtime.h>
#include <hip/hip_cooperative_groups.h>
#include <cstdio>
#include <cstdint>
namespace cg = cooperative_groups;

namespace pg8 {
#define PG8_LAS __attribute__((address_space(3)))
typedef unsigned short bf16_t;
typedef short bf16x8 __attribute__((ext_vector_type(8)));
typedef float f32x4 __attribute__((ext_vector_type(4)));
typedef unsigned u32x4 __attribute__((ext_vector_type(4)));
constexpr int BM = 256, BK = 64, HALF = 128, HTB = HALF * BK * 2, STAGE_BYTES = 8 * HTB, NXCD = 8, WGM = 4;

__host__ __device__ __forceinline__ int lds_byte(int r, int c) { const int st = (r >> 4) * 2 + (c >> 5), rr = r & 15, cc = c & 31, ob = rr * 64 + cc * 2; return st * 1024 + (ob ^ (((ob >> 9) & 1) << 5)); }
__host__ __device__ __forceinline__ void stage_rc(int b, int& R, int& C) { const int st = b / 1024, sb = b % 1024, swz = sb ^ (((sb >> 9) & 1) << 5); R = (st >> 1) * 16 + swz / 64; C = (st & 1) * 32 + (swz % 64) / 2; }
__host__ __device__ __forceinline__ int perm32(int rho) { const int n = rho >> 4, i = rho & 15; return 8 * (i >> 2) + 4 * n + (i & 3); }

struct Unit { int pm, pn; };
struct Gemm { const bf16_t* A; const bf16_t* Bt; int M, N, K, lda; };

struct StaticOrder {
    int nM, nN, nwg, G, c;
    __device__ void init(int M, int N, int G_, int c_) { nM = M / BM; nN = N / BM; nwg = nM * nN; G = G_; c = c_; }
    __device__ bool next(int i, Unit& u) const {
        const long L = (long)i * G + c; if (L >= nwg) return false;
        int wgid = (int)L; { const int q = nwg / NXCD, r = nwg % NXCD, xcd = wgid % NXCD, off = wgid / NXCD; wgid = (xcd < r ? xcd * (q + 1) : r * (q + 1) + (xcd - r) * q) + off; }
        const int nig = WGM * nN, gid = wgid / nig, fm = gid * WGM, gsz = (nM - fm) < WGM ? (nM - fm) : WGM;
        u.pm = fm + ((wgid % nig) % gsz); u.pn = (wgid % nig) / gsz; return true;
    }
    __device__ __forceinline__ const char* a_ptr(const Gemm& g, const Unit& u) const { return (const char*)g.A + (size_t)u.pm * (size_t)(BM * 2) * (size_t)g.lda; }
    __device__ __forceinline__ const char* b_ptr(const Gemm& g, const Unit& u) const { return (const char*)g.Bt + (size_t)u.pn * (size_t)(BM * 2) * (size_t)g.K; }
    __device__ __forceinline__ void a_ready(const Unit&) const {}
    __device__ __forceinline__ void done(const Unit&) const {}
};

template <class Epi, class Sched, bool ALIGN_EPI = false, bool SP2 = false>
__device__ __forceinline__ void gemm_phase(PG8_LAS unsigned char* lds, const Gemm g, const Sched& S, const Epi& E) {
    int tid_ = threadIdx.x; asm volatile("" : "+v"(tid_));
    const int tid = tid_, wid = __builtin_amdgcn_readfirstlane(tid >> 6), lane = tid & 63, wr = wid >> 2, wc = wid & 3, fr = lane & 15, fq = lane >> 4;
    const int K = g.K, nt = K / BK;
    unsigned voffA[2], voffB[2];
#pragma unroll
    for (int i = 0; i < 2; ++i) { int R, C; stage_rc(tid * 16 + i * 8192, R, C); const int Rb = Epi::PERM2 ? (64 * (R >> 5) + perm32(R & 31)) : (Epi::PERM ? ((R & ~31) + perm32(R & 31)) : R);
        voffA[i] = (unsigned)(R * g.lda + C) * 2u; voffB[i] = (unsigned)(Rb * K + C) * 2u; }
    const size_t kstep = (size_t)(BK * 2);
    const size_t hsA = (size_t)HALF * g.lda * 2, hsB = (size_t)(Epi::PERM2 ? 32 : HALF) * K * 2;
    const unsigned ldsw = (unsigned)wid * 1024u;
    const int aoff = lds_byte(wr * 64 + fr, fq * 8), boff = lds_byte(wc * 32 + fr, fq * 8);
#define PG8_SA(b, h) (((b) * 2 + (h)) * HTB)
#define PG8_SB(b, h) ((4 + (b) * 2 + (h)) * HTB)
#define PG8_STAGE(bufoff, gbase, voff) do { _Pragma("unroll") for (int _i = 0; _i < 2; ++_i) \
        __builtin_amdgcn_global_load_lds((const unsigned*)((const char*)(gbase) + (voff)[_i]), (PG8_LAS unsigned*)(lds + (bufoff) + ldsw + _i * 8192), 16, 0, 0); } while (0)
#define PG8_LDA(dst, b, h) do { _Pragma("unroll") for (int m = 0; m < 4; ++m) _Pragma("unroll") for (int k = 0; k < 2; ++k) dst[m][k] = *(const PG8_LAS bf16x8*)(lds + PG8_SA(b, h) + aoff + m * 2048 + k * 1024); } while (0)
#define PG8_LDB(dst, b, h) do { _Pragma("unroll") for (int n = 0; n < 2; ++n) _Pragma("unroll") for (int k = 0; k < 2; ++k) dst[n][k] = *(const PG8_LAS bf16x8*)(lds + PG8_SB(b, h) + boff + n * 2048 + k * 1024); } while (0)
#define PG8_MMA(ai, bj, At, Bt) do { __builtin_amdgcn_s_setprio(1); _Pragma("unroll") for (int m = 0; m < 4; ++m) _Pragma("unroll") for (int n = 0; n < 2; ++n) _Pragma("unroll") for (int k = 0; k < 2; ++k) \
        acc[ai][bj][m][n] = __builtin_amdgcn_mfma_f32_16x16x32_bf16(Bt[n][k], At[m][k], acc[ai][bj][m][n], 0, 0, 0); __builtin_amdgcn_s_setprio(0); } while (0)
#define PG8_WAIT_V(n) asm volatile("s_waitcnt vmcnt(" #n ")" ::: "memory")
#define PG8_WAIT_L(n) asm volatile("s_waitcnt lgkmcnt(" #n ")" ::: "memory")
#define PG8_BAR __builtin_amdgcn_s_barrier()
#define PG8_SCHED __builtin_amdgcn_sched_barrier(0)
    Unit cur, nxt; int ui = 0;
    if (!S.next(0, cur)) return;
    f32x4 acc[2][2][4][2];
#pragma unroll
    for (int a = 0; a < 2; ++a)
#pragma unroll
        for (int b = 0; b < 2; ++b)
#pragma unroll
            for (int m = 0; m < 4; ++m)
#pragma unroll
                for (int n = 0; n < 2; ++n) acc[a][b][m][n] = (f32x4){0.f, 0.f, 0.f, 0.f};
    bf16x8 At[4][2], B0[2][2], B1[2][2];
    const char* cA = S.a_ptr(g, cur); const char* cB = S.b_ptr(g, cur);
    S.a_ready(cur);
    if constexpr (SP2) {
        PG8_STAGE(PG8_SB(0, 0), cB, voffB); PG8_STAGE(PG8_SB(0, 1), cB + hsB, voffB); PG8_STAGE(PG8_SA(0, 0), cA, voffA); PG8_STAGE(PG8_SA(0, 1), cA + hsA, voffA);
        if (wr == 1) PG8_BAR;
        PG8_WAIT_V(2); PG8_BAR;
        PG8_STAGE(PG8_SB(1, 0), cB + kstep, voffB); PG8_STAGE(PG8_SA(1, 0), cA + kstep, voffA); PG8_STAGE(PG8_SB(1, 1), cB + hsB + kstep, voffB);
        PG8_WAIT_V(6); PG8_BAR;
    } else {
        PG8_STAGE(PG8_SB(0, 0), cB, voffB); PG8_STAGE(PG8_SA(0, 0), cA, voffA); PG8_STAGE(PG8_SB(0, 1), cB + hsB, voffB); PG8_STAGE(PG8_SA(0, 1), cA + hsA, voffA);
        if (wr == 1) PG8_BAR;
        PG8_WAIT_V(4); PG8_BAR;
        PG8_STAGE(PG8_SB(1, 0), cB + kstep, voffB); PG8_STAGE(PG8_SA(1, 0), cA + kstep, voffA); PG8_STAGE(PG8_SB(1, 1), cB + hsB + kstep, voffB);
        PG8_WAIT_V(6); PG8_BAR;
    }
    for (;;) {
        const bool has_next = S.next(ui + 1, nxt);
        const char* nA = has_next ? S.a_ptr(g, nxt) : cA; const char* nB = has_next ? S.b_ptr(g, nxt) : cB;
        for (int t = 0; t < nt; t += 2) {
            const bool last = (t == nt - 2);
            const char* a1 = cA + (size_t)(t + 1) * kstep;
            const char* a2 = last ? nA : cA + (size_t)(t + 2) * kstep; const char* b2 = last ? nB : cB + (size_t)(t + 2) * kstep;
            const char* a3 = a2 + kstep; const char* b3 = b2 + kstep;
            if (last && has_next) S.a_ready(nxt);
            if constexpr (SP2) {
            PG8_LDB(B0, 0, 0); PG8_LDB(B1, 0, 1); PG8_SCHED; PG8_LDA(At, 0, 0); PG8_STAGE(PG8_SA(1, 1), a1 + hsA, voffA);
            PG8_WAIT_V(8); PG8_WAIT_L(0); PG8_BAR; PG8_MMA(0, 0, At, B0); PG8_MMA(0, 1, At, B1); PG8_BAR; PG8_SCHED;
            PG8_LDA(At, 0, 1); PG8_STAGE(PG8_SB(0, 0), b2, voffB); PG8_STAGE(PG8_SB(0, 1), b2 + hsB, voffB); PG8_STAGE(PG8_SA(0, 0), a2, voffA);
            PG8_WAIT_V(8); PG8_WAIT_L(0); PG8_BAR; PG8_MMA(1, 0, At, B0); PG8_MMA(1, 1, At, B1); PG8_BAR; PG8_SCHED;
            PG8_LDB(B0, 1, 0); PG8_LDB(B1, 1, 1); PG8_SCHED; PG8_LDA(At, 1, 0); PG8_STAGE(PG8_SA(0, 1), a2 + hsA, voffA);
            PG8_WAIT_V(8); PG8_WAIT_L(0); PG8_BAR; PG8_MMA(0, 0, At, B0); PG8_MMA(0, 1, At, B1); PG8_BAR; PG8_SCHED;
            PG8_LDA(At, 1, 1); PG8_STAGE(PG8_SB(1, 0), b3, voffB); PG8_STAGE(PG8_SB(1, 1), b3 + hsB, voffB); PG8_STAGE(PG8_SA(1, 0), a3, voffA);
            PG8_WAIT_V(8); PG8_WAIT_L(0); PG8_BAR; PG8_MMA(1, 0, At, B0); PG8_MMA(1, 1, At, B1); PG8_BAR; PG8_SCHED;
            } else {
            PG8_LDB(B0, 0, 0); PG8_SCHED; PG8_LDA(At, 0, 0); PG8_STAGE(PG8_SA(1, 1), a1 + hsA, voffA);
            PG8_WAIT_L(8); PG8_BAR; PG8_WAIT_L(0); PG8_MMA(0, 0, At, B0); PG8_BAR; PG8_SCHED;
            PG8_LDB(B1, 0, 1); PG8_STAGE(PG8_SB(0, 0), b2, voffB);
            PG8_BAR; PG8_WAIT_L(0); PG8_MMA(0, 1, At, B1); PG8_BAR;
            PG8_LDA(At, 0, 1); PG8_STAGE(PG8_SA(0, 0), a2, voffA);
            PG8_BAR; PG8_WAIT_L(0); PG8_MMA(1, 0, At, B0); PG8_BAR; PG8_SCHED;
            PG8_STAGE(PG8_SB(0, 1), b2 + hsB, voffB);
            PG8_WAIT_V(6); PG8_BAR; PG8_MMA(1, 1, At, B1); PG8_BAR;
            PG8_LDB(B0, 1, 0); PG8_SCHED; PG8_LDA(At, 1, 0); PG8_STAGE(PG8_SA(0, 1), a2 + hsA, voffA);
            PG8_WAIT_L(8); PG8_BAR; PG8_WAIT_L(0); PG8_MMA(0, 0, At, B0); PG8_BAR; PG8_SCHED;
            PG8_LDB(B1, 1, 1); PG8_STAGE(PG8_SB(1, 0), b3, voffB);
            PG8_BAR; PG8_WAIT_L(0); PG8_MMA(0, 1, At, B1); PG8_BAR;
            PG8_LDA(At, 1, 1); PG8_STAGE(PG8_SA(1, 0), a3, voffA);
            PG8_BAR; PG8_WAIT_L(0); PG8_MMA(1, 0, At, B0); PG8_BAR; PG8_SCHED;
            PG8_STAGE(PG8_SB(1, 1), b3 + hsB, voffB);
            PG8_WAIT_V(6); PG8_BAR; PG8_MMA(1, 1, At, B1); PG8_BAR;
            }
        }
        if constexpr (ALIGN_EPI) { if (wr == 0) PG8_BAR; }
        if constexpr (!Epi::AFTER_DRAIN) { E(acc, cur, wr, wc, fr, fq); S.done(cur); }
        if (!has_next) break;
#pragma unroll
        for (int a = 0; a < 2; ++a)
#pragma unroll
            for (int b = 0; b < 2; ++b)
#pragma unroll
                for (int m = 0; m < 4; ++m)
#pragma unroll
                    for (int n = 0; n < 2; ++n) acc[a][b][m][n] = (f32x4){0.f, 0.f, 0.f, 0.f};
        cur = nxt; cA = nA; cB = nB; ++ui;
        if constexpr (ALIGN_EPI) { if (wr == 1) PG8_BAR; }
    }
    PG8_WAIT_V(0);
    if constexpr (!ALIGN_EPI) { if (wr == 0) PG8_BAR; }
    PG8_BAR;
    if constexpr (Epi::AFTER_DRAIN) { E.fused(acc, cur, wr, wc, fr, fq, lds, wid, lane); S.done(cur); }
#undef PG8_SA
#undef PG8_SB
#undef PG8_STAGE
#undef PG8_LDA
#undef PG8_LDB
#undef PG8_MMA
#undef PG8_WAIT_V
#undef PG8_WAIT_L
#undef PG8_BAR
#undef PG8_SCHED
}
}


#define LAS __attribute__((address_space(3)))
typedef unsigned short bf16;
typedef unsigned v4u __attribute__((ext_vector_type(4)));
typedef unsigned v2u __attribute__((ext_vector_type(2)));
typedef float f32x4 __attribute__((ext_vector_type(4)));
typedef float f32x2 __attribute__((ext_vector_type(2)));
typedef float f32x16 __attribute__((ext_vector_type(16)));
typedef short bf16x8 __attribute__((ext_vector_type(8)));
typedef short s16x4 __attribute__((ext_vector_type(4)));
typedef __bf16 bf16x2_t __attribute__((ext_vector_type(2)));

constexpr int NB = 8, SEQ = 4096, DM = 1024, MTOK = NB * SEQ;
constexpr int NIN = 2840, NINP = 3072, NSEG = NINP / 64, DFF = 2816, NGU = 2 * DFF;
constexpr float EPS = 1e-6f;
constexpr float LOG2E = 1.4426950408889634f;
constexpr int NTHREADS = 512, NWAVES = 8;
constexpr int LDS_BYTES = 147456 + 256;
constexpr int XB_LDS_OFF = 147456;
constexpr int HB_OFF = 131072;

constexpr size_t MiB = 1u << 20;
constexpr size_t WS_MOD = 0, WS_BIAS1 = 256 * 1024, WS_BAR = 512 * 1024, BAR_BYTES = 16384;
constexpr size_t WS_BT_IN = 1 * MiB, WS_BT_OUT = 7 * MiB, WS_BT_GU = 9 * MiB, WS_BT_DN = 20 * MiB, WS_BT_C1 = 26 * MiB;
constexpr size_t WS_HID = 28 * MiB, WS_KCN = 36 * MiB, WS_VCT = 36 * MiB + 512 * 1024, WS_GATES = 37 * MiB;
constexpr size_t WS_GTAIL = 40 * MiB, WS_GHEAD = 43 * MiB, WS_UHEAD = 46 * MiB;
constexpr size_t WS_KSN = 50 * MiB, WS_KWN = 58 * MiB, WS_VST = 66 * MiB, WS_VWT = 74 * MiB, WS_QN = 82 * MiB;
constexpr size_t WS_X1B = 50 * MiB;
constexpr size_t WS_XN = 114 * MiB, WS_MIXED = 178 * MiB, WS_PROJ = 242 * MiB, WS_H = WS_PROJ, WS_END = 434 * MiB;

struct Args { const float* in[26]; float* out; unsigned char* ws; };

#define LDS_WAIT() asm volatile("s_waitcnt lgkmcnt(0)" ::: "memory")
__device__ __forceinline__ unsigned f2bf(float f) { unsigned u = __builtin_bit_cast(unsigned, f); return (u + 0x7fffu + ((u >> 16) & 1u)) >> 16; }
__device__ __forceinline__ unsigned pk2(float lo, float hi) { f32x2 v = {lo, hi}; bf16x2_t b = __builtin_convertvector(v, bf16x2_t); return __builtin_bit_cast(unsigned, b); }
__device__ __forceinline__ float bf2f(unsigned short h) { return __builtin_bit_cast(float, (unsigned)h << 16); }
__device__ __forceinline__ float bflo(unsigned w) { return __builtin_bit_cast(float, w << 16); }
__device__ __forceinline__ float bfhi(unsigned w) { return __builtin_bit_cast(float, w & 0xffff0000u); }
__device__ __forceinline__ float wave_sum(float v) {
#pragma unroll
    for (int o = 1; o < 64; o <<= 1) v += __shfl_xor(v, o);
    return v;
}
__device__ __forceinline__ float silu_f(float x) { return x * __builtin_amdgcn_rcpf(1.0f + __builtin_amdgcn_exp2f(-LOG2E * x)); }
__device__ __forceinline__ float gelu_tanh_f(float x) { const float y = 0.7978845608028654f * (x + 0.044715f * x * x * x); const float t = 1.0f - 2.0f * __builtin_amdgcn_rcpf(__builtin_amdgcn_exp2f(2.0f * LOG2E * y) + 1.0f); return 0.5f * x * (1.0f + t); }

#define XB_TMO      128
#define XB_XCNT(j)  (256  + 64 * (j))
#define XB_XSUB(j)  (1280 + 64 * (j))
#define XB_XGEN(j)  (2304 + 64 * (j))
#define XB_TOP      3328
#define XB_TOPGEN   3392
#define XCD_BAR_WORDS 3456
#define XB_SPIN_CAP (1u << 18)

__device__ __forceinline__ unsigned xb_ld(unsigned* p)              { return __hip_atomic_load(p, __ATOMIC_RELAXED, __HIP_MEMORY_SCOPE_AGENT); }
__device__ __forceinline__ unsigned xb_add(unsigned* p, unsigned v) { return __hip_atomic_fetch_add(p, v, __ATOMIC_RELAXED, __HIP_MEMORY_SCOPE_AGENT); }
__device__ __forceinline__ unsigned xb_xcc_id() { return (unsigned)__builtin_amdgcn_s_getreg((3 << 11) | 20) & 0xFu; }
#define XB_SPIN(cond, bar) do { unsigned _sp = 0; while (cond) { __builtin_amdgcn_s_sleep(1); \
    if ((++_sp & 255u) == 0u) { if (xb_ld(&(bar)[XB_TMO])) break; if (_sp > XB_SPIN_CAP) { atomicAdd(&(bar)[XB_TMO], 1u); break; } } } } while (0)

struct XcdBarrier {
    unsigned* bar; unsigned x;
    volatile LAS unsigned* st;
};

__device__ __forceinline__ XcdBarrier xcd_barrier_post(unsigned* bar, volatile LAS unsigned* st) {
    XcdBarrier b; b.bar = bar; b.x = xb_xcc_id(); b.st = st;
    if (threadIdx.x == 0) (void)xb_add(&bar[XB_XCNT(b.x)], 1u);
    return b;
}
__device__ __forceinline__ void xcd_barrier_complete(unsigned* bar, unsigned x, unsigned& nloc, unsigned& nx) {
    const unsigned G = gridDim.x * gridDim.y * gridDim.z;
    unsigned sum, cnt, mine, sp = 0u;
    for (;;) {
        sum = 0u; cnt = 0u; mine = 0u;
#pragma unroll
        for (unsigned j = 0; j < 16; ++j) { const unsigned c = xb_ld(&bar[XB_XCNT(j)]); sum += c; cnt += (c > 0u) ? 1u : 0u; mine = (j == x) ? c : mine; }
        if (sum == G) break;
        __builtin_amdgcn_s_sleep(1);
        if ((++sp & 255u) == 0u) { if (xb_ld(&bar[XB_TMO])) break; if (sp > XB_SPIN_CAP) { atomicAdd(&bar[XB_TMO], 1u); break; } }
    }
    nloc = mine > 0u ? mine : 1u; nx = cnt > 0u ? cnt : 1u;
}

__device__ __forceinline__ void xcd_barrier(const XcdBarrier& b) {
    asm volatile("s_waitcnt vmcnt(0)" ::: "memory");
    __syncthreads();
    if (threadIdx.x == 0) {
        unsigned* bar = b.bar;
        __builtin_amdgcn_s_waitcnt(0);
        unsigned nloc = b.st[0], nx = b.st[1];
        if (nloc == 0u) { xcd_barrier_complete(bar, b.x, nloc, nx); b.st[0] = nloc; b.st[1] = nx; }
        const unsigned old = xb_add(&bar[XB_XSUB(b.x)], 1u);
        const unsigned gen = old / nloc;
        if (old + 1u == (gen + 1u) * nloc) {
            __builtin_amdgcn_fence(__ATOMIC_RELEASE, "agent");
            asm volatile("s_waitcnt vmcnt(0)" ::: "memory");
            const unsigned og = xb_add(&bar[XB_TOP], 1u);
            const unsigned tg = og / nx;
            if (og + 1u == (tg + 1u) * nx) xb_add(&bar[XB_TOPGEN], 1u);
            else XB_SPIN(xb_ld(&bar[XB_TOPGEN]) == tg, bar);
            __builtin_amdgcn_fence(__ATOMIC_ACQUIRE, "agent");
            xb_add(&bar[XB_XGEN(b.x)], 1u);
            asm volatile("s_waitcnt vmcnt(0)" ::: "memory");
        } else {
            XB_SPIN(xb_ld(&bar[XB_XGEN(b.x)]) == gen, bar);
            __builtin_amdgcn_fence(__ATOMIC_ACQUIRE, "agent");
            asm volatile("s_waitcnt vmcnt(0)" ::: "memory");
        }
    }
    __syncthreads();
}


__device__ __forceinline__ void transpose_item(const float* __restrict__ W, int K, int N, bf16* WT, int k0, int n0, int drow0, LAS float* scr, int lane) {
    const int nn = n0 + (lane & 31);
#pragma unroll 8
    for (int i = 0; i < 32; ++i) { const int kk = 2 * i + (lane >> 5); scr[kk * 33 + (lane & 31)] = (nn < N) ? W[(size_t)(k0 + kk) * N + nn] : 0.0f; }
    LDS_WAIT(); asm volatile("" ::: "memory");
    const int c = lane & 7;
#pragma unroll
    for (int j = 0; j < 4; ++j) { const int n = (lane >> 3) + 8 * j; const LAS float* s = scr + (8 * c) * 33 + n;
        v4u o; o.x = pk2(s[0 * 33], s[1 * 33]); o.y = pk2(s[2 * 33], s[3 * 33]); o.z = pk2(s[4 * 33], s[5 * 33]); o.w = pk2(s[6 * 33], s[7 * 33]);
        *(v4u*)(WT + (size_t)(drow0 + n) * K + k0 + 8 * c) = o; }
    LDS_WAIT(); asm volatile("" ::: "memory");
}

__device__ __forceinline__ void phase0(const Args& a, LAS unsigned char* lds) {
    int tid_ = threadIdx.x; asm volatile("" : "+v"(tid_)); const int tid = tid_, lane = tid & 63, wave = tid >> 6, G = gridDim.x;
    unsigned char* ws = a.ws;
    LAS float* SC = (LAS float*)lds;
    LAS float* RED = (LAS float*)(lds + 32768);
    float* mod = (float*)(ws + WS_MOD);
    float* bias1 = (float*)(ws + WS_BIAS1);
    for (int it = blockIdx.x; it < 208; it += G) {
        const int cl = tid & 31, sl = tid >> 5;
        if (it < 192) {
            const float* c = a.in[1]; const float* w_ada = a.in[2]; const float* b_ada = a.in[3];
            for (int i = tid; i < 8192; i += NTHREADS) { const float v = c[i]; SC[i] = silu_f(v); }
            __syncthreads();
            float acc[8];
#pragma unroll
            for (int b = 0; b < 8; ++b) acc[b] = 0.f;
            const int col = it * 32 + cl;
#pragma unroll 8
            for (int k = sl * 64; k < sl * 64 + 64; ++k) {
                const float w = w_ada[(size_t)k * 6144 + col];
#pragma unroll
                for (int b = 0; b < 8; ++b) acc[b] += SC[b * 1024 + k] * w;
            }
#pragma unroll
            for (int b = 0; b < 8; ++b) RED[(sl * 8 + b) * 32 + cl] = acc[b];
            __syncthreads();
            if (tid < 256) { const int b = tid >> 5; float s = 0.f;
#pragma unroll
              for (int w = 0; w < 16; ++w) s += RED[(w * 8 + b) * 32 + cl];
              mod[b * 6144 + it * 32 + cl] = s + b_ada[it * 32 + cl]; }
            __syncthreads();
        } else {
            const int q = it - 192, kv = q >> 3, cgp = q & 7;
            const float* pos = a.in[11 + kv]; const float* w1 = a.in[13 + 2 * kv];
            float acc = 0.f;
#pragma unroll 8
            for (int k = sl * 128; k < sl * 128 + 128; ++k) acc += pos[k] * w1[(size_t)k * 256 + cgp * 32 + cl];
            RED[sl * 32 + cl] = acc;
            __syncthreads();
            if (tid < 32) { float s = 0.f;
#pragma unroll
                for (int w = 0; w < 16; ++w) s += RED[w * 32 + tid];
                bias1[kv * 256 + cgp * 32 + tid] = s; }
            __syncthreads();
        }
    }
}

__device__ __forceinline__ void weight_copies(const Args& a, LAS unsigned char* lds) {
    int tid_ = threadIdx.x; asm volatile("" : "+v"(tid_)); const int tid = tid_, lane = tid & 63, wave = tid >> 6, G = gridDim.x;
    unsigned char* ws = a.ws;
    LAS float* scr = (LAS float*)(lds + 49152 + wave * 8448);
    const int gw = blockIdx.x * NWAVES + wave, NGW = G * NWAVES;
    constexpr int I_IN = 16 * 96, I_OUT = 16 * 32, I_G = 16 * 88, I_D = 44 * 32, I_C = 32 * 8;
    constexpr int TOT = I_IN + I_OUT + 2 * I_G + I_D + 2 * I_C;
    for (int it = gw; it < TOT; it += NGW) {
        int r = it;
        if (r < I_IN) { const int kb = r / 96, nb = r % 96; transpose_item(a.in[5], 1024, NIN, (bf16*)(ws + WS_BT_IN), 64 * kb, 32 * nb, 32 * nb, scr, lane); continue; } r -= I_IN;
        if (r < I_OUT) { const int kb = r / 32, nb = r % 32; transpose_item(a.in[20], 1024, 1024, (bf16*)(ws + WS_BT_OUT), 64 * kb, 32 * nb, 32 * nb, scr, lane); continue; } r -= I_OUT;
        if (r < I_G) { const int kb = r / 88, nb = r % 88, n0 = 32 * nb; transpose_item(a.in[22], 1024, DFF, (bf16*)(ws + WS_BT_GU), 64 * kb, n0, 256 * (n0 >> 7) + (n0 & 127), scr, lane); continue; } r -= I_G;
        if (r < I_G) { const int kb = r / 88, nb = r % 88, n0 = 32 * nb; transpose_item(a.in[23], 1024, DFF, (bf16*)(ws + WS_BT_GU), 64 * kb, n0, 256 * (n0 >> 7) + (n0 & 127) + 128, scr, lane); continue; } r -= I_G;
        if (r < I_D) { const int kb = r / 32, nb = r % 32; transpose_item(a.in[25], DFF, 1024, (bf16*)(ws + WS_BT_DN), 64 * kb, 32 * nb, 32 * nb, scr, lane); continue; } r -= I_D;
        if (r < I_C) { const int kb = r / 8, nb = r % 8; transpose_item(a.in[13], 2048, 256, (bf16*)(ws + WS_BT_C1), 64 * kb, 32 * nb, 32 * nb, scr, lane); continue; } r -= I_C;
        { const int kb = r / 8, nb = r % 8; transpose_item(a.in[15], 2048, 256, (bf16*)(ws + WS_BT_C1) + 256 * 2048, 64 * kb, 32 * nb, 32 * nb, scr, lane); }
    }
}

__device__ __forceinline__ void norm_rows(const float* __restrict__ src, const float* __restrict__ gamma, const float* __restrict__ mod, int sh_off, int sc_off, bf16* dst) {
    int tid_ = threadIdx.x; asm volatile("" : "+v"(tid_)); const int tid = tid_, lane = tid & 63, wave = tid >> 6;
    const int gw = blockIdx.x * NWAVES + wave, NGW = gridDim.x * NWAVES;
    const int per = (MTOK + NGW - 1) / NGW;
    const int r0 = gw * per, r1 = (r0 + per) < MTOK ? (r0 + per) : MTOK;
    if (r0 >= r1) return;
    f32x4 ga[4], sh[4];
    int bcur = -1;
    f32x4 va[4], vb[4];
    { const f32x4* xr = (const f32x4*)(src + (size_t)r0 * DM) + lane;
#pragma unroll
      for (int j = 0; j < 4; ++j) va[j] = xr[64 * j]; }
    { const int rr = (r0 + 1 < r1) ? r0 + 1 : r0; const f32x4* xr = (const f32x4*)(src + (size_t)rr * DM) + lane;
#pragma unroll
      for (int j = 0; j < 4; ++j) vb[j] = xr[64 * j]; }
    for (int row = r0; row < r1; ++row) {
        f32x4 v[4];
#pragma unroll
        for (int j = 0; j < 4; ++j) { v[j] = va[j]; va[j] = vb[j]; }
        { const int rr = (row + 2 < r1) ? row + 2 : row; const f32x4* xr = (const f32x4*)(src + (size_t)rr * DM) + lane;
#pragma unroll
          for (int j = 0; j < 4; ++j) vb[j] = xr[64 * j]; }
        const int b = row >> 12;
        if (b != bcur) { bcur = b; const float* mb = mod + b * 6144;
#pragma unroll
            for (int j = 0; j < 4; ++j) { const int col = 4 * lane + 256 * j; const f32x4 gv = *(const f32x4*)(gamma + col), sc = *(const f32x4*)(mb + sc_off + col);
                sh[j] = *(const f32x4*)(mb + sh_off + col); ga[j] = gv * (1.0f + sc); } }
        float ss = 0.f;
#pragma unroll
        for (int j = 0; j < 4; ++j) ss += v[j][0] * v[j][0] + v[j][1] * v[j][1] + v[j][2] * v[j][2] + v[j][3] * v[j][3];
        ss = wave_sum(ss);
        const float rstd = rsqrtf(ss * (1.0f / DM) + EPS);
#pragma unroll
        for (int j = 0; j < 4; ++j) {
            const int col = 4 * lane + 256 * j;
            f32x4 y;
#pragma unroll
            for (int e = 0; e < 4; ++e) y[e] = (v[j][e] * rstd) * ga[j][e] + sh[j][e];
            v2u o; o.x = pk2(y[0], y[1]); o.y = pk2(y[2], y[3]);
            *(v2u*)(dst + (size_t)row * DM + col) = o;
        }
    }
}

__device__ __forceinline__ void norm_rows_b(const bf16* __restrict__ src, const float* __restrict__ gamma, const float* __restrict__ mod, int sh_off, int sc_off, bf16* dst) {
    int tid_ = threadIdx.x; asm volatile("" : "+v"(tid_)); const int tid = tid_, lane = tid & 63, wave = tid >> 6;
    const int gw = blockIdx.x * NWAVES + wave, NGW = gridDim.x * NWAVES;
    const int per = (MTOK + NGW - 1) / NGW;
    const int r0 = gw * per, r1 = (r0 + per) < MTOK ? (r0 + per) : MTOK;
    if (r0 >= r1) return;
    f32x4 ga[4], sh[4];
    int bcur = -1;
    v4u va[2], vb[2];
    { const v4u* xr = (const v4u*)(src + (size_t)r0 * DM) + lane; va[0] = xr[0]; va[1] = xr[64]; }
    { const int rr = (r0 + 1 < r1) ? r0 + 1 : r0; const v4u* xr = (const v4u*)(src + (size_t)rr * DM) + lane; vb[0] = xr[0]; vb[1] = xr[64]; }
    for (int row = r0; row < r1; ++row) {
        v4u raw[2]; raw[0] = va[0]; raw[1] = va[1]; va[0] = vb[0]; va[1] = vb[1];
        { const int rr = (row + 2 < r1) ? row + 2 : row; const v4u* xr = (const v4u*)(src + (size_t)rr * DM) + lane; vb[0] = xr[0]; vb[1] = xr[64]; }
        const int b = row >> 12;
        if (b != bcur) { bcur = b; const float* mb = mod + b * 6144;
#pragma unroll
            for (int j = 0; j < 4; ++j) { const int col = 512 * (j >> 1) + 8 * lane + 4 * (j & 1); const f32x4 gv = *(const f32x4*)(gamma + col), sc = *(const f32x4*)(mb + sc_off + col);
                sh[j] = *(const f32x4*)(mb + sh_off + col); ga[j] = gv * (1.0f + sc); } }
        f32x4 v[4];
#pragma unroll
        for (int h = 0; h < 2; ++h) { v[2 * h] = (f32x4){bflo(raw[h].x), bfhi(raw[h].x), bflo(raw[h].y), bfhi(raw[h].y)}; v[2 * h + 1] = (f32x4){bflo(raw[h].z), bfhi(raw[h].z), bflo(raw[h].w), bfhi(raw[h].w)}; }
        float ss = 0.f;
#pragma unroll
        for (int j = 0; j < 4; ++j) ss += v[j][0] * v[j][0] + v[j][1] * v[j][1] + v[j][2] * v[j][2] + v[j][3] * v[j][3];
        ss = wave_sum(ss);
        const float rstd = rsqrtf(ss * (1.0f / DM) + EPS);
#pragma unroll
        for (int h = 0; h < 2; ++h) {
            f32x4 y0, y1;
#pragma unroll
            for (int e = 0; e < 4; ++e) { y0[e] = (v[2 * h][e] * rstd) * ga[2 * h][e] + sh[2 * h][e]; y1[e] = (v[2 * h + 1][e] * rstd) * ga[2 * h + 1][e] + sh[2 * h + 1][e]; }
            v4u o; o.x = pk2(y0[0], y0[1]); o.y = pk2(y0[2], y0[3]); o.z = pk2(y1[0], y1[1]); o.w = pk2(y1[2], y1[3]);
            *(v4u*)(dst + (size_t)row * DM + 512 * h + 8 * lane) = o;
        }
    }
}

__device__ __forceinline__ float dpp_shr1(float v) { return __builtin_bit_cast(float, __builtin_amdgcn_update_dpp(0, __builtin_bit_cast(int, v), 0x111, 0xf, 0xf, true)); }
__device__ __forceinline__ float dpp_shr2(float v) { return __builtin_bit_cast(float, __builtin_amdgcn_update_dpp(0, __builtin_bit_cast(int, v), 0x112, 0xf, 0xf, true)); }
__device__ __forceinline__ unsigned dpp_ror8(unsigned v) { return (unsigned)__builtin_amdgcn_update_dpp(0, (int)v, 0x128, 0xf, 0xf, false); }
struct EpiProj {
    static constexpr bool PERM = true, PERM2 = true, AFTER_DRAIN = false;
    bf16* P; bf16* QN; bf16* KSN; bf16* KWN; float* gates; const float* gq; const float* gs; const float* gw; const float* bgate;
    __device__ __forceinline__ void operator()(const f32x4 (&acc)[2][2][4][2], const pg8::Unit& u, int wr, int wc, int fr, int fq) const {
        const bool lo = fr < 8;
        const int colb = u.pn * 256 + wc * 64, seg = colb >> 6, d = (lo ? 0 : 32) + 8 * fq;
        const bool keep = (colb + d) < NIN;
        const int rowb = u.pm * 256 + wr * 64 + (fr & 7);
        bf16* base = P; int ns = NSEG, sidx = seg; const float* gm = nullptr; float mult = 1.0f;
        if (seg < 8) { base = QN; ns = 8; gm = gq; mult = 0.125f * LOG2E; }
        else if (seg == 12 || seg == 13) { base = KSN; ns = 2; sidx = seg - 12; gm = gs; }
        else if (seg == 16 || seg == 17) { base = KWN; ns = 2; sidx = seg - 16; gm = gw; }
        f32x4 g00 = {1.f, 1.f, 1.f, 1.f}, g01 = g00, g10 = g00, g11 = g00;
        if (gm) { g00 = *(const f32x4*)(gm + 8 * fq); g01 = *(const f32x4*)(gm + 8 * fq + 4); g10 = *(const f32x4*)(gm + 32 + 8 * fq); g11 = *(const f32x4*)(gm + 32 + 8 * fq + 4); }
#pragma unroll
        for (int ai = 0; ai < 2; ++ai)
#pragma unroll
            for (int m = 0; m < 4; ++m) {
                f32x4 a0 = acc[ai][0][m][0], a1 = acc[ai][0][m][1], b0 = acc[ai][1][m][0], b1 = acc[ai][1][m][1];
                const int rown = u.pm * 256 + wr * 64 + ai * 128 + m * 16 + fr;
                if (gm) {
                    float ss = 0.f;
#pragma unroll
                    for (int e = 0; e < 4; ++e) ss += a0[e] * a0[e] + a1[e] * a1[e] + b0[e] * b0[e] + b1[e] * b1[e];
                    ss += __shfl_xor(ss, 16); ss += __shfl_xor(ss, 32);
                    const float rs = rsqrtf(ss * (1.0f / 64.0f) + EPS) * mult;
                    a0 = a0 * rs * g00; a1 = a1 * rs * g01; b0 = b0 * rs * g10; b1 = b1 * rs * g11;
                } else if (seg == 20 && fq < 3) {
                    const f32x4 bg0 = *(const f32x4*)(bgate + 8 * fq), bg1 = *(const f32x4*)(bgate + 8 * fq + 4);
                    f32x4 s0, s1;
#pragma unroll
                    for (int e = 0; e < 4; ++e) { s0[e] = __builtin_amdgcn_rcpf(1.0f + __builtin_amdgcn_exp2f(-LOG2E * (a0[e] + bg0[e]))); s1[e] = __builtin_amdgcn_rcpf(1.0f + __builtin_amdgcn_exp2f(-LOG2E * (a1[e] + bg1[e]))); }
                    *(f32x4*)(gates + (size_t)rown * 24 + 8 * fq) = s0; *(f32x4*)(gates + (size_t)rown * 24 + 8 * fq + 4) = s1;
                }
                v4u p0, p1; p0.x = pk2(a0[0], a0[1]); p0.y = pk2(a0[2], a0[3]); p0.z = pk2(a1[0], a1[1]); p0.w = pk2(a1[2], a1[3]);
                p1.x = pk2(b0[0], b0[1]); p1.y = pk2(b0[2], b0[3]); p1.z = pk2(b1[0], b1[1]); p1.w = pk2(b1[2], b1[3]);
                const unsigned sx = lo ? p1.x : p0.x, sy = lo ? p1.y : p0.y, sz = lo ? p1.z : p0.z, sw = lo ? p1.w : p0.w;
                v4u rc; rc.x = dpp_ror8(sx); rc.y = dpp_ror8(sy); rc.z = dpp_ror8(sz); rc.w = dpp_ror8(sw);
                v4u s1, s2;
                s1.x = lo ? p0.x : rc.x; s1.y = lo ? p0.y : rc.y; s1.z = lo ? p0.z : rc.z; s1.w = lo ? p0.w : rc.w;
                s2.x = lo ? rc.x : p1.x; s2.y = lo ? rc.y : p1.y; s2.z = lo ? rc.z : p1.z; s2.w = lo ? rc.w : p1.w;
                const int r = rowb + ai * 128 + m * 16, b = r >> 12, t = r & 4095;
                bf16* dst = base + ((size_t)(b * ns + sidx) * SEQ + t) * 64 + d;
                if (keep) { __builtin_nontemporal_store(s1, (v4u*)dst); __builtin_nontemporal_store(s2, (v4u*)(dst + 8 * 64)); }
            }
    }
};
struct EpiRes {
    static constexpr bool PERM = true, PERM2 = false, AFTER_DRAIN = false;
    const float* base; float* out; const float* mod; int goff;
    __device__ __forceinline__ void operator()(const f32x4 (&acc)[2][2][4][2], const pg8::Unit& u, int wr, int wc, int fr, int fq) const {
        const int row0 = u.pm * 256 + wr * 64 + fr, col0 = u.pn * 256 + wc * 32 + 8 * fq;
        const int b = (u.pm * 256) >> 12;
        f32x4 gv[2][2];
#pragma unroll
        for (int bj = 0; bj < 2; ++bj)
#pragma unroll
            for (int n = 0; n < 2; ++n) gv[bj][n] = *(const f32x4*)(mod + b * 6144 + goff + col0 + bj * 128 + n * 4);
#pragma unroll
        for (int ai = 0; ai < 2; ++ai) {
            f32x4 xv[4][2][2];
#pragma unroll
            for (int m = 0; m < 4; ++m) { const size_t r = (size_t)(row0 + ai * 128 + m * 16);
#pragma unroll
                for (int bj = 0; bj < 2; ++bj)
#pragma unroll
                    for (int n = 0; n < 2; ++n) xv[m][bj][n] = *(const f32x4*)(base + r * DM + col0 + bj * 128 + n * 4); }
#pragma unroll
            for (int m = 0; m < 4; ++m) { const size_t r = (size_t)(row0 + ai * 128 + m * 16);
#pragma unroll
                for (int bj = 0; bj < 2; ++bj)
#pragma unroll
                    for (int n = 0; n < 2; ++n) *(f32x4*)(out + r * DM + col0 + bj * 128 + n * 4) = xv[m][bj][n] + gv[bj][n] * acc[ai][bj][m][n]; }
        }
    }
};
struct EpiResB {
    static constexpr bool PERM = true, PERM2 = false, AFTER_DRAIN = false;
    const float* base; bf16* out; const float* mod; int goff;
    __device__ __forceinline__ void operator()(const f32x4 (&acc)[2][2][4][2], const pg8::Unit& u, int wr, int wc, int fr, int fq) const {
        const int row0 = u.pm * 256 + wr * 64 + fr, col0 = u.pn * 256 + wc * 32 + 8 * fq;
        const int b = (u.pm * 256) >> 12;
        f32x4 gv[2][2];
#pragma unroll
        for (int bj = 0; bj < 2; ++bj)
#pragma unroll
            for (int n = 0; n < 2; ++n) gv[bj][n] = *(const f32x4*)(mod + b * 6144 + goff + col0 + bj * 128 + n * 4);
#pragma unroll
        for (int ai = 0; ai < 2; ++ai) {
            f32x4 xv[4][2][2];
#pragma unroll
            for (int m = 0; m < 4; ++m) { const size_t r = (size_t)(row0 + ai * 128 + m * 16);
#pragma unroll
                for (int bj = 0; bj < 2; ++bj)
#pragma unroll
                    for (int n = 0; n < 2; ++n) xv[m][bj][n] = *(const f32x4*)(base + r * DM + col0 + bj * 128 + n * 4); }
#pragma unroll
            for (int m = 0; m < 4; ++m) { const size_t r = (size_t)(row0 + ai * 128 + m * 16);
#pragma unroll
                for (int bj = 0; bj < 2; ++bj) { const f32x4 v0 = xv[m][bj][0] + gv[bj][0] * acc[ai][bj][m][0], v1 = xv[m][bj][1] + gv[bj][1] * acc[ai][bj][m][1];
                    v4u w; w.x = pk2(v0[0], v0[1]); w.y = pk2(v0[2], v0[3]); w.z = pk2(v1[0], v1[1]); w.w = pk2(v1[2], v1[3]);
                    *(v4u*)(out + r * DM + col0 + bj * 128) = w; } }
        }
    }
};
struct EpiResF {
    static constexpr bool PERM = true, PERM2 = false, AFTER_DRAIN = false;
    const bf16* base; float* out; const float* mod; int goff;
    __device__ __forceinline__ void operator()(const f32x4 (&acc)[2][2][4][2], const pg8::Unit& u, int wr, int wc, int fr, int fq) const {
        const int row0 = u.pm * 256 + wr * 64 + fr, col0 = u.pn * 256 + wc * 32 + 8 * fq;
        const int b = (u.pm * 256) >> 12;
        f32x4 gv[2][2];
#pragma unroll
        for (int bj = 0; bj < 2; ++bj)
#pragma unroll
            for (int n = 0; n < 2; ++n) gv[bj][n] = *(const f32x4*)(mod + b * 6144 + goff + col0 + bj * 128 + n * 4);
#pragma unroll
        for (int ai = 0; ai < 2; ++ai) {
            v4u xv[4][2];
#pragma unroll
            for (int m = 0; m < 4; ++m) { const size_t r = (size_t)(row0 + ai * 128 + m * 16);
#pragma unroll
                for (int bj = 0; bj < 2; ++bj) xv[m][bj] = *(const v4u*)(base + r * DM + col0 + bj * 128); }
#pragma unroll
            for (int m = 0; m < 4; ++m) { const size_t r = (size_t)(row0 + ai * 128 + m * 16);
#pragma unroll
                for (int bj = 0; bj < 2; ++bj) { const v4u x = xv[m][bj];
                    const f32x4 x0 = {bflo(x.x), bfhi(x.x), bflo(x.y), bfhi(x.y)}, x1 = {bflo(x.z), bfhi(x.z), bflo(x.w), bfhi(x.w)};
                    *(f32x4*)(out + r * DM + col0 + bj * 128) = x0 + gv[bj][0] * acc[ai][bj][m][0];
                    *(f32x4*)(out + r * DM + col0 + bj * 128 + 4) = x1 + gv[bj][1] * acc[ai][bj][m][1]; } }
        }
    }
};
struct EpiCmp {
    static constexpr bool PERM = false, PERM2 = false, AFTER_DRAIN = false;
    float* hid; const float* bias1;
    __device__ __forceinline__ void operator()(const f32x4 (&acc)[2][2][4][2], const pg8::Unit& u, int wr, int wc, int fr, int fq) const {
        const int row0 = wr * 64 + fr, col0 = wc * 32 + 4 * fq;
        float* hb = hid + ((size_t)u.pn * 4096 + (size_t)u.pm * 256) * 256;
#pragma unroll
        for (int ai = 0; ai < 2; ++ai)
#pragma unroll
            for (int m = 0; m < 4; ++m) { const int r = row0 + ai * 128 + m * 16;
#pragma unroll
                for (int bj = 0; bj < 2; ++bj)
#pragma unroll
                    for (int n = 0; n < 2; ++n) { const int c = col0 + bj * 128 + n * 16;
                        const f32x4 bv = *(const f32x4*)(bias1 + u.pn * 256 + c); f32x4 v = acc[ai][bj][m][n] + bv;
#pragma unroll
                        for (int e = 0; e < 4; ++e) v[e] = gelu_tanh_f(v[e]);
                        *(f32x4*)(hb + (size_t)r * 256 + c) = v; } }
    }
};
struct CmpOrder {
    int c; const bf16* proj; const bf16* btc1;
    __device__ bool next(int i, pg8::Unit& u) const { if (i > 0 || c >= 32) return false; u.pm = c & 15; u.pn = c >> 4; return true; }
    __device__ __forceinline__ const char* a_ptr(const pg8::Gemm&, const pg8::Unit& u) const { const int b = u.pm >> 1, g = u.pm & 1; return (const char*)(proj + ((size_t)(b * NSEG + 8 + 2 * u.pn + g) * SEQ) * 64); }
    __device__ __forceinline__ const char* b_ptr(const pg8::Gemm&, const pg8::Unit& u) const { return (const char*)(btc1 + (size_t)u.pn * 256 * 2048); }
    __device__ __forceinline__ void a_ready(const pg8::Unit&) const {}
    __device__ __forceinline__ void done(const pg8::Unit&) const {}
};
struct EpiFfn {
    static constexpr bool PERM = true, PERM2 = false, AFTER_DRAIN = false;
    bf16* H; const float* cw; float* gtail; float* ghead; float* uhead; LAS float* hb;
    __device__ __forceinline__ void operator()(const f32x4 (&acc)[2][2][4][2], const pg8::Unit& u, int wr, int wc, int fr, int fq) const {
        int cl_ = wc * 32 + 8 * fq; asm volatile("" : "+v"(cl_));
        const int cl = cl_, ch0 = u.pn * 128 + cl;
        if (fr >= 14) {
#pragma unroll
            for (int ai = 0; ai < 2; ++ai)
#pragma unroll
                for (int m = 0; m < 4; ++m) { const int kk = 8 * ai + 4 * wr + m;
#pragma unroll
                    for (int n = 0; n < 2; ++n) *(LAS f32x4*)(hb + ((kk * 2 + (fr - 14)) * 128 + cl + 4 * n)) = acc[ai][0][m][n]; }
        }
        asm volatile("s_waitcnt lgkmcnt(0)" ::: "memory"); __builtin_amdgcn_s_barrier(); asm volatile("" ::: "memory");
        f32x4 w0[2], w1[2], w2[2];
#pragma unroll
        for (int n = 0; n < 2; ++n) { w0[n] = *(const f32x4*)(cw + ch0 + 4 * n); w1[n] = *(const f32x4*)(cw + DFF + ch0 + 4 * n); w2[n] = *(const f32x4*)(cw + 2 * DFF + ch0 + 4 * n); }
#pragma unroll
        for (int ai = 0; ai < 2; ++ai)
#pragma unroll
            for (int m = 0; m < 4; ++m) { const int kk = 8 * ai + 4 * wr + m; const int rl = 128 * ai + 64 * wr + 16 * m + fr; const size_t r = (size_t)u.pm * 256 + rl;
                f32x4 hv[2];
#pragma unroll
                for (int n = 0; n < 2; ++n) { const f32x4 g0 = acc[ai][0][m][n]; f32x4 g1, g2;
                    g1[0] = dpp_shr1(g0[0]); g1[1] = dpp_shr1(g0[1]); g1[2] = dpp_shr1(g0[2]); g1[3] = dpp_shr1(g0[3]);
                    g2[0] = dpp_shr2(g0[0]); g2[1] = dpp_shr2(g0[1]); g2[2] = dpp_shr2(g0[2]); g2[3] = dpp_shr2(g0[3]);
                    if (fr < 2) { const f32x4 z = {0.f, 0.f, 0.f, 0.f};
                        const f32x4 p15 = kk > 0 ? *(const LAS f32x4*)(hb + (((kk - 1) * 2 + 1) * 128 + cl + 4 * n)) : z;
                        const f32x4 p14 = kk > 0 ? *(const LAS f32x4*)(hb + (((kk - 1) * 2 + 0) * 128 + cl + 4 * n)) : z;
                        if (fr == 0) { g1 = p15; g2 = p14; } else { g2 = p15; } }
                    const f32x4 pre = w0[n] * g2 + w1[n] * g1 + w2[n] * g0; const f32x4 up = acc[ai][1][m][n];
#pragma unroll
                    for (int e = 0; e < 4; ++e) hv[n][e] = silu_f(pre[e]) * up[e];
                    if (kk == 0 && fr < 2) { *(f32x4*)(ghead + ((size_t)u.pm * 2 + fr) * DFF + ch0 + 4 * n) = g0; *(f32x4*)(uhead + ((size_t)u.pm * 2 + fr) * DFF + ch0 + 4 * n) = up; }
                    if (kk == 15 && fr >= 14) *(f32x4*)(gtail + ((size_t)u.pm * 2 + (fr - 14)) * DFF + ch0 + 4 * n) = g0;
                }
                v4u w; w.x = pk2(hv[0][0], hv[0][1]); w.y = pk2(hv[0][2], hv[0][3]); w.z = pk2(hv[1][0], hv[1][1]); w.w = pk2(hv[1][2], hv[1][3]);
                __builtin_nontemporal_store(w, (v4u*)(H + r * DFF + ch0)); }
    }
};

__device__ __forceinline__ void phase3_prep(const Args& a, LAS unsigned char* lds, int pw, int PW) {
    int tid_ = threadIdx.x; asm volatile("" : "+v"(tid_)); const int tid = tid_, lane = tid & 63, wave = tid >> 6;
    unsigned char* ws = a.ws;
    const bf16* __restrict__ proj = (const bf16*)(ws + WS_PROJ);
    {
        bf16* mixed = (bf16*)(ws + WS_MIXED);
        const float* cw = a.in[17]; const float* cg_g = a.in[19];
        const int sub = lane & 7;
        constexpr int NST = NB * 8 * SEQ / 8;
        for (int st0 = pw; st0 < NST; st0 += 2 * PW) {
            v4u rb[2], rc0[2], rx0[2], rc1[2], rx1[2], rc2[2], rx2[2];
#pragma unroll
            for (int u = 0; u < 2; ++u) { const int st1 = st0 + u * PW, st = st1 < NST ? st1 : NST - 1;
                {
                    const int b = st >> 12, cgp = (st >> 9) & 7, t = (st & 511) * 8 + (lane >> 3);
                    const int c = cgp * 64 + sub * 8;
                    const int colB = 1304 + c, colC = 1816 + c, colX = 2328 + c;
                    const bf16* pB = proj + ((size_t)(b * NSEG + (colB >> 6)) * SEQ + t) * 64 + (colB & 63);
                    const bf16* pC = proj + ((size_t)(b * NSEG + (colC >> 6)) * SEQ + t) * 64 + (colC & 63);
                    const bf16* pX = proj + ((size_t)(b * NSEG + (colX >> 6)) * SEQ + t) * 64 + (colX & 63);
                    const v4u z = {0u, 0u, 0u, 0u};
                    rb[u] = *(const v4u*)pB; rc0[u] = *(const v4u*)pC; rx0[u] = *(const v4u*)pX;
                    rc1[u] = t >= 1 ? *(const v4u*)(pC - 64) : z; rx1[u] = t >= 1 ? *(const v4u*)(pX - 64) : z;
                    rc2[u] = t >= 2 ? *(const v4u*)(pC - 128) : z; rx2[u] = t >= 2 ? *(const v4u*)(pX - 128) : z; } }
#pragma unroll
            for (int u = 0; u < 2; ++u) { const int st1 = st0 + u * PW, st = st1 < NST ? st1 : NST - 1;
                {
                    const int b = st >> 12, cgp = (st >> 9) & 7, t = (st & 511) * 8 + (lane >> 3);
                    const int c = cgp * 64 + sub * 8;
                    const f32x4 w0a = *(const f32x4*)(cw + c), w0b = *(const f32x4*)(cw + c + 4), w1a = *(const f32x4*)(cw + 512 + c), w1b = *(const f32x4*)(cw + 512 + c + 4);
                    const f32x4 w2a = *(const f32x4*)(cw + 1024 + c), w2b = *(const f32x4*)(cw + 1024 + c + 4), ga = *(const f32x4*)(cg_g + c), gb = *(const f32x4*)(cg_g + c + 4);
                    float v[8];
#define CONV_E(e, RW, W0, W1, W2, LOHI) v[e] = LOHI(rb[u].RW) * (W0 * (LOHI(rc2[u].RW) * LOHI(rx2[u].RW)) + W1 * (LOHI(rc1[u].RW) * LOHI(rx1[u].RW)) + W2 * (LOHI(rc0[u].RW) * LOHI(rx0[u].RW)))
                    CONV_E(0, x, w0a[0], w1a[0], w2a[0], bflo); CONV_E(1, x, w0a[1], w1a[1], w2a[1], bfhi); CONV_E(2, y, w0a[2], w1a[2], w2a[2], bflo); CONV_E(3, y, w0a[3], w1a[3], w2a[3], bfhi);
                    CONV_E(4, z, w0b[0], w1b[0], w2b[0], bflo); CONV_E(5, z, w0b[1], w1b[1], w2b[1], bfhi); CONV_E(6, w, w0b[2], w1b[2], w2b[2], bflo); CONV_E(7, w, w0b[3], w1b[3], w2b[3], bfhi);
#undef CONV_E
                    float ss = 0.f;
#pragma unroll
                    for (int e = 0; e < 8; ++e) ss += v[e] * v[e];
                    ss += __shfl_xor(ss, 1); ss += __shfl_xor(ss, 2); ss += __shfl_xor(ss, 4);
                    const float rs = rsqrtf(ss * (1.0f / 64.0f) + EPS);
                    v4u o; o.x = pk2(v[0] * rs * ga[0], v[1] * rs * ga[1]); o.y = pk2(v[2] * rs * ga[2], v[3] * rs * ga[3]);
                    o.z = pk2(v[4] * rs * gb[0], v[5] * rs * gb[1]); o.w = pk2(v[6] * rs * gb[2], v[7] * rs * gb[3]);
                    if (st1 < NST) *(v4u*)(mixed + ((size_t)b * SEQ + t) * DM + 512 + c) = o;
                } }
        }
    }
}

__device__ __forceinline__ void phase4(const Args& a, LAS unsigned char* lds) {
    int tid_ = threadIdx.x; asm volatile("" : "+v"(tid_)); const int tid = tid_, lane = tid & 63, wave = tid >> 6;
    unsigned char* ws = a.ws;
    const float* hid = (const float*)(ws + WS_HID);
    const int G = gridDim.x, half = G >> 1;
    const int kv = (int)blockIdx.x >= half ? 1 : 0;
    const int bl = (int)blockIdx.x - kv * half, nb = kv ? (G - half) : half;
    LAS float* W2 = (LAS float*)lds;
    LAS float* scr = (LAS float*)(lds + 65536 + wave * 4096);
    { const float* w2 = a.in[14 + 2 * kv];
#pragma unroll
      for (int q = 0; q < 8; ++q) { const int idx = q * 512 + tid; *(LAS f32x4*)(W2 + idx * 4) = *(const f32x4*)(w2 + idx * 4); } }
    __syncthreads();
    for (int it = bl * NWAVES + wave; it < 1024; it += nb * NWAVES) {
        const int r4 = it * 4;
#pragma unroll
        for (int j = 0; j < 4; ++j)
#pragma unroll
            for (int q = 0; q < 4; ++q) scr[(q * 64 + lane) * 4 + j] = hid[((size_t)kv * 4096 + r4 + j) * 256 + q * 64 + lane];
        LDS_WAIT(); asm volatile("" ::: "memory");
        f32x4 acc = {0.f, 0.f, 0.f, 0.f};
#pragma unroll 16
        for (int k = 0; k < 256; ++k) { const float w = W2[k * 64 + lane]; const f32x4 h = *(const LAS f32x4*)(scr + k * 4); acc += h * w; }
        LDS_WAIT(); asm volatile("" ::: "memory");
#pragma unroll
        for (int j = 0; j < 4; ++j) {
            const int row = r4 + j, pair = row >> 8, n = row & 255;
            if (kv == 0) {
                const float ss = wave_sum(acc[j] * acc[j]);
                const float y = acc[j] * rsqrtf(ss * (1.0f / 64.0f) + EPS) * a.in[8][lane];
                ((bf16*)(ws + WS_KCN))[((size_t)pair * 256 + n) * 64 + lane] = (n < 255) ? (bf16)f2bf(y) : (bf16)0;
            } else {
                ((bf16*)(ws + WS_VCT))[((size_t)pair * 64 + lane) * 256 + n] = (n < 255) ? (bf16)f2bf(acc[j]) : (bf16)0;
            }
        }
    }
}

#ifndef PROBE_CMP
#define PROBE_CMP 0
#endif
#ifndef PROBE_TOPK
#define PROBE_TOPK 0
#endif
#ifndef PROBE_SEL
#define PROBE_SEL 0
#endif
#ifndef PROBE_WIN
#define PROBE_WIN 0
#endif
#define MFMA32(a, b, c) __builtin_amdgcn_mfma_f32_32x32x16_bf16((a), (b), (c), 0, 0, 0)
constexpr int AT_CK = 0, AT_CV = 36864, AT_PS = 70656, AT_SLOT = 0, AT_OF = 73728, AT_WU = 139264, AT_KEYS = 139392, PS_PITCH = 260;
constexpr int QCTR_WORD = 3584;
constexpr int AT_KB0 = 0, AT_KB1 = 9216, AT_VB0 = 18432, AT_VB1 = 27648;
constexpr float NEG_BIG = -1.0e30f;

__device__ __forceinline__ float quad_sum(float t) {
    t += __builtin_bit_cast(float, __builtin_amdgcn_mov_dpp(__builtin_bit_cast(int, t), 0xB1, 0xf, 0xf, true));
    t += __builtin_bit_cast(float, __builtin_amdgcn_mov_dpp(__builtin_bit_cast(int, t), 0x4E, 0xf, 0xf, true));
    return t;
}
__device__ __forceinline__ s16x4 vtr(const LAS unsigned char* p) { return __builtin_amdgcn_ds_read_tr16_b64_v4i16((LAS s16x4*)p); }
template <int MODE, bool DIAG, bool VTR = false>
__device__ __forceinline__ void attn_tile(const LAS unsigned char* Kt, const LAS unsigned char* Vt, int vpitch, int vkoff, const bf16x8 (&qf)[4], int r, int h2,
                                          float cs, float A, int lo, int hi, float& m, float& l, f32x16 (&o)[2], float inv_l, LAS float* psrow) {
    float rowsum = 0.f;
#pragma unroll
    for (int sub = 0; sub < 2; ++sub) {
        f32x16 s;
#pragma unroll
        for (int i = 0; i < 16; ++i) s[i] = __builtin_fmaf(cs, (float)(32 * sub + (i & 3) + 8 * (i >> 2)), A);
#pragma unroll
        for (int ks = 0; ks < 4; ++ks) { const bf16x8 kf = *(const LAS bf16x8*)(Kt + (32 * sub + r) * 144 + (16 * ks + 8 * h2) * 2); s = MFMA32(kf, qf[ks], s); }
        if (DIAG) {
#pragma unroll
            for (int i = 0; i < 16; ++i) { const int ci = 32 * sub + (i & 3) + 8 * (i >> 2); s[i] = (ci >= lo && ci <= hi) ? s[i] : -INFINITY; }
        }
        if (MODE == 0) {
            float mx = s[0];
#pragma unroll
            for (int i = 1; i < 16; ++i) mx = fmaxf(mx, s[i]);
            mx = fmaxf(mx, __shfl_xor(mx, 32));
            const float mn = fmaxf(m, mx); l *= __builtin_amdgcn_exp2f(m - mn); m = mn;
            float rs = 0.f;
#pragma unroll
            for (int i = 0; i < 16; ++i) rs += __builtin_amdgcn_exp2f(s[i] - mn);
            l += rs;
            continue;
        }
#pragma unroll
        for (int i = 0; i < 16; ++i) {
            float p;
            if (MODE == 1) p = __builtin_amdgcn_exp2f(s[i] - m) * inv_l; else p = __builtin_amdgcn_exp2f(s[i]);
            rowsum += p; s[i] = p;
        }
        if (MODE == 1) {
#pragma unroll
            for (int i = 0; i < 16; ++i) { const float t = quad_sum(s[i]);
                if ((r & 3) == 0) psrow[32 * sub + (i & 3) + 8 * (i >> 2) + 4 * h2] = t; }
        }
#pragma unroll
        for (int st = 0; st < 2; ++st) {
            v4u pw; pw.x = pk2(s[8 * st + 0], s[8 * st + 1]); pw.y = pk2(s[8 * st + 2], s[8 * st + 3]);
            pw.z = pk2(s[8 * st + 4], s[8 * st + 5]); pw.w = pk2(s[8 * st + 6], s[8 * st + 7]);
            const bf16x8 pf = __builtin_bit_cast(bf16x8, pw);
#pragma unroll
            for (int dt = 0; dt < 2; ++dt) {
                s16x4 lo4, hi4;
                if (VTR) {
                    const LAS unsigned char* vp = Vt + (32 * sub + 16 * st + 4 * h2 + ((r & 15) >> 2)) * vpitch + (32 * dt + 16 * (r >> 4)) * 2 + 8 * (r & 3);
                    lo4 = vtr(vp); hi4 = vtr(vp + 8 * vpitch);
                } else {
                    const LAS unsigned char* vp = Vt + (32 * dt + r) * vpitch + vkoff + (32 * sub + 16 * st + 4 * h2) * 2;
                    lo4 = *(const LAS s16x4*)(vp); hi4 = *(const LAS s16x4*)(vp + 16);
                }
                const bf16x8 vf = __builtin_shufflevector(lo4, hi4, 0, 1, 2, 3, 4, 5, 6, 7);
                o[dt] = MFMA32(vf, pf, o[dt]);
            }
        }
    }
    if (MODE >= 2) l += rowsum;
}

template <int MODE>
__device__ __forceinline__ void attn_blocks(LAS unsigned char* lds, unsigned long long blocks, unsigned long long wmask, int iq, const bf16* Kg, const bf16* Vtg, const bf16x8 (&qf)[4], int r, int h2,
                                            float slope2, float smax2, int tpos, unsigned long long mymask, float& l, f32x16 (&o)[2]) {
    int tid_ = threadIdx.x; asm volatile("" : "+v"(tid_)); const int tid = tid_;
    const int lrow = tid >> 3, lch = tid & 7;
    const int loff = lrow * 144 + lch * 16;
    const unsigned char* kgp = (const unsigned char*)Kg + tid * 16;
    const unsigned char* vgp = (const unsigned char*)Vtg + tid * 16;
    float mdummy = 0.f;
    unsigned long long rem = blocks;
    int j0 = __builtin_ctzll(rem); rem &= rem - 1;
    int j1 = rem ? __builtin_ctzll(rem) : -1; if (rem) rem &= rem - 1;
    v4u k0, v0, k1 = {0u, 0u, 0u, 0u}, v1 = {0u, 0u, 0u, 0u};
    k0 = *(const v4u*)(kgp + (size_t)j0 * 8192); v0 = *(const v4u*)(vgp + (size_t)j0 * 8192);
    if (j1 >= 0) { k1 = *(const v4u*)(kgp + (size_t)j1 * 8192); v1 = *(const v4u*)(vgp + (size_t)j1 * 8192); }
    *(LAS v4u*)(lds + AT_SLOT + loff) = k0; *(LAS v4u*)(lds + AT_SLOT + 9216 + loff) = v0;
    *(LAS v4u*)(lds + AT_SLOT + 18432 + loff) = k1; *(LAS v4u*)(lds + AT_SLOT + 27648 + loff) = v1;
    __syncthreads();
    int cur = 0;
    for (;;) {
        const int n0 = rem ? __builtin_ctzll(rem) : -1; if (rem) rem &= rem - 1;
        const int n1 = rem ? __builtin_ctzll(rem) : -1; if (rem) rem &= rem - 1;
        if (n0 >= 0) { k0 = *(const v4u*)(kgp + (size_t)n0 * 8192); v0 = *(const v4u*)(vgp + (size_t)n0 * 8192); }
        if (n1 >= 0) { k1 = *(const v4u*)(kgp + (size_t)n1 * 8192); v1 = *(const v4u*)(vgp + (size_t)n1 * 8192); }
        const LAS unsigned char* sb = lds + AT_SLOT + cur * 36864;
#pragma unroll
        for (int u = 0; u < 2; ++u) {
            const int j = u ? j1 : j0;
            if (j >= 0 && ((wmask >> j) & 1ull)) {
                int rr = r, hh = h2; asm volatile("" : "+v"(rr), "+v"(hh));
                const bool on = (mymask >> j) & 1ull;
                const int rel = tpos - 64 * j - 4 * h2;
                float A = -slope2 * (float)rel - smax2;
                if (MODE == 2 && !on) A = -INFINITY;
                const LAS unsigned char* kb = sb + u * 18432; const LAS unsigned char* vb = kb + 9216;
                if (j == iq || (MODE == 3 && j == iq - 8)) attn_tile<MODE, true, true>(kb, vb, 144, 0, qf, rr, hh, slope2, A, (MODE == 3) ? rel - 511 : -100000, rel, mdummy, l, o, 0.f, nullptr);
                else attn_tile<MODE, false, true>(kb, vb, 144, 0, qf, rr, hh, slope2, A, 0, 0, mdummy, l, o, 0.f, nullptr);
            }
        }
        if (n0 >= 0) {
            LAS unsigned char* nb = lds + AT_SLOT + (cur ^ 1) * 36864;
            *(LAS v4u*)(nb + loff) = k0; *(LAS v4u*)(nb + 9216 + loff) = v0;
            if (n1 >= 0) { *(LAS v4u*)(nb + 18432 + loff) = k1; *(LAS v4u*)(nb + 27648 + loff) = v1; }
        }
        __syncthreads();
        if (n0 < 0) break;
        j0 = n0; j1 = n1; cur ^= 1;
    }
}

__device__ __forceinline__ float max_abs64(const float* g) {
    float m = fabsf(g[threadIdx.x & 63]);
#pragma unroll
    for (int o = 1; o < 64; o <<= 1) m = fmaxf(m, __shfl_xor(m, o));
    return m; }

__device__ __forceinline__ void phase5(const Args& a, LAS unsigned char* lds) {
    int tid_ = threadIdx.x; asm volatile("" : "+v"(tid_)); const int tid = tid_, lane = tid & 63, wave = tid >> 6, G = gridDim.x, c = blockIdx.x;
    unsigned char* ws = a.ws;
    const bf16* QN = (const bf16*)(ws + WS_QN);
    const float* gates = (const float*)(ws + WS_GATES);
    bf16* mixed = (bf16*)(ws + WS_MIXED);
    LAS float* PS = (LAS float*)(lds + AT_PS);
    LAS unsigned long long* WU = (LAS unsigned long long*)(lds + AT_WU);
    const float qb = max_abs64(a.in[7]) * (64.0f * 0.125f * LOG2E * 1.02f);
    const float smax_s = qb * max_abs64(a.in[9]), smax_w = qb * max_abs64(a.in[10]);
    for (int rd = 0;; ++rd) {
        const int rank = rd * G + ((rd & 1) ? (G - 1 - c) : c);
        if (rd * G >= 1024) break;
        if (rank >= 1024) continue;
        int ln_ = lane; asm volatile("" : "+v"(ln_));
        const int r = ln_ & 31, h2 = ln_ >> 5, hq = r & 3, tl = r >> 2;
        const int i = 63 - (rank >> 4), bg = rank & 15, b = bg >> 1, g = bg & 1;
        const int T0 = 64 * i, tpos = T0 + 8 * wave + tl;
        const int head = 4 * g + hq;
        const float slope2 = exp2f(-(float)(head + 1)) * LOG2E;
        const size_t mrow = (size_t)b * SEQ + tpos;
        {
            const unsigned char* kc = (const unsigned char*)((const bf16*)(ws + WS_KCN) + (size_t)bg * 256 * 64);
            const unsigned char* vc = (const unsigned char*)((const bf16*)(ws + WS_VCT) + (size_t)bg * 64 * 256);
#pragma unroll
            for (int q = 0; q < 4; ++q) { const int idx = q * 512 + tid;
                const v4u kv_ = *(const v4u*)(kc + (size_t)idx * 16); *(LAS v4u*)(lds + AT_CK + (idx >> 3) * 144 + (idx & 7) * 16) = kv_;
                const v4u vv_ = *(const v4u*)(vc + (size_t)idx * 16); *(LAS v4u*)(lds + AT_CV + (idx >> 5) * 528 + (idx & 31) * 16) = vv_; }
        }
        bf16x8 qf[4];
        { const bf16* qp = QN + ((size_t)(b * 8 + head) * SEQ + tpos) * 64 + 8 * h2;
#pragma unroll
          for (int ks = 0; ks < 4; ++ks) qf[ks] = *(const bf16x8*)(qp + 16 * ks); }
        __syncthreads();
        f32x16 ofin[2];
        const int KT = ((4 * i + 2) >> 6) + 1;
        float g_c, g_s, g_w;
        { const float* gp = gates + mrow * 24 + head * 3; g_c = gp[0]; g_s = gp[1]; g_w = gp[2]; }
#if PROBE_CMP
        for (int rep = 0; rep < 2; ++rep)
#endif
        {
            float m = NEG_BIG, l = 0.f; f32x16 o[2];
#pragma unroll
            for (int dt = 0; dt < 2; ++dt)
#pragma unroll
                for (int e = 0; e < 16; ++e) o[dt][e] = 0.f;
            const float cs = 16.0f * slope2;
            for (int kt = 0; kt < KT; ++kt) {
                const int rel = tpos - 31 - 1024 * kt;
                attn_tile<0, true>(lds + AT_CK + kt * 64 * 144, lds + AT_CV, 528, kt * 128, qf, r, h2, cs, -slope2 * (float)(rel - 64 * h2), -100000, (rel >> 4) - 4 * h2, m, l, o, 0.f, nullptr);
            }
            const float lt = l + __shfl_xor(l, 32);
            const float inv_l = lt > 0.f ? 1.0f / lt : 0.f;
            LAS float* psrow = PS + (8 * wave + tl) * PS_PITCH;
            for (int kt = 0; kt < KT; ++kt) {
                const int rel = tpos - 31 - 1024 * kt;
                attn_tile<1, true>(lds + AT_CK + kt * 64 * 144, lds + AT_CV, 528, kt * 128, qf, r, h2, cs, -slope2 * (float)(rel - 64 * h2), -100000, (rel >> 4) - 4 * h2, m, l, o, inv_l, psrow + 64 * kt);
            }
#pragma unroll
            for (int dt = 0; dt < 2; ++dt)
#pragma unroll
                for (int e = 0; e < 16; ++e) ofin[dt][e] = g_c * o[dt][e];
        }
        LDS_WAIT(); asm volatile("" ::: "memory");
        unsigned long long mymask = 0ull, wunion = 0ull;
#if PROBE_TOPK
        for (int rep = 0; rep < 2; ++rep)
#endif
        {
            const int nmax = (4 * i + 3) < 254 ? (4 * i + 3) : 254;
            const unsigned long long validbits = (i >= 63) ? ~0ull : ((1ull << (i + 1)) - 1ull);
            const bool forced = (lane == 0) || (lane == i) || (lane == i - 1);
            LAS unsigned* KEYS = (LAS unsigned*)(lds + AT_KEYS) + wave * 128;
            if (i < 16) { mymask = validbits; wunion = validbits; }
            else
#pragma unroll 1
            for (int t8 = 0; t8 < 8; t8 += 2) {
                const LAS float* psa = PS + (8 * wave + t8) * PS_PITCH; const LAS float* psb = psa + PS_PITCH;
                float impa = 0.f, impb = 0.f;
#pragma unroll
                for (int dn = -1; dn <= 3; ++dn) { const int n = 4 * lane + dn; if (n >= 0 && n <= nmax) { impa += psa[n]; impb += psb[n]; } }
                unsigned keya = (lane <= i) ? (((__builtin_bit_cast(unsigned, impa) & ~63u) + 64u) | (unsigned)(63 - lane)) : (unsigned)(63 - lane);
                unsigned keyb = (lane <= i) ? (((__builtin_bit_cast(unsigned, impb) & ~63u) + 64u) | (unsigned)(63 - lane)) : (unsigned)(63 - lane);
                keya = forced ? (0xFFFFFFC0u | (unsigned)(63 - lane)) : keya; keyb = forced ? (0xFFFFFFC0u | (unsigned)(63 - lane)) : keyb;
                KEYS[lane] = keya; KEYS[64 + lane] = keyb;
                LDS_WAIT(); asm volatile("" ::: "memory");
                int cnta = 0, cntb = 0;
#pragma unroll
                for (int k4 = 0; k4 < 16; ++k4) { const v4u ka = *(const LAS v4u*)(KEYS + 4 * k4), kb = *(const LAS v4u*)(KEYS + 64 + 4 * k4);
                    cnta += (ka.x > keya) ? 1 : 0; cnta += (ka.y > keya) ? 1 : 0; cnta += (ka.z > keya) ? 1 : 0; cnta += (ka.w > keya) ? 1 : 0;
                    cntb += (kb.x > keyb) ? 1 : 0; cntb += (kb.y > keyb) ? 1 : 0; cntb += (kb.z > keyb) ? 1 : 0; cntb += (kb.w > keyb) ? 1 : 0; }
                LDS_WAIT(); asm volatile("" ::: "memory");
                const unsigned long long mska = __ballot(cnta < 16) & validbits, mskb = __ballot(cntb < 16) & validbits;
                wunion |= mska | mskb;
                if (tl == t8) mymask = mska;
                if (tl == t8 + 1) mymask = mskb;
            }
            if (lane == 0) WU[wave] = wunion;
        }
        __syncthreads();
        unsigned long long uni = 0ull;
#pragma unroll
        for (int w = 0; w < 8; ++w) uni |= WU[w];
        {
            const unsigned lo = __builtin_amdgcn_readfirstlane((unsigned)uni), hi = __builtin_amdgcn_readfirstlane((unsigned)(uni >> 32));
            uni = ((unsigned long long)hi << 32) | lo;
        }
        LAS float* OF = (LAS float*)(lds + AT_OF) + tid;
#pragma unroll
        for (int dt = 0; dt < 2; ++dt)
#pragma unroll
            for (int e = 0; e < 16; ++e) OF[(dt * 16 + e) * 512] = ofin[dt][e];
        {
            float l = 0.f; f32x16 o[2];
#pragma unroll
            for (int dt = 0; dt < 2; ++dt)
#pragma unroll
                for (int e = 0; e < 16; ++e) o[dt][e] = 0.f;
            attn_blocks<2>(lds, uni, wunion, i, (const bf16*)(ws + WS_KSN) + (size_t)bg * SEQ * 64, (const bf16*)(ws + WS_PROJ) + ((size_t)(b * NSEG + 14 + g) * SEQ) * 64, qf, r, h2, slope2, smax_s, tpos, mymask, l, o);
            const float lt = l + __shfl_xor(l, 32);
            const float sc = lt > 0.f ? g_s / lt : 0.f;
#pragma unroll
            for (int dt = 0; dt < 2; ++dt)
#pragma unroll
                for (int e = 0; e < 16; ++e) OF[(dt * 16 + e) * 512] += sc * o[dt][e];
        }
        {
            float l = 0.f; f32x16 o[2];
#pragma unroll
            for (int dt = 0; dt < 2; ++dt)
#pragma unroll
                for (int e = 0; e < 16; ++e) o[dt][e] = 0.f;
            const int jlo = i - 8 < 0 ? 0 : i - 8;
            const unsigned long long upto = (i >= 63) ? ~0ull : ((1ull << (i + 1)) - 1ull);
            const unsigned long long wb = upto & ~((1ull << jlo) - 1ull);
            attn_blocks<3>(lds, wb, ~0ull, i, (const bf16*)(ws + WS_KWN) + (size_t)bg * SEQ * 64, (const bf16*)(ws + WS_PROJ) + ((size_t)(b * NSEG + 18 + g) * SEQ) * 64, qf, r, h2, slope2, smax_w, tpos, ~0ull, l, o);
            const float lt = l + __shfl_xor(l, 32);
            const float sc = lt > 0.f ? g_w / lt : 0.f;
#pragma unroll
            for (int dt = 0; dt < 2; ++dt)
#pragma unroll
                for (int e = 0; e < 16; ++e) ofin[dt][e] = OF[(dt * 16 + e) * 512] + sc * o[dt][e];
        }
        {
            float ss = 0.f;
#pragma unroll
            for (int dt = 0; dt < 2; ++dt)
#pragma unroll
                for (int e = 0; e < 16; ++e) ss += ofin[dt][e] * ofin[dt][e];
            ss += __shfl_xor(ss, 32);
            const float rs = rsqrtf(ss * (1.0f / 64.0f) + EPS);
            const float* og = a.in[18] + head * 64;
            LAS unsigned char* ob = lds + AT_CK + (wave * 32 + r) * 144;
#pragma unroll
            for (int dt = 0; dt < 2; ++dt)
#pragma unroll
                for (int i4 = 0; i4 < 4; ++i4) { const int d0 = 32 * dt + 8 * i4 + 4 * h2; const f32x4 gv = *(const f32x4*)(og + d0);
                    v2u w; w.x = pk2(ofin[dt][4 * i4 + 0] * rs * gv[0], ofin[dt][4 * i4 + 1] * rs * gv[1]); w.y = pk2(ofin[dt][4 * i4 + 2] * rs * gv[2], ofin[dt][4 * i4 + 3] * rs * gv[3]);
                    *(LAS v2u*)(ob + d0 * 2) = w; }
            __syncthreads();
#pragma unroll
            for (int q = 0; q < 4; ++q) { const int idx = q * 512 + tid, row = idx >> 3, chunk = idx & 7;
                const v4u v = *(const LAS v4u*)(lds + AT_CK + row * 144 + chunk * 16);
                *(v4u*)(mixed + ((size_t)b * SEQ + T0 + (row >> 2)) * DM + (4 * g + (row & 3)) * 64 + chunk * 8) = v; }
            __syncthreads();
        }
    }
}

__device__ __forceinline__ void phase8b(const Args& a) {
    unsigned char* ws = a.ws;
    const float* gtail = (const float*)(ws + WS_GTAIL); const float* ghead = (const float*)(ws + WS_GHEAD); const float* uhead = (const float*)(ws + WS_UHEAD);
    const float* cw = a.in[24]; bf16* H = (bf16*)(ws + WS_H);
    for (int e = blockIdx.x * NTHREADS + threadIdx.x; e < 128 * DFF; e += gridDim.x * NTHREADS) {
        const int pm = e / DFF, ch = e % DFF;
        float t0 = 0.f, t1 = 0.f;
        if (pm & 15) { t0 = gtail[((size_t)(pm - 1) * 2 + 0) * DFF + ch]; t1 = gtail[((size_t)(pm - 1) * 2 + 1) * DFF + ch]; }
        const float g0 = ghead[((size_t)pm * 2 + 0) * DFF + ch], g1 = ghead[((size_t)pm * 2 + 1) * DFF + ch];
        const float u0 = uhead[((size_t)pm * 2 + 0) * DFF + ch], u1 = uhead[((size_t)pm * 2 + 1) * DFF + ch];
        const float w0 = cw[ch], w1 = cw[DFF + ch], w2 = cw[2 * DFF + ch];
        H[((size_t)pm * 256 + 0) * DFF + ch] = (bf16)f2bf(silu_f(w0 * t0 + w1 * t1 + w2 * g0) * u0);
        H[((size_t)pm * 256 + 1) * DFF + ch] = (bf16)f2bf(silu_f(w0 * t1 + w1 * g0 + w2 * g1) * u1);
    }
}

__global__ void __launch_bounds__(NTHREADS) nsa_layer_fwd(Args a) {
    extern __shared__ __attribute__((aligned(16))) unsigned char smem[];
    LAS unsigned char* lds = (LAS unsigned char*)smem;
    cg::grid_group grid = cg::this_grid();
    unsigned char* ws = a.ws;
    const int G = gridDim.x, c = blockIdx.x;
    const float* mod = (const float*)(ws + WS_MOD);

    if (threadIdx.x < 2) ((volatile LAS unsigned*)(lds + XB_LDS_OFF))[threadIdx.x] = 0u;
    __syncthreads();
    const XcdBarrier xbar = xcd_barrier_post((unsigned*)(ws + WS_BAR), (volatile LAS unsigned*)(lds + XB_LDS_OFF));
    if (a.ws == nullptr) grid.sync();
    phase0(a, lds);
    xcd_barrier(xbar);
    norm_rows(a.in[0], a.in[4], mod, 0, 1024, (bf16*)(ws + WS_XN));
    weight_copies(a, lds);
    xcd_barrier(xbar);
    {
        pg8::Gemm g{(const bf16*)(ws + WS_XN), (const bf16*)(ws + WS_BT_IN), MTOK, NINP, 1024, 1024};
        pg8::StaticOrder S; S.init(MTOK, NINP, G, c);
        EpiProj E{(bf16*)(ws + WS_PROJ), (bf16*)(ws + WS_QN), (bf16*)(ws + WS_KSN), (bf16*)(ws + WS_KWN), (float*)(ws + WS_GATES), a.in[7], a.in[9], a.in[10], a.in[6]};
        pg8::gemm_phase<EpiProj, pg8::StaticOrder, true, true>(lds, g, S, E);
    }
    xcd_barrier(xbar);
    if (c < 32) {
        pg8::Gemm g{(const bf16*)(ws + WS_PROJ), (const bf16*)(ws + WS_BT_C1), 4096, 256, 2048, 1024};
        CmpOrder S{c, (const bf16*)(ws + WS_PROJ), (const bf16*)(ws + WS_BT_C1)};
        EpiCmp E{(float*)(ws + WS_HID), (const float*)(ws + WS_BIAS1)};
        pg8::gemm_phase<EpiCmp, CmpOrder, true, true>(lds, g, S, E);
    } else {
        phase3_prep(a, lds, (c - 32) * NWAVES + (int)(threadIdx.x >> 6), (G - 32) * NWAVES);
    }
    xcd_barrier(xbar);
    phase4(a, lds);
    xcd_barrier(xbar);
    phase5(a, lds);
    xcd_barrier(xbar);
    {
        pg8::Gemm g{(const bf16*)(ws + WS_MIXED), (const bf16*)(ws + WS_BT_OUT), MTOK, 1024, 1024, 1024};
        pg8::StaticOrder S; S.init(MTOK, 1024, G, c);
        EpiResB E{a.in[0], (bf16*)(ws + WS_X1B), mod, 2048};
        pg8::gemm_phase<EpiResB, pg8::StaticOrder, true, true>(lds, g, S, E);
    }
    xcd_barrier(xbar);
    norm_rows_b((const bf16*)(ws + WS_X1B), a.in[21], mod, 3072, 4096, (bf16*)(ws + WS_XN));
    xcd_barrier(xbar);
    {
        pg8::Gemm g{(const bf16*)(ws + WS_XN), (const bf16*)(ws + WS_BT_GU), MTOK, NGU, 1024, 1024};
        pg8::StaticOrder S; S.init(MTOK, NGU, G, c);
        EpiFfn E{(bf16*)(ws + WS_H), a.in[24], (float*)(ws + WS_GTAIL), (float*)(ws + WS_GHEAD), (float*)(ws + WS_UHEAD), (LAS float*)(lds + HB_OFF)};
        pg8::gemm_phase<EpiFfn, pg8::StaticOrder, true, true>(lds, g, S, E);
    }
    xcd_barrier(xbar);
    phase8b(a);
    xcd_barrier(xbar);
    {
        pg8::Gemm g{(const bf16*)(ws + WS_H), (const bf16*)(ws + WS_BT_DN), MTOK, 1024, DFF, DFF};
        pg8::StaticOrder S; S.init(MTOK, 1024, G, c);
        EpiResF E{(const bf16*)(ws + WS_X1B), a.out, mod, 5120};
        pg8::gemm_phase<EpiResF, pg8::StaticOrder, true, true>(lds, g, S, E);
    }
}

extern "C" void kernel_launch(void* const* d_in, const int* in_sizes, int n_in, void* d_out, int out_size, void* d_ws, size_t ws_size, hipStream_t stream) {
    static int grid = 0;
    if (grid == 0) {
        if (n_in != 26 || out_size != MTOK * DM || ws_size < WS_END) { fprintf(stderr, "kernel_launch: unexpected problem (n_in %d, out %d, ws %zu)\n", n_in, out_size, ws_size); grid = -1; return; }
        int dev = 0, cus = 0, per_cu = 0;
        (void)hipGetDevice(&dev);
        (void)hipDeviceGetAttribute(&cus, hipDeviceAttributeMultiprocessorCount, dev);
        if (hipFuncSetAttribute((const void*)nsa_layer_fwd, hipFuncAttributeMaxDynamicSharedMemorySize, LDS_BYTES) != hipSuccess) { fprintf(stderr, "kernel_launch: hipFuncSetAttribute failed\n"); grid = -1; return; }
        if (hipOccupancyMaxActiveBlocksPerMultiprocessor(&per_cu, (const void*)nsa_layer_fwd, NTHREADS, LDS_BYTES) != hipSuccess || per_cu < 1) { fprintf(stderr, "kernel_launch: occupancy query says %d\n", per_cu); per_cu = 1; }
        (void)hipGetLastError();
        grid = cus * per_cu;
        if (grid > 1024) grid = 1024;
    }
    if (grid < 0) return;
    if (hipMemsetAsync((char*)d_ws + WS_BAR, 0, BAR_BYTES, stream) != hipSuccess) { fprintf(stderr, "kernel_launch: memset of the barrier words failed\n"); return; }
    Args a{};
    for (int i = 0; i < 26; ++i) a.in[i] = (const float*)d_in[i];
    a.out = (float*)d_out; a.ws = (unsigned char*)d_ws;
    void* args[] = {&a};
    hipError_t e = hipLaunchCooperativeKernel((const void*)nsa_layer_fwd, dim3(grid), dim3(NTHREADS), args, LDS_BYTES, stream);
    if (e != hipSuccess) fprintf(stderr, "cooperative launch failed: %s (grid %d)\n", hipGetErrorString(e), grid);
}
```

```cpp
#include <hip/hip_runtime.h>
#include <hip/hip_cooperative_groups.h>
#include <cstdio>
#include <cstdint>
namespace cg = cooperative_groups;

namespace pg8 {
#define PG8_LAS __attribute__((address_space(3)))
typedef unsigned short bf16_t;
typedef short bf16x8 __attribute__((ext_vector_type(8)));
typedef float f32x4 __attribute__((ext_vector_type(4)));
typedef unsigned u32x4 __attribute__((ext_vector_type(4)));
constexpr int BM = 256, BK = 64, HALF = 128, HTB = HALF * BK * 2, STAGE_BYTES = 8 * HTB, NXCD = 8, WGM = 4;

__host__ __device__ __forceinline__ int lds_byte(int r, int c) { const int st = (r >> 4) * 2 + (c >> 5), rr = r & 15, cc = c & 31, ob = rr * 64 + cc * 2; return st * 1024 + (ob ^ (((ob >> 9) & 1) << 5)); }
__host__ __device__ __forceinline__ void stage_rc(int b, int& R, int& C) { const int st = b / 1024, sb = b % 1024, swz = sb ^ (((sb >> 9) & 1) << 5); R = (st >> 1) * 16 + swz / 64; C = (st & 1) * 32 + (swz % 64) / 2; }
__host__ __device__ __forceinline__ int perm32(int rho) { const int n = rho >> 4, i = rho & 15; return 8 * (i >> 2) + 4 * n + (i & 3); }

struct Unit { int pm, pn; };
struct Gemm { const bf16_t* A; const bf16_t* Bt; int M, N, K, lda; };

struct StaticOrder {
    int nM, nN, nwg, G, c, wgm;
    __device__ void init(int M, int N, int G_, int c_, int wgm_ = WGM) { nM = M / BM; nN = N / BM; nwg = nM * nN; G = G_; c = c_; wgm = wgm_; }
    __device__ bool next(int i, Unit& u) const {
        const long L = (long)i * G + c; if (L >= nwg) return false;
        int wgid = (int)L; { const int q = nwg / NXCD, r = nwg % NXCD, xcd = wgid % NXCD, off = wgid / NXCD; wgid = (xcd < r ? xcd * (q + 1) : r * (q + 1) + (xcd - r) * q) + off; }
        const int nig = wgm * nN, gid = wgid / nig, fm = gid * wgm, gsz = (nM - fm) < wgm ? (nM - fm) : wgm;
        u.pm = fm + ((wgid % nig) % gsz); u.pn = (wgid % nig) / gsz; return true;
    }
    __device__ __forceinline__ const char* a_ptr(const Gemm& g, const Unit& u) const { return (const char*)g.A + (size_t)u.pm * (size_t)(BM * 2) * (size_t)g.lda; }
    __device__ __forceinline__ const char* b_ptr(const Gemm& g, const Unit& u) const { return (const char*)g.Bt + (size_t)u.pn * (size_t)(BM * 2) * (size_t)g.K; }
    __device__ __forceinline__ void a_ready(const Unit&) const {}
    __device__ __forceinline__ void done(const Unit&) const {}
};

template <class Epi, class Sched, bool ALIGN_EPI = false, bool SP2 = false>
__device__ __forceinline__ void gemm_phase(PG8_LAS unsigned char* lds, const Gemm g, const Sched& S, const Epi& E) {
    int tid_ = threadIdx.x; asm volatile("" : "+v"(tid_));
    const int tid = tid_, wid = __builtin_amdgcn_readfirstlane(tid >> 6), lane = tid & 63, wr = wid >> 2, wc = wid & 3, fr = lane & 15, fq = lane >> 4;
    const int K = g.K, nt = K / BK;
    unsigned voffA[2], voffB[2];
#pragma unroll
    for (int i = 0; i < 2; ++i) { int R, C; stage_rc(tid * 16 + i * 8192, R, C); const int Rb = Epi::PERM2 ? (64 * (R >> 5) + perm32(R & 31)) : (Epi::PERM ? ((R & ~31) + perm32(R & 31)) : R);
        voffA[i] = (unsigned)(R * g.lda + C) * 2u; voffB[i] = (unsigned)(Rb * K + C) * 2u; }
    const size_t kstep = (size_t)(BK * 2);
    const size_t hsA = (size_t)HALF * g.lda * 2, hsB = (size_t)(Epi::PERM2 ? 32 : HALF) * K * 2;
    const unsigned ldsw = (unsigned)wid * 1024u;
    const int aoff = lds_byte(wr * 64 + fr, fq * 8), boff = lds_byte(wc * 32 + fr, fq * 8);
#define PG8_SA(b, h) (((b) * 2 + (h)) * HTB)
#define PG8_SB(b, h) ((4 + (b) * 2 + (h)) * HTB)
#define PG8_STAGE(bufoff, gbase, voff) do { _Pragma("unroll") for (int _i = 0; _i < 2; ++_i) \
        __builtin_amdgcn_global_load_lds((const unsigned*)((const char*)(gbase) + (voff)[_i]), (PG8_LAS unsigned*)(lds + (bufoff) + ldsw + _i * 8192), 16, 0, 0); } while (0)
#define PG8_LDA(dst, b, h) do { _Pragma("unroll") for (int m = 0; m < 4; ++m) _Pragma("unroll") for (int k = 0; k < 2; ++k) dst[m][k] = *(const PG8_LAS bf16x8*)(lds + PG8_SA(b, h) + aoff + m * 2048 + k * 1024); } while (0)
#define PG8_LDB(dst, b, h) do { _Pragma("unroll") for (int n = 0; n < 2; ++n) _Pragma("unroll") for (int k = 0; k < 2; ++k) dst[n][k] = *(const PG8_LAS bf16x8*)(lds + PG8_SB(b, h) + boff + n * 2048 + k * 1024); } while (0)
#define PG8_MMA(ai, bj, At, Bt) do { __builtin_amdgcn_s_setprio(1); _Pragma("unroll") for (int m = 0; m < 4; ++m) _Pragma("unroll") for (int n = 0; n < 2; ++n) _Pragma("unroll") for (int k = 0; k < 2; ++k) \
        acc[ai][bj][m][n] = __builtin_amdgcn_mfma_f32_16x16x32_bf16(Bt[n][k], At[m][k], acc[ai][bj][m][n], 0, 0, 0); __builtin_amdgcn_s_setprio(0); } while (0)
#define PG8_WAIT_V(n) asm volatile("s_waitcnt vmcnt(" #n ")" ::: "memory")
#define PG8_WAIT_L(n) asm volatile("s_waitcnt lgkmcnt(" #n ")" ::: "memory")
#define PG8_BAR __builtin_amdgcn_s_barrier()
#define PG8_SCHED __builtin_amdgcn_sched_barrier(0)
    Unit cur, nxt; int ui = 0;
    if (!S.next(0, cur)) return;
    f32x4 acc[2][2][4][2];
#pragma unroll
    for (int a = 0; a < 2; ++a)
#pragma unroll
        for (int b = 0; b < 2; ++b)
#pragma unroll
            for (int m = 0; m < 4; ++m)
#pragma unroll
                for (int n = 0; n < 2; ++n) acc[a][b][m][n] = (f32x4){0.f, 0.f, 0.f, 0.f};
    bf16x8 At[4][2], B0[2][2], B1[2][2];
    const char* cA = S.a_ptr(g, cur); const char* cB = S.b_ptr(g, cur);
    S.a_ready(cur);
    if constexpr (SP2) {
        PG8_STAGE(PG8_SB(0, 0), cB, voffB); PG8_STAGE(PG8_SB(0, 1), cB + hsB, voffB); PG8_STAGE(PG8_SA(0, 0), cA, voffA); PG8_STAGE(PG8_SA(0, 1), cA + hsA, voffA);
        if (wr == 1) PG8_BAR;
        PG8_WAIT_V(2); PG8_BAR;
        PG8_STAGE(PG8_SB(1, 0), cB + kstep, voffB); PG8_STAGE(PG8_SA(1, 0), cA + kstep, voffA); PG8_STAGE(PG8_SB(1, 1), cB + hsB + kstep, voffB);
        PG8_WAIT_V(6); PG8_BAR;
    } else {
        PG8_STAGE(PG8_SB(0, 0), cB, voffB); PG8_STAGE(PG8_SA(0, 0), cA, voffA); PG8_STAGE(PG8_SB(0, 1), cB + hsB, voffB); PG8_STAGE(PG8_SA(0, 1), cA + hsA, voffA);
        if (wr == 1) PG8_BAR;
        PG8_WAIT_V(4); PG8_BAR;
        PG8_STAGE(PG8_SB(1, 0), cB + kstep, voffB); PG8_STAGE(PG8_SA(1, 0), cA + kstep, voffA); PG8_STAGE(PG8_SB(1, 1), cB + hsB + kstep, voffB);
        PG8_WAIT_V(6); PG8_BAR;
    }
    for (;;) {
        const bool has_next = S.next(ui + 1, nxt);
        const char* nA = has_next ? S.a_ptr(g, nxt) : cA; const char* nB = has_next ? S.b_ptr(g, nxt) : cB;
        for (int t = 0; t < nt; t += 2) {
            const bool last = (t == nt - 2);
            const char* a1 = cA + (size_t)(t + 1) * kstep;
            const char* a2 = last ? nA : cA + (size_t)(t + 2) * kstep; const char* b2 = last ? nB : cB + (size_t)(t + 2) * kstep;
            const char* a3 = a2 + kstep; const char* b3 = b2 + kstep;
            if (last && has_next) S.a_ready(nxt);
            if constexpr (SP2) {
            PG8_LDB(B0, 0, 0); PG8_LDB(B1, 0, 1); PG8_SCHED; PG8_LDA(At, 0, 0); PG8_STAGE(PG8_SA(1, 1), a1 + hsA, voffA);
            PG8_WAIT_V(8); PG8_WAIT_L(0); PG8_BAR; PG8_MMA(0, 0, At, B0); PG8_MMA(0, 1, At, B1); PG8_BAR; PG8_SCHED;
            PG8_LDA(At, 0, 1); PG8_STAGE(PG8_SB(0, 0), b2, voffB); PG8_STAGE(PG8_SB(0, 1), b2 + hsB, voffB); PG8_STAGE(PG8_SA(0, 0), a2, voffA);
            PG8_WAIT_V(8); PG8_WAIT_L(0); PG8_BAR; PG8_MMA(1, 0, At, B0); PG8_MMA(1, 1, At, B1); PG8_BAR; PG8_SCHED;
            PG8_LDB(B0, 1, 0); PG8_LDB(B1, 1, 1); PG8_SCHED; PG8_LDA(At, 1, 0); PG8_STAGE(PG8_SA(0, 1), a2 + hsA, voffA);
            PG8_WAIT_V(8); PG8_WAIT_L(0); PG8_BAR; PG8_MMA(0, 0, At, B0); PG8_MMA(0, 1, At, B1); PG8_BAR; PG8_SCHED;
            PG8_LDA(At, 1, 1); PG8_STAGE(PG8_SB(1, 0), b3, voffB); PG8_STAGE(PG8_SB(1, 1), b3 + hsB, voffB); PG8_STAGE(PG8_SA(1, 0), a3, voffA);
            PG8_WAIT_V(8); PG8_WAIT_L(0); PG8_BAR; PG8_MMA(1, 0, At, B0); PG8_MMA(1, 1, At, B1); PG8_BAR; PG8_SCHED;
            } else {
            PG8_LDB(B0, 0, 0); PG8_SCHED; PG8_LDA(At, 0, 0); PG8_STAGE(PG8_SA(1, 1), a1 + hsA, voffA);
            PG8_WAIT_L(8); PG8_BAR; PG8_WAIT_L(0); PG8_MMA(0, 0, At, B0); PG8_BAR; PG8_SCHED;
            PG8_LDB(B1, 0, 1); PG8_STAGE(PG8_SB(0, 0), b2, voffB);
            PG8_BAR; PG8_WAIT_L(0); PG8_MMA(0, 1, At, B1); PG8_BAR;
            PG8_LDA(At, 0, 1); PG8_STAGE(PG8_SA(0, 0), a2, voffA);
            PG8_BAR; PG8_WAIT_L(0); PG8_MMA(1, 0, At, B0); PG8_BAR; PG8_SCHED;
            PG8_STAGE(PG8_SB(0, 1), b2 + hsB, voffB);
            PG8_WAIT_V(6); PG8_BAR; PG8_MMA(1, 1, At, B1); PG8_BAR;
            PG8_LDB(B0, 1, 0); PG8_SCHED; PG8_LDA(At, 1, 0); PG8_STAGE(PG8_SA(0, 1), a2 + hsA, voffA);
            PG8_WAIT_L(8); PG8_BAR; PG8_WAIT_L(0); PG8_MMA(0, 0, At, B0); PG8_BAR; PG8_SCHED;
            PG8_LDB(B1, 1, 1); PG8_STAGE(PG8_SB(1, 0), b3, voffB);
            PG8_BAR; PG8_WAIT_L(0); PG8_MMA(0, 1, At, B1); PG8_BAR;
            PG8_LDA(At, 1, 1); PG8_STAGE(PG8_SA(1, 0), a3, voffA);
            PG8_BAR; PG8_WAIT_L(0); PG8_MMA(1, 0, At, B0); PG8_BAR; PG8_SCHED;
            PG8_STAGE(PG8_SB(1, 1), b3 + hsB, voffB);
            PG8_WAIT_V(6); PG8_BAR; PG8_MMA(1, 1, At, B1); PG8_BAR;
            }
        }
        if constexpr (ALIGN_EPI) { if (wr == 0) PG8_BAR; }
        if constexpr (!Epi::AFTER_DRAIN) { E(acc, cur, wr, wc, fr, fq); S.done(cur); }
        if (!has_next) break;
#pragma unroll
        for (int a = 0; a < 2; ++a)
#pragma unroll
            for (int b = 0; b < 2; ++b)
#pragma unroll
                for (int m = 0; m < 4; ++m)
#pragma unroll
                    for (int n = 0; n < 2; ++n) acc[a][b][m][n] = (f32x4){0.f, 0.f, 0.f, 0.f};
        cur = nxt; cA = nA; cB = nB; ++ui;
        if constexpr (ALIGN_EPI) { if (wr == 1) PG8_BAR; }
    }
    PG8_WAIT_V(0);
    if constexpr (!ALIGN_EPI) { if (wr == 0) PG8_BAR; }
    PG8_BAR;
    if constexpr (Epi::AFTER_DRAIN) { E.fused(acc, cur, wr, wc, fr, fq, lds, wid, lane); S.done(cur); }
#undef PG8_SA
#undef PG8_SB
#undef PG8_STAGE
#undef PG8_LDA
#undef PG8_LDB
#undef PG8_MMA
#undef PG8_WAIT_V
#undef PG8_WAIT_L
#undef PG8_BAR
#undef PG8_SCHED
}
}


#define LAS __attribute__((address_space(3)))
typedef unsigned short bf16;
typedef unsigned v4u __attribute__((ext_vector_type(4)));
typedef unsigned v2u __attribute__((ext_vector_type(2)));
typedef float f32x4 __attribute__((ext_vector_type(4)));
typedef float f32x2 __attribute__((ext_vector_type(2)));
typedef float f32x16 __attribute__((ext_vector_type(16)));
typedef short bf16x8 __attribute__((ext_vector_type(8)));
typedef short s16x4 __attribute__((ext_vector_type(4)));
typedef __bf16 bf16x2_t __attribute__((ext_vector_type(2)));

constexpr int NB = 8, SEQ = 4096, DM = 1024, MTOK = NB * SEQ;
constexpr int NIN = 2840, NINP = 3072, NSEG = NINP / 64, DFF = 2816, NGU = 2 * DFF;
constexpr float EPS = 1e-6f;
constexpr float LOG2E = 1.4426950408889634f;
constexpr int NTHREADS = 512, NWAVES = 8;
constexpr int LDS_BYTES = 147456 + 256;
constexpr int XB_LDS_OFF = 147456;
constexpr int HB_OFF = 131072;

constexpr size_t MiB = 1u << 20;
constexpr size_t WS_MOD = 0, WS_BIAS1 = 256 * 1024, WS_BAR = 512 * 1024, BAR_BYTES = 16384;
constexpr size_t WS_BT_IN = 1 * MiB, WS_BT_OUT = 7 * MiB, WS_BT_GU = 9 * MiB, WS_BT_DN = 20 * MiB, WS_BT_C1 = 26 * MiB;
constexpr size_t WS_HID = 28 * MiB, WS_KCN = 36 * MiB, WS_VCT = 36 * MiB + 512 * 1024, WS_GATES = 37 * MiB;
constexpr size_t WS_GTAIL = 40 * MiB, WS_GHEAD = 43 * MiB, WS_UHEAD = 46 * MiB;
constexpr size_t WS_KSN = 50 * MiB, WS_KWN = 58 * MiB, WS_VST = 66 * MiB, WS_VWT = 74 * MiB, WS_QN = 82 * MiB;
constexpr size_t WS_X1B = 50 * MiB;
constexpr size_t WS_XN = 114 * MiB, WS_MIXED = 178 * MiB, WS_PROJ = 242 * MiB, WS_H = WS_PROJ, WS_END = 434 * MiB;

#ifndef WGM_P2
#define WGM_P2 4
#endif
#ifndef WGM_P8
#define WGM_P8 8
#endif
#ifndef WGM_P69
#define WGM_P69 4
#endif
struct Args { const float* in[26]; float* out; unsigned char* ws; };

#define LDS_WAIT() asm volatile("s_waitcnt lgkmcnt(0)" ::: "memory")
__device__ __forceinline__ unsigned f2bf(float f) { unsigned u = __builtin_bit_cast(unsigned, f); return (u + 0x7fffu + ((u >> 16) & 1u)) >> 16; }
__device__ __forceinline__ unsigned pk2(float lo, float hi) { f32x2 v = {lo, hi}; bf16x2_t b = __builtin_convertvector(v, bf16x2_t); return __builtin_bit_cast(unsigned, b); }
__device__ __forceinline__ float bf2f(unsigned short h) { return __builtin_bit_cast(float, (unsigned)h << 16); }
__device__ __forceinline__ float bflo(unsigned w) { return __builtin_bit_cast(float, w << 16); }
__device__ __forceinline__ float bfhi(unsigned w) { return __builtin_bit_cast(float, w & 0xffff0000u); }
__device__ __forceinline__ float wave_sum(float v) {
#pragma unroll
    for (int o = 1; o < 64; o <<= 1) v += __shfl_xor(v, o);
    return v;
}
__device__ __forceinline__ float silu_f(float x) { return x * __builtin_amdgcn_rcpf(1.0f + __builtin_amdgcn_exp2f(-LOG2E * x)); }
__device__ __forceinline__ float gelu_tanh_f(float x) { const float y = 0.7978845608028654f * (x + 0.044715f * x * x * x); const float t = 1.0f - 2.0f * __builtin_amdgcn_rcpf(__builtin_amdgcn_exp2f(2.0f * LOG2E * y) + 1.0f); return 0.5f * x * (1.0f + t); }

#define XB_TMO      128
#define XB_XCNT(j)  (256  + 64 * (j))
#define XB_XSUB(j)  (1280 + 64 * (j))
#define XB_XGEN(j)  (2304 + 64 * (j))
#define XB_TOP      3328
#define XB_TOPGEN   3392
#define XCD_BAR_WORDS 3456
#define XB_SPIN_CAP (1u << 18)

__device__ __forceinline__ unsigned xb_ld(unsigned* p)              { return __hip_atomic_load(p, __ATOMIC_RELAXED, __HIP_MEMORY_SCOPE_AGENT); }
__device__ __forceinline__ unsigned xb_add(unsigned* p, unsigned v) { return __hip_atomic_fetch_add(p, v, __ATOMIC_RELAXED, __HIP_MEMORY_SCOPE_AGENT); }
__device__ __forceinline__ unsigned xb_xcc_id() { return (unsigned)__builtin_amdgcn_s_getreg((3 << 11) | 20) & 0xFu; }
#define XB_SPIN(cond, bar) do { unsigned _sp = 0; while (cond) { __builtin_amdgcn_s_sleep(1); \
    if ((++_sp & 255u) == 0u) { if (xb_ld(&(bar)[XB_TMO])) break; if (_sp > XB_SPIN_CAP) { atomicAdd(&(bar)[XB_TMO], 1u); break; } } } } while (0)

struct XcdBarrier {
    unsigned* bar; unsigned x;
    volatile LAS unsigned* st;
};

__device__ __forceinline__ XcdBarrier xcd_barrier_post(unsigned* bar, volatile LAS unsigned* st) {
    XcdBarrier b; b.bar = bar; b.x = xb_xcc_id(); b.st = st;
    if (threadIdx.x == 0) (void)xb_add(&bar[XB_XCNT(b.x)], 1u);
    return b;
}
__device__ __forceinline__ void xcd_barrier_complete(unsigned* bar, unsigned x, unsigned& nloc, unsigned& nx) {
    const unsigned G = gridDim.x * gridDim.y * gridDim.z;
    unsigned sum, cnt, mine, sp = 0u;
    for (;;) {
        sum = 0u; cnt = 0u; mine = 0u;
#pragma unroll
        for (unsigned j = 0; j < 16; ++j) { const unsigned c = xb_ld(&bar[XB_XCNT(j)]); sum += c; cnt += (c > 0u) ? 1u : 0u; mine = (j == x) ? c : mine; }
        if (sum == G) break;
        __builtin_amdgcn_s_sleep(1);
        if ((++sp & 255u) == 0u) { if (xb_ld(&bar[XB_TMO])) break; if (sp > XB_SPIN_CAP) { atomicAdd(&bar[XB_TMO], 1u); break; } }
    }
    nloc = mine > 0u ? mine : 1u; nx = cnt > 0u ? cnt : 1u;
}

__device__ __forceinline__ void xcd_barrier(const XcdBarrier& b) {
    asm volatile("s_waitcnt vmcnt(0)" ::: "memory");
    __syncthreads();
    if (threadIdx.x == 0) {
        unsigned* bar = b.bar;
        __builtin_amdgcn_s_waitcnt(0);
        unsigned nloc = b.st[0], nx = b.st[1];
        if (nloc == 0u) { xcd_barrier_complete(bar, b.x, nloc, nx); b.st[0] = nloc; b.st[1] = nx; }
        const unsigned old = xb_add(&bar[XB_XSUB(b.x)], 1u);
        const unsigned gen = old / nloc;
        if (old + 1u == (gen + 1u) * nloc) {
            __builtin_amdgcn_fence(__ATOMIC_RELEASE, "agent");
            asm volatile("s_waitcnt vmcnt(0)" ::: "memory");
            const unsigned og = xb_add(&bar[XB_TOP], 1u);
            const unsigned tg = og / nx;
            if (og + 1u == (tg + 1u) * nx) xb_add(&bar[XB_TOPGEN], 1u);
            else XB_SPIN(xb_ld(&bar[XB_TOPGEN]) == tg, bar);
            __builtin_amdgcn_fence(__ATOMIC_ACQUIRE, "agent");
            xb_add(&bar[XB_XGEN(b.x)], 1u);
            asm volatile("s_waitcnt vmcnt(0)" ::: "memory");
        } else {
            XB_SPIN(xb_ld(&bar[XB_XGEN(b.x)]) == gen, bar);
            __builtin_amdgcn_fence(__ATOMIC_ACQUIRE, "agent");
            asm volatile("s_waitcnt vmcnt(0)" ::: "memory");
        }
    }
    __syncthreads();
}


__device__ __forceinline__ void transpose_item(const float* __restrict__ W, int K, int N, bf16* WT, int k0, int n0, int drow0, LAS float* scr, int lane) {
    const int nn = n0 + (lane & 31);
#pragma unroll 8
    for (int i = 0; i < 32; ++i) { const int kk = 2 * i + (lane >> 5); scr[kk * 33 + (lane & 31)] = (nn < N) ? W[(size_t)(k0 + kk) * N + nn] : 0.0f; }
    LDS_WAIT(); asm volatile("" ::: "memory");
    const int c = lane & 7;
#pragma unroll
    for (int j = 0; j < 4; ++j) { const int n = (lane >> 3) + 8 * j; const LAS float* s = scr + (8 * c) * 33 + n;
        v4u o; o.x = pk2(s[0 * 33], s[1 * 33]); o.y = pk2(s[2 * 33], s[3 * 33]); o.z = pk2(s[4 * 33], s[5 * 33]); o.w = pk2(s[6 * 33], s[7 * 33]);
        *(v4u*)(WT + (size_t)(drow0 + n) * K + k0 + 8 * c) = o; }
    LDS_WAIT(); asm volatile("" ::: "memory");
}

__device__ __forceinline__ void phase0(const Args& a, LAS unsigned char* lds) {
    int tid_ = threadIdx.x; asm volatile("" : "+v"(tid_)); const int tid = tid_, lane = tid & 63, wave = tid >> 6, G = gridDim.x;
    unsigned char* ws = a.ws;
    LAS float* SC = (LAS float*)lds;
    LAS float* RED = (LAS float*)(lds + 32768);
    float* mod = (float*)(ws + WS_MOD);
    float* bias1 = (float*)(ws + WS_BIAS1);
    for (int it = blockIdx.x; it < 208; it += G) {
        const int cl = tid & 31, sl = tid >> 5;
        if (it < 192) {
            const float* c = a.in[1]; const float* w_ada = a.in[2]; const float* b_ada = a.in[3];
            for (int i = tid; i < 8192; i += NTHREADS) { const float v = c[i]; SC[i] = silu_f(v); }
            __syncthreads();
            float acc[8];
#pragma unroll
            for (int b = 0; b < 8; ++b) acc[b] = 0.f;
            const int col = it * 32 + cl;
#pragma unroll 8
            for (int k = sl * 64; k < sl * 64 + 64; ++k) {
                const float w = w_ada[(size_t)k * 6144 + col];
#pragma unroll
                for (int b = 0; b < 8; ++b) acc[b] += SC[b * 1024 + k] * w;
            }
#pragma unroll
            for (int b = 0; b < 8; ++b) RED[(sl * 8 + b) * 32 + cl] = acc[b];
            __syncthreads();
            if (tid < 256) { const int b = tid >> 5; float s = 0.f;
#pragma unroll
              for (int w = 0; w < 16; ++w) s += RED[(w * 8 + b) * 32 + cl];
              mod[b * 6144 + it * 32 + cl] = s + b_ada[it * 32 + cl]; }
            __syncthreads();
        } else {
            const int q = it - 192, kv = q >> 3, cgp = q & 7;
            const float* pos = a.in[11 + kv]; const float* w1 = a.in[13 + 2 * kv];
            float acc = 0.f;
#pragma unroll 8
            for (int k = sl * 128; k < sl * 128 + 128; ++k) acc += pos[k] * w1[(size_t)k * 256 + cgp * 32 + cl];
            RED[sl * 32 + cl] = acc;
            __syncthreads();
            if (tid < 32) { float s = 0.f;
#pragma unroll
                for (int w = 0; w < 16; ++w) s += RED[w * 32 + tid];
                bias1[kv * 256 + cgp * 32 + tid] = s; }
            __syncthreads();
        }
    }
}

__device__ __forceinline__ void weight_copies(const Args& a, LAS unsigned char* lds) {
    int tid_ = threadIdx.x; asm volatile("" : "+v"(tid_)); const int tid = tid_, lane = tid & 63, wave = tid >> 6, G = gridDim.x;
    unsigned char* ws = a.ws;
    LAS float* scr = (LAS float*)(lds + 49152 + wave * 8448);
    const int gw = blockIdx.x * NWAVES + wave, NGW = G * NWAVES;
    constexpr int I_IN = 16 * 96, I_OUT = 16 * 32, I_G = 16 * 88, I_D = 44 * 32, I_C = 32 * 8;
    constexpr int TOT = I_IN + I_OUT + 2 * I_G + I_D + 2 * I_C;
    for (int it = gw; it < TOT; it += NGW) {
        int r = it;
        if (r < I_IN) { const int kb = r / 96, nb = r % 96; transpose_item(a.in[5], 1024, NIN, (bf16*)(ws + WS_BT_IN), 64 * kb, 32 * nb, 32 * nb, scr, lane); continue; } r -= I_IN;
        if (r < I_OUT) { const int kb = r / 32, nb = r % 32; transpose_item(a.in[20], 1024, 1024, (bf16*)(ws + WS_BT_OUT), 64 * kb, 32 * nb, 32 * nb, scr, lane); continue; } r -= I_OUT;
        if (r < I_G) { const int kb = r / 88, nb = r % 88, n0 = 32 * nb; transpose_item(a.in[22], 1024, DFF, (bf16*)(ws + WS_BT_GU), 64 * kb, n0, 256 * (n0 >> 7) + (n0 & 127), scr, lane); continue; } r -= I_G;
        if (r < I_G) { const int kb = r / 88, nb = r % 88, n0 = 32 * nb; transpose_item(a.in[23], 1024, DFF, (bf16*)(ws + WS_BT_GU), 64 * kb, n0, 256 * (n0 >> 7) + (n0 & 127) + 128, scr, lane); continue; } r -= I_G;
        if (r < I_D) { const int kb = r / 32, nb = r % 32; transpose_item(a.in[25], DFF, 1024, (bf16*)(ws + WS_BT_DN), 64 * kb, 32 * nb, 32 * nb, scr, lane); continue; } r -= I_D;
        if (r < I_C) { const int kb = r / 8, nb = r % 8; transpose_item(a.in[13], 2048, 256, (bf16*)(ws + WS_BT_C1), 64 * kb, 32 * nb, 32 * nb, scr, lane); continue; } r -= I_C;
        { const int kb = r / 8, nb = r % 8; transpose_item(a.in[15], 2048, 256, (bf16*)(ws + WS_BT_C1) + 256 * 2048, 64 * kb, 32 * nb, 32 * nb, scr, lane); }
    }
}

__device__ __forceinline__ void norm_rows(const float* __restrict__ src, const float* __restrict__ gamma, const float* __restrict__ mod, int sh_off, int sc_off, bf16* dst) {
    int tid_ = threadIdx.x; asm volatile("" : "+v"(tid_)); const int tid = tid_, lane = tid & 63, wave = tid >> 6;
    const int gw = blockIdx.x * NWAVES + wave, NGW = gridDim.x * NWAVES;
    const int per = (MTOK + NGW - 1) / NGW;
    const int r0 = gw * per, r1 = (r0 + per) < MTOK ? (r0 + per) : MTOK;
    if (r0 >= r1) return;
    f32x4 ga[4], sh[4];
    int bcur = -1;
    f32x4 va[4], vb[4];
    { const f32x4* xr = (const f32x4*)(src + (size_t)r0 * DM) + lane;
#pragma unroll
      for (int j = 0; j < 4; ++j) va[j] = xr[64 * j]; }
    { const int rr = (r0 + 1 < r1) ? r0 + 1 : r0; const f32x4* xr = (const f32x4*)(src + (size_t)rr * DM) + lane;
#pragma unroll
      for (int j = 0; j < 4; ++j) vb[j] = xr[64 * j]; }
    for (int row = r0; row < r1; ++row) {
        f32x4 v[4];
#pragma unroll
        for (int j = 0; j < 4; ++j) { v[j] = va[j]; va[j] = vb[j]; }
        { const int rr = (row + 2 < r1) ? row + 2 : row; const f32x4* xr = (const f32x4*)(src + (size_t)rr * DM) + lane;
#pragma unroll
          for (int j = 0; j < 4; ++j) vb[j] = xr[64 * j]; }
        const int b = row >> 12;
        if (b != bcur) { bcur = b; const float* mb = mod + b * 6144;
#pragma unroll
            for (int j = 0; j < 4; ++j) { const int col = 4 * lane + 256 * j; const f32x4 gv = *(const f32x4*)(gamma + col), sc = *(const f32x4*)(mb + sc_off + col);
                sh[j] = *(const f32x4*)(mb + sh_off + col); ga[j] = gv * (1.0f + sc); } }
        float ss = 0.f;
#pragma unroll
        for (int j = 0; j < 4; ++j) ss += v[j][0] * v[j][0] + v[j][1] * v[j][1] + v[j][2] * v[j][2] + v[j][3] * v[j][3];
        ss = wave_sum(ss);
        const float rstd = rsqrtf(ss * (1.0f / DM) + EPS);
#pragma unroll
        for (int j = 0; j < 4; ++j) {
            const int col = 4 * lane + 256 * j;
            f32x4 y;
#pragma unroll
            for (int e = 0; e < 4; ++e) y[e] = (v[j][e] * rstd) * ga[j][e] + sh[j][e];
            v2u o; o.x = pk2(y[0], y[1]); o.y = pk2(y[2], y[3]);
            *(v2u*)(dst + (size_t)row * DM + col) = o;
        }
    }
}

__device__ __forceinline__ void norm_rows_b(const bf16* __restrict__ src, const float* __restrict__ gamma, const float* __restrict__ mod, int sh_off, int sc_off, bf16* dst) {
    int tid_ = threadIdx.x; asm volatile("" : "+v"(tid_)); const int tid = tid_, lane = tid & 63, wave = tid >> 6;
    const int gw = blockIdx.x * NWAVES + wave, NGW = gridDim.x * NWAVES;
    const int per = (MTOK + NGW - 1) / NGW;
    const int r0 = gw * per, r1 = (r0 + per) < MTOK ? (r0 + per) : MTOK;
    if (r0 >= r1) return;
    f32x4 ga[4], sh[4];
    int bcur = -1;
    v4u va[2], vb[2];
    { const v4u* xr = (const v4u*)(src + (size_t)r0 * DM) + lane; va[0] = xr[0]; va[1] = xr[64]; }
    { const int rr = (r0 + 1 < r1) ? r0 + 1 : r0; const v4u* xr = (const v4u*)(src + (size_t)rr * DM) + lane; vb[0] = xr[0]; vb[1] = xr[64]; }
    for (int row = r0; row < r1; ++row) {
        v4u raw[2]; raw[0] = va[0]; raw[1] = va[1]; va[0] = vb[0]; va[1] = vb[1];
        { const int rr = (row + 2 < r1) ? row + 2 : row; const v4u* xr = (const v4u*)(src + (size_t)rr * DM) + lane; vb[0] = xr[0]; vb[1] = xr[64]; }
        const int b = row >> 12;
        if (b != bcur) { bcur = b; const float* mb = mod + b * 6144;
#pragma unroll
            for (int j = 0; j < 4; ++j) { const int col = 512 * (j >> 1) + 8 * lane + 4 * (j & 1); const f32x4 gv = *(const f32x4*)(gamma + col), sc = *(const f32x4*)(mb + sc_off + col);
                sh[j] = *(const f32x4*)(mb + sh_off + col); ga[j] = gv * (1.0f + sc); } }
        f32x4 v[4];
#pragma unroll
        for (int h = 0; h < 2; ++h) { v[2 * h] = (f32x4){bflo(raw[h].x), bfhi(raw[h].x), bflo(raw[h].y), bfhi(raw[h].y)}; v[2 * h + 1] = (f32x4){bflo(raw[h].z), bfhi(raw[h].z), bflo(raw[h].w), bfhi(raw[h].w)}; }
        float ss = 0.f;
#pragma unroll
        for (int j = 0; j < 4; ++j) ss += v[j][0] * v[j][0] + v[j][1] * v[j][1] + v[j][2] * v[j][2] + v[j][3] * v[j][3];
        ss = wave_sum(ss);
        const float rstd = rsqrtf(ss * (1.0f / DM) + EPS);
#pragma unroll
        for (int h = 0; h < 2; ++h) {
            f32x4 y0, y1;
#pragma unroll
            for (int e = 0; e < 4; ++e) { y0[e] = (v[2 * h][e] * rstd) * ga[2 * h][e] + sh[2 * h][e]; y1[e] = (v[2 * h + 1][e] * rstd) * ga[2 * h + 1][e] + sh[2 * h + 1][e]; }
            v4u o; o.x = pk2(y0[0], y0[1]); o.y = pk2(y0[2], y0[3]); o.z = pk2(y1[0], y1[1]); o.w = pk2(y1[2], y1[3]);
            *(v4u*)(dst + (size_t)row * DM + 512 * h + 8 * lane) = o;
        }
    }
}

__device__ __forceinline__ float dpp_shr1(float v) { return __builtin_bit_cast(float, __builtin_amdgcn_update_dpp(0, __builtin_bit_cast(int, v), 0x111, 0xf, 0xf, true)); }
__device__ __forceinline__ float dpp_shr2(float v) { return __builtin_bit_cast(float, __builtin_amdgcn_update_dpp(0, __builtin_bit_cast(int, v), 0x112, 0xf, 0xf, true)); }
__device__ __forceinline__ unsigned dpp_ror8(unsigned v) { return (unsigned)__builtin_amdgcn_update_dpp(0, (int)v, 0x128, 0xf, 0xf, false); }
struct EpiProj {
    static constexpr bool PERM = true, PERM2 = true, AFTER_DRAIN = false;
    bf16* P; bf16* QN; bf16* KSN; bf16* KWN; float* gates; const float* gq; const float* gs; const float* gw; const float* bgate;
    __device__ __forceinline__ void operator()(const f32x4 (&acc)[2][2][4][2], const pg8::Unit& u, int wr, int wc, int fr, int fq) const {
        const bool lo = fr < 8;
        const int colb = u.pn * 256 + wc * 64, seg = colb >> 6, d = (lo ? 0 : 32) + 8 * fq;
        const bool keep = (colb + d) < NIN;
        const int rowb = u.pm * 256 + wr * 64 + (fr & 7);
        bf16* base = P; int ns = NSEG, sidx = seg; const float* gm = nullptr; float mult = 1.0f;
        if (seg < 8) { base = QN; ns = 8; gm = gq; mult = 0.125f * LOG2E; }
        else if (seg == 12 || seg == 13) { base = KSN; ns = 2; sidx = seg - 12; gm = gs; }
        else if (seg == 16 || seg == 17) { base = KWN; ns = 2; sidx = seg - 16; gm = gw; }
        f32x4 g00 = {1.f, 1.f, 1.f, 1.f}, g01 = g00, g10 = g00, g11 = g00;
        if (gm) { g00 = *(const f32x4*)(gm + 8 * fq); g01 = *(const f32x4*)(gm + 8 * fq + 4); g10 = *(const f32x4*)(gm + 32 + 8 * fq); g11 = *(const f32x4*)(gm + 32 + 8 * fq + 4); }
#pragma unroll
        for (int ai = 0; ai < 2; ++ai)
#pragma unroll
            for (int m = 0; m < 4; ++m) {
                f32x4 a0 = acc[ai][0][m][0], a1 = acc[ai][0][m][1], b0 = acc[ai][1][m][0], b1 = acc[ai][1][m][1];
                const int rown = u.pm * 256 + wr * 64 + ai * 128 + m * 16 + fr;
                if (gm) {
                    float ss = 0.f;
#pragma unroll
                    for (int e = 0; e < 4; ++e) ss += a0[e] * a0[e] + a1[e] * a1[e] + b0[e] * b0[e] + b1[e] * b1[e];
                    ss += __shfl_xor(ss, 16); ss += __shfl_xor(ss, 32);
                    const float rs = rsqrtf(ss * (1.0f / 64.0f) + EPS) * mult;
                    a0 = a0 * rs * g00; a1 = a1 * rs * g01; b0 = b0 * rs * g10; b1 = b1 * rs * g11;
                } else if (seg == 20 && fq < 3) {
                    const f32x4 bg0 = *(const f32x4*)(bgate + 8 * fq), bg1 = *(const f32x4*)(bgate + 8 * fq + 4);
                    f32x4 s0, s1;
#pragma unroll
                    for (int e = 0; e < 4; ++e) { s0[e] = __builtin_amdgcn_rcpf(1.0f + __builtin_amdgcn_exp2f(-LOG2E * (a0[e] + bg0[e]))); s1[e] = __builtin_amdgcn_rcpf(1.0f + __builtin_amdgcn_exp2f(-LOG2E * (a1[e] + bg1[e]))); }
                    *(f32x4*)(gates + (size_t)rown * 24 + 8 * fq) = s0; *(f32x4*)(gates + (size_t)rown * 24 + 8 * fq + 4) = s1;
                }
                v4u p0, p1; p0.x = pk2(a0[0], a0[1]); p0.y = pk2(a0[2], a0[3]); p0.z = pk2(a1[0], a1[1]); p0.w = pk2(a1[2], a1[3]);
                p1.x = pk2(b0[0], b0[1]); p1.y = pk2(b0[2], b0[3]); p1.z = pk2(b1[0], b1[1]); p1.w = pk2(b1[2], b1[3]);
                const unsigned sx = lo ? p1.x : p0.x, sy = lo ? p1.y : p0.y, sz = lo ? p1.z : p0.z, sw = lo ? p1.w : p0.w;
                v4u rc; rc.x = dpp_ror8(sx); rc.y = dpp_ror8(sy); rc.z = dpp_ror8(sz); rc.w = dpp_ror8(sw);
                v4u s1, s2;
                s1.x = lo ? p0.x : rc.x; s1.y = lo ? p0.y : rc.y; s1.z = lo ? p0.z : rc.z; s1.w = lo ? p0.w : rc.w;
                s2.x = lo ? rc.x : p1.x; s2.y = lo ? rc.y : p1.y; s2.z = lo ? rc.z : p1.z; s2.w = lo ? rc.w : p1.w;
                const int r = rowb + ai * 128 + m * 16, b = r >> 12, t = r & 4095;
                bf16* dst = base + ((size_t)(b * ns + sidx) * SEQ + t) * 64 + d;
                if (keep) { __builtin_nontemporal_store(s1, (v4u*)dst); __builtin_nontemporal_store(s2, (v4u*)(dst + 8 * 64)); }
            }
    }
};
struct EpiRes {
    static constexpr bool PERM = true, PERM2 = false, AFTER_DRAIN = false;
    const float* base; float* out; const float* mod; int goff;
    __device__ __forceinline__ void operator()(const f32x4 (&acc)[2][2][4][2], const pg8::Unit& u, int wr, int wc, int fr, int fq) const {
        const int row0 = u.pm * 256 + wr * 64 + fr, col0 = u.pn * 256 + wc * 32 + 8 * fq;
        const int b = (u.pm * 256) >> 12;
        f32x4 gv[2][2];
#pragma unroll
        for (int bj = 0; bj < 2; ++bj)
#pragma unroll
            for (int n = 0; n < 2; ++n) gv[bj][n] = *(const f32x4*)(mod + b * 6144 + goff + col0 + bj * 128 + n * 4);
#pragma unroll
        for (int ai = 0; ai < 2; ++ai) {
            f32x4 xv[4][2][2];
#pragma unroll
            for (int m = 0; m < 4; ++m) { const size_t r = (size_t)(row0 + ai * 128 + m * 16);
#pragma unroll
                for (int bj = 0; bj < 2; ++bj)
#pragma unroll
                    for (int n = 0; n < 2; ++n) xv[m][bj][n] = *(const f32x4*)(base + r * DM + col0 + bj * 128 + n * 4); }
#pragma unroll
            for (int m = 0; m < 4; ++m) { const size_t r = (size_t)(row0 + ai * 128 + m * 16);
#pragma unroll
                for (int bj = 0; bj < 2; ++bj)
#pragma unroll
                    for (int n = 0; n < 2; ++n) *(f32x4*)(out + r * DM + col0 + bj * 128 + n * 4) = xv[m][bj][n] + gv[bj][n] * acc[ai][bj][m][n]; }
        }
    }
};
struct EpiResB {
    static constexpr bool PERM = true, PERM2 = false, AFTER_DRAIN = false;
    const float* base; bf16* out; const float* mod; int goff;
    __device__ __forceinline__ void operator()(const f32x4 (&acc)[2][2][4][2], const pg8::Unit& u, int wr, int wc, int fr, int fq) const {
        const int row0 = u.pm * 256 + wr * 64 + fr, col0 = u.pn * 256 + wc * 32 + 8 * fq;
        const int b = (u.pm * 256) >> 12;
        f32x4 gv[2][2];
#pragma unroll
        for (int bj = 0; bj < 2; ++bj)
#pragma unroll
            for (int n = 0; n < 2; ++n) gv[bj][n] = *(const f32x4*)(mod + b * 6144 + goff + col0 + bj * 128 + n * 4);
#pragma unroll
        for (int ai = 0; ai < 2; ++ai) {
            f32x4 xv[4][2][2];
#pragma unroll
            for (int m = 0; m < 4; ++m) { const size_t r = (size_t)(row0 + ai * 128 + m * 16);
#pragma unroll
                for (int bj = 0; bj < 2; ++bj)
#pragma unroll
                    for (int n = 0; n < 2; ++n) xv[m][bj][n] = *(const f32x4*)(base + r * DM + col0 + bj * 128 + n * 4); }
#pragma unroll
            for (int m = 0; m < 4; ++m) { const size_t r = (size_t)(row0 + ai * 128 + m * 16);
#pragma unroll
                for (int bj = 0; bj < 2; ++bj) { const f32x4 v0 = xv[m][bj][0] + gv[bj][0] * acc[ai][bj][m][0], v1 = xv[m][bj][1] + gv[bj][1] * acc[ai][bj][m][1];
                    v4u w; w.x = pk2(v0[0], v0[1]); w.y = pk2(v0[2], v0[3]); w.z = pk2(v1[0], v1[1]); w.w = pk2(v1[2], v1[3]);
                    *(v4u*)(out + r * DM + col0 + bj * 128) = w; } }
        }
    }
};
struct EpiResF {
    static constexpr bool PERM = true, PERM2 = false, AFTER_DRAIN = false;
    const bf16* base; float* out; const float* mod; int goff;
    __device__ __forceinline__ void operator()(const f32x4 (&acc)[2][2][4][2], const pg8::Unit& u, int wr, int wc, int fr, int fq) const {
        const int row0 = u.pm * 256 + wr * 64 + fr, col0 = u.pn * 256 + wc * 32 + 8 * fq;
        const int b = (u.pm * 256) >> 12;
        f32x4 gv[2][2];
#pragma unroll
        for (int bj = 0; bj < 2; ++bj)
#pragma unroll
            for (int n = 0; n < 2; ++n) gv[bj][n] = *(const f32x4*)(mod + b * 6144 + goff + col0 + bj * 128 + n * 4);
#pragma unroll
        for (int ai = 0; ai < 2; ++ai) {
            v4u xv[4][2];
#pragma unroll
            for (int m = 0; m < 4; ++m) { const size_t r = (size_t)(row0 + ai * 128 + m * 16);
#pragma unroll
                for (int bj = 0; bj < 2; ++bj) xv[m][bj] = *(const v4u*)(base + r * DM + col0 + bj * 128); }
#pragma unroll
            for (int m = 0; m < 4; ++m) { const size_t r = (size_t)(row0 + ai * 128 + m * 16);
#pragma unroll
                for (int bj = 0; bj < 2; ++bj) { const v4u x = xv[m][bj];
                    const f32x4 x0 = {bflo(x.x), bfhi(x.x), bflo(x.y), bfhi(x.y)}, x1 = {bflo(x.z), bfhi(x.z), bflo(x.w), bfhi(x.w)};
                    *(f32x4*)(out + r * DM + col0 + bj * 128) = x0 + gv[bj][0] * acc[ai][bj][m][0];
                    *(f32x4*)(out + r * DM + col0 + bj * 128 + 4) = x1 + gv[bj][1] * acc[ai][bj][m][1]; } }
        }
    }
};
struct EpiCmp {
    static constexpr bool PERM = false, PERM2 = false, AFTER_DRAIN = false;
    float* hid; const float* bias1;
    __device__ __forceinline__ void operator()(const f32x4 (&acc)[2][2][4][2], const pg8::Unit& u, int wr, int wc, int fr, int fq) const {
        const int row0 = wr * 64 + fr, col0 = wc * 32 + 4 * fq;
        float* hb = hid + ((size_t)u.pn * 4096 + (size_t)u.pm * 256) * 256;
#pragma unroll
        for (int ai = 0; ai < 2; ++ai)
#pragma unroll
            for (int m = 0; m < 4; ++m) { const int r = row0 + ai * 128 + m * 16;
#pragma unroll
                for (int bj = 0; bj < 2; ++bj)
#pragma unroll
                    for (int n = 0; n < 2; ++n) { const int c = col0 + bj * 128 + n * 16;
                        const f32x4 bv = *(const f32x4*)(bias1 + u.pn * 256 + c); f32x4 v = acc[ai][bj][m][n] + bv;
#pragma unroll
                        for (int e = 0; e < 4; ++e) v[e] = gelu_tanh_f(v[e]);
                        *(f32x4*)(hb + (size_t)r * 256 + c) = v; } }
    }
};
struct CmpOrder {
    int c; const bf16* proj; const bf16* btc1;
    __device__ bool next(int i, pg8::Unit& u) const { if (i > 0 || c >= 32) return false; u.pm = c & 15; u.pn = c >> 4; return true; }
    __device__ __forceinline__ const char* a_ptr(const pg8::Gemm&, const pg8::Unit& u) const { const int b = u.pm >> 1, g = u.pm & 1; return (const char*)(proj + ((size_t)(b * NSEG + 8 + 2 * u.pn + g) * SEQ) * 64); }
    __device__ __forceinline__ const char* b_ptr(const pg8::Gemm&, const pg8::Unit& u) const { return (const char*)(btc1 + (size_t)u.pn * 256 * 2048); }
    __device__ __forceinline__ void a_ready(const pg8::Unit&) const {}
    __device__ __forceinline__ void done(const pg8::Unit&) const {}
};
struct EpiFfn {
    static constexpr bool PERM = true, PERM2 = false, AFTER_DRAIN = false;
    bf16* H; const float* cw; float* gtail; float* ghead; float* uhead; LAS float* hb;
    __device__ __forceinline__ void operator()(const f32x4 (&acc)[2][2][4][2], const pg8::Unit& u, int wr, int wc, int fr, int fq) const {
        int cl_ = wc * 32 + 8 * fq; asm volatile("" : "+v"(cl_));
        const int cl = cl_, ch0 = u.pn * 128 + cl;
        if (fr >= 14) {
#pragma unroll
            for (int ai = 0; ai < 2; ++ai)
#pragma unroll
                for (int m = 0; m < 4; ++m) { const int kk = 8 * ai + 4 * wr + m;
#pragma unroll
                    for (int n = 0; n < 2; ++n) *(LAS f32x4*)(hb + ((kk * 2 + (fr - 14)) * 128 + cl + 4 * n)) = acc[ai][0][m][n]; }
        }
        asm volatile("s_waitcnt lgkmcnt(0)" ::: "memory"); __builtin_amdgcn_s_barrier(); asm volatile("" ::: "memory");
        f32x4 w0[2], w1[2], w2[2];
#pragma unroll
        for (int n = 0; n < 2; ++n) { w0[n] = *(const f32x4*)(cw + ch0 + 4 * n); w1[n] = *(const f32x4*)(cw + DFF + ch0 + 4 * n); w2[n] = *(const f32x4*)(cw + 2 * DFF + ch0 + 4 * n); }
#pragma unroll
        for (int ai = 0; ai < 2; ++ai)
#pragma unroll
            for (int m = 0; m < 4; ++m) { const int kk = 8 * ai + 4 * wr + m; const int rl = 128 * ai + 64 * wr + 16 * m + fr; const size_t r = (size_t)u.pm * 256 + rl;
                f32x4 hv[2];
#pragma unroll
                for (int n = 0; n < 2; ++n) { const f32x4 g0 = acc[ai][0][m][n]; f32x4 g1, g2;
                    g1[0] = dpp_shr1(g0[0]); g1[1] = dpp_shr1(g0[1]); g1[2] = dpp_shr1(g0[2]); g1[3] = dpp_shr1(g0[3]);
                    g2[0] = dpp_shr2(g0[0]); g2[1] = dpp_shr2(g0[1]); g2[2] = dpp_shr2(g0[2]); g2[3] = dpp_shr2(g0[3]);
                    if (fr < 2) { const f32x4 z = {0.f, 0.f, 0.f, 0.f};
                        const f32x4 p15 = kk > 0 ? *(const LAS f32x4*)(hb + (((kk - 1) * 2 + 1) * 128 + cl + 4 * n)) : z;
                        const f32x4 p14 = kk > 0 ? *(const LAS f32x4*)(hb + (((kk - 1) * 2 + 0) * 128 + cl + 4 * n)) : z;
                        if (fr == 0) { g1 = p15; g2 = p14; } else { g2 = p15; } }
                    const f32x4 pre = w0[n] * g2 + w1[n] * g1 + w2[n] * g0; const f32x4 up = acc[ai][1][m][n];
#pragma unroll
                    for (int e = 0; e < 4; ++e) hv[n][e] = silu_f(pre[e]) * up[e];
                    if (kk == 0 && fr < 2) { *(f32x4*)(ghead + ((size_t)u.pm * 2 + fr) * DFF + ch0 + 4 * n) = g0; *(f32x4*)(uhead + ((size_t)u.pm * 2 + fr) * DFF + ch0 + 4 * n) = up; }
                    if (kk == 15 && fr >= 14) *(f32x4*)(gtail + ((size_t)u.pm * 2 + (fr - 14)) * DFF + ch0 + 4 * n) = g0;
                }
                v4u w; w.x = pk2(hv[0][0], hv[0][1]); w.y = pk2(hv[0][2], hv[0][3]); w.z = pk2(hv[1][0], hv[1][1]); w.w = pk2(hv[1][2], hv[1][3]);
                __builtin_nontemporal_store(w, (v4u*)(H + r * DFF + ch0)); }
    }
};

__device__ __forceinline__ void phase3_prep(const Args& a, LAS unsigned char* lds, int pw, int PW) {
    int tid_ = threadIdx.x; asm volatile("" : "+v"(tid_)); const int tid = tid_, lane = tid & 63, wave = tid >> 6;
    unsigned char* ws = a.ws;
    const bf16* __restrict__ proj = (const bf16*)(ws + WS_PROJ);
    {
        bf16* mixed = (bf16*)(ws + WS_MIXED);
        const float* cw = a.in[17]; const float* cg_g = a.in[19];
        const int sub = lane & 7;
        constexpr int NST = NB * 8 * SEQ / 8;
        for (int st0 = pw; st0 < NST; st0 += 2 * PW) {
            v4u rb[2], rc0[2], rx0[2], rc1[2], rx1[2], rc2[2], rx2[2];
#pragma unroll
            for (int u = 0; u < 2; ++u) { const int st1 = st0 + u * PW, st = st1 < NST ? st1 : NST - 1;
                {
                    const int b = st >> 12, cgp = (st >> 9) & 7, t = (st & 511) * 8 + (lane >> 3);
                    const int c = cgp * 64 + sub * 8;
                    const int colB = 1304 + c, colC = 1816 + c, colX = 2328 + c;
                    const bf16* pB = proj + ((size_t)(b * NSEG + (colB >> 6)) * SEQ + t) * 64 + (colB & 63);
                    const bf16* pC = proj + ((size_t)(b * NSEG + (colC >> 6)) * SEQ + t) * 64 + (colC & 63);
                    const bf16* pX = proj + ((size_t)(b * NSEG + (colX >> 6)) * SEQ + t) * 64 + (colX & 63);
                    const v4u z = {0u, 0u, 0u, 0u};
                    rb[u] = *(const v4u*)pB; rc0[u] = *(const v4u*)pC; rx0[u] = *(const v4u*)pX;
                    rc1[u] = t >= 1 ? *(const v4u*)(pC - 64) : z; rx1[u] = t >= 1 ? *(const v4u*)(pX - 64) : z;
                    rc2[u] = t >= 2 ? *(const v4u*)(pC - 128) : z; rx2[u] = t >= 2 ? *(const v4u*)(pX - 128) : z; } }
#pragma unroll
            for (int u = 0; u < 2; ++u) { const int st1 = st0 + u * PW, st = st1 < NST ? st1 : NST - 1;
                {
                    const int b = st >> 12, cgp = (st >> 9) & 7, t = (st & 511) * 8 + (lane >> 3);
                    const int c = cgp * 64 + sub * 8;
                    const f32x4 w0a = *(const f32x4*)(cw + c), w0b = *(const f32x4*)(cw + c + 4), w1a = *(const f32x4*)(cw + 512 + c), w1b = *(const f32x4*)(cw + 512 + c + 4);
                    const f32x4 w2a = *(const f32x4*)(cw + 1024 + c), w2b = *(const f32x4*)(cw + 1024 + c + 4), ga = *(const f32x4*)(cg_g + c), gb = *(const f32x4*)(cg_g + c + 4);
                    float v[8];
#define CONV_E(e, RW, W0, W1, W2, LOHI) v[e] = LOHI(rb[u].RW) * (W0 * (LOHI(rc2[u].RW) * LOHI(rx2[u].RW)) + W1 * (LOHI(rc1[u].RW) * LOHI(rx1[u].RW)) + W2 * (LOHI(rc0[u].RW) * LOHI(rx0[u].RW)))
                    CONV_E(0, x, w0a[0], w1a[0], w2a[0], bflo); CONV_E(1, x, w0a[1], w1a[1], w2a[1], bfhi); CONV_E(2, y, w0a[2], w1a[2], w2a[2], bflo); CONV_E(3, y, w0a[3], w1a[3], w2a[3], bfhi);
                    CONV_E(4, z, w0b[0], w1b[0], w2b[0], bflo); CONV_E(5, z, w0b[1], w1b[1], w2b[1], bfhi); CONV_E(6, w, w0b[2], w1b[2], w2b[2], bflo); CONV_E(7, w, w0b[3], w1b[3], w2b[3], bfhi);
#undef CONV_E
                    float ss = 0.f;
#pragma unroll
                    for (int e = 0; e < 8; ++e) ss += v[e] * v[e];
                    ss += __shfl_xor(ss, 1); ss += __shfl_xor(ss, 2); ss += __shfl_xor(ss, 4);
                    const float rs = rsqrtf(ss * (1.0f / 64.0f) + EPS);
                    v4u o; o.x = pk2(v[0] * rs * ga[0], v[1] * rs * ga[1]); o.y = pk2(v[2] * rs * ga[2], v[3] * rs * ga[3]);
                    o.z = pk2(v[4] * rs * gb[0], v[5] * rs * gb[1]); o.w = pk2(v[6] * rs * gb[2], v[7] * rs * gb[3]);
                    if (st1 < NST) *(v4u*)(mixed + ((size_t)b * SEQ + t) * DM + 512 + c) = o;
                } }
        }
    }
}

__device__ __forceinline__ void phase4(const Args& a, LAS unsigned char* lds) {
    int tid_ = threadIdx.x; asm volatile("" : "+v"(tid_)); const int tid = tid_, lane = tid & 63, wave = tid >> 6;
    unsigned char* ws = a.ws;
    const float* hid = (const float*)(ws + WS_HID);
    const int G = gridDim.x, half = G >> 1;
    const int kv = (int)blockIdx.x >= half ? 1 : 0;
    const int bl = (int)blockIdx.x - kv * half, nb = kv ? (G - half) : half;
    LAS float* W2 = (LAS float*)lds;
    LAS float* scr = (LAS float*)(lds + 65536 + wave * 4096);
    { const float* w2 = a.in[14 + 2 * kv];
#pragma unroll
      for (int q = 0; q < 8; ++q) { const int idx = q * 512 + tid; *(LAS f32x4*)(W2 + idx * 4) = *(const f32x4*)(w2 + idx * 4); } }
    __syncthreads();
    for (int it = bl * NWAVES + wave; it < 1024; it += nb * NWAVES) {
        const int r4 = it * 4;
#pragma unroll
        for (int j = 0; j < 4; ++j)
#pragma unroll
            for (int q = 0; q < 4; ++q) scr[(q * 64 + lane) * 4 + j] = hid[((size_t)kv * 4096 + r4 + j) * 256 + q * 64 + lane];
        LDS_WAIT(); asm volatile("" ::: "memory");
        f32x4 acc = {0.f, 0.f, 0.f, 0.f};
#pragma unroll 16
        for (int k = 0; k < 256; ++k) { const float w = W2[k * 64 + lane]; const f32x4 h = *(const LAS f32x4*)(scr + k * 4); acc += h * w; }
        LDS_WAIT(); asm volatile("" ::: "memory");
#pragma unroll
        for (int j = 0; j < 4; ++j) {
            const int row = r4 + j, pair = row >> 8, n = row & 255;
            if (kv == 0) {
                const float ss = wave_sum(acc[j] * acc[j]);
                const float y = acc[j] * rsqrtf(ss * (1.0f / 64.0f) + EPS) * a.in[8][lane];
                ((bf16*)(ws + WS_KCN))[((size_t)pair * 256 + n) * 64 + lane] = (n < 255) ? (bf16)f2bf(y) : (bf16)0;
            } else {
                ((bf16*)(ws + WS_VCT))[((size_t)pair * 64 + lane) * 256 + n] = (n < 255) ? (bf16)f2bf(acc[j]) : (bf16)0;
            }
        }
    }
}

#ifndef PROBE_CMP
#define PROBE_CMP 0
#endif
#ifndef PROBE_TOPK
#define PROBE_TOPK 0
#endif
#ifndef PROBE_SEL
#define PROBE_SEL 0
#endif
#ifndef PROBE_WIN
#define PROBE_WIN 0
#endif
#define MFMA32(a, b, c) __builtin_amdgcn_mfma_f32_32x32x16_bf16((a), (b), (c), 0, 0, 0)
constexpr int AT_CK = 0, AT_CV = 36864, AT_PS = 70656, AT_SLOT = 0, AT_OF = 73728, AT_WU = 139264, AT_KEYS = 139392, PS_PITCH = 260;
constexpr int QCTR_WORD = 3584;
constexpr int AT_KB0 = 0, AT_KB1 = 9216, AT_VB0 = 18432, AT_VB1 = 27648;
constexpr float NEG_BIG = -1.0e30f;

__device__ __forceinline__ float quad_sum(float t) {
    t += __builtin_bit_cast(float, __builtin_amdgcn_mov_dpp(__builtin_bit_cast(int, t), 0xB1, 0xf, 0xf, true));
    t += __builtin_bit_cast(float, __builtin_amdgcn_mov_dpp(__builtin_bit_cast(int, t), 0x4E, 0xf, 0xf, true));
    return t;
}
__device__ __forceinline__ s16x4 vtr(const LAS unsigned char* p) { return __builtin_amdgcn_ds_read_tr16_b64_v4i16((LAS s16x4*)p); }
template <int MODE, bool DIAG, bool VTR = false>
__device__ __forceinline__ void attn_tile(const LAS unsigned char* Kt, const LAS unsigned char* Vt, int vpitch, int vkoff, const bf16x8 (&qf)[4], int r, int h2,
                                          float cs, float A, int lo, int hi, float& m, float& l, f32x16 (&o)[2], float inv_l, LAS float* psrow) {
    float rowsum = 0.f;
#pragma unroll
    for (int sub = 0; sub < 2; ++sub) {
        f32x16 s;
#pragma unroll
        for (int i = 0; i < 16; ++i) s[i] = __builtin_fmaf(cs, (float)(32 * sub + (i & 3) + 8 * (i >> 2)), A);
#pragma unroll
        for (int ks = 0; ks < 4; ++ks) { const bf16x8 kf = *(const LAS bf16x8*)(Kt + (32 * sub + r) * 144 + (16 * ks + 8 * h2) * 2); s = MFMA32(kf, qf[ks], s); }
        if (DIAG) {
#pragma unroll
            for (int i = 0; i < 16; ++i) { const int ci = 32 * sub + (i & 3) + 8 * (i >> 2); s[i] = (ci >= lo && ci <= hi) ? s[i] : -INFINITY; }
        }
        if (MODE == 0) {
            float mx = s[0];
#pragma unroll
            for (int i = 1; i < 16; ++i) mx = fmaxf(mx, s[i]);
            mx = fmaxf(mx, __shfl_xor(mx, 32));
            const float mn = fmaxf(m, mx); l *= __builtin_amdgcn_exp2f(m - mn); m = mn;
            float rs = 0.f;
#pragma unroll
            for (int i = 0; i < 16; ++i) rs += __builtin_amdgcn_exp2f(s[i] - mn);
            l += rs;
            continue;
        }
#pragma unroll
        for (int i = 0; i < 16; ++i) {
            float p;
            if (MODE == 1) p = __builtin_amdgcn_exp2f(s[i] - m) * inv_l; else p = __builtin_amdgcn_exp2f(s[i]);
            rowsum += p; s[i] = p;
        }
        if (MODE == 1) {
#pragma unroll
            for (int i = 0; i < 16; ++i) { const float t = quad_sum(s[i]);
                if ((r & 3) == 0) psrow[32 * sub + (i & 3) + 8 * (i >> 2) + 4 * h2] = t; }
        }
#pragma unroll
        for (int st = 0; st < 2; ++st) {
            v4u pw; pw.x = pk2(s[8 * st + 0], s[8 * st + 1]); pw.y = pk2(s[8 * st + 2], s[8 * st + 3]);
            pw.z = pk2(s[8 * st + 4], s[8 * st + 5]); pw.w = pk2(s[8 * st + 6], s[8 * st + 7]);
            const bf16x8 pf = __builtin_bit_cast(bf16x8, pw);
#pragma unroll
            for (int dt = 0; dt < 2; ++dt) {
                s16x4 lo4, hi4;
                if (VTR) {
                    const LAS unsigned char* vp = Vt + (32 * sub + 16 * st + 4 * h2 + ((r & 15) >> 2)) * vpitch + (32 * dt + 16 * (r >> 4)) * 2 + 8 * (r & 3);
                    lo4 = vtr(vp); hi4 = vtr(vp + 8 * vpitch);
                } else {
                    const LAS unsigned char* vp = Vt + (32 * dt + r) * vpitch + vkoff + (32 * sub + 16 * st + 4 * h2) * 2;
                    lo4 = *(const LAS s16x4*)(vp); hi4 = *(const LAS s16x4*)(vp + 16);
                }
                const bf16x8 vf = __builtin_shufflevector(lo4, hi4, 0, 1, 2, 3, 4, 5, 6, 7);
                o[dt] = MFMA32(vf, pf, o[dt]);
            }
        }
    }
    if (MODE >= 2) l += rowsum;
}

template <int MODE>
__device__ __forceinline__ void attn_blocks(LAS unsigned char* lds, unsigned long long blocks, unsigned long long wmask, int iq, const bf16* Kg, const bf16* Vtg, const bf16x8 (&qf)[4], int r, int h2,
                                            float slope2, float smax2, int tpos, unsigned long long mymask, float& l, f32x16 (&o)[2]) {
    int tid_ = threadIdx.x; asm volatile("" : "+v"(tid_)); const int tid = tid_;
    const int lrow = tid >> 3, lch = tid & 7;
    const int loff = lrow * 144 + lch * 16;
    const unsigned char* kgp = (const unsigned char*)Kg + tid * 16;
    const unsigned char* vgp = (const unsigned char*)Vtg + tid * 16;
    float mdummy = 0.f;
    unsigned long long rem = blocks;
    int j0 = __builtin_ctzll(rem); rem &= rem - 1;
    int j1 = rem ? __builtin_ctzll(rem) : -1; if (rem) rem &= rem - 1;
    v4u k0, v0, k1 = {0u, 0u, 0u, 0u}, v1 = {0u, 0u, 0u, 0u};
    k0 = *(const v4u*)(kgp + (size_t)j0 * 8192); v0 = *(const v4u*)(vgp + (size_t)j0 * 8192);
    if (j1 >= 0) { k1 = *(const v4u*)(kgp + (size_t)j1 * 8192); v1 = *(const v4u*)(vgp + (size_t)j1 * 8192); }
    *(LAS v4u*)(lds + AT_SLOT + loff) = k0; *(LAS v4u*)(lds + AT_SLOT + 9216 + loff) = v0;
    *(LAS v4u*)(lds + AT_SLOT + 18432 + loff) = k1; *(LAS v4u*)(lds + AT_SLOT + 27648 + loff) = v1;
    __syncthreads();
    int cur = 0;
    for (;;) {
        const int n0 = rem ? __builtin_ctzll(rem) : -1; if (rem) rem &= rem - 1;
        const int n1 = rem ? __builtin_ctzll(rem) : -1; if (rem) rem &= rem - 1;
        if (n0 >= 0) { k0 = *(const v4u*)(kgp + (size_t)n0 * 8192); v0 = *(const v4u*)(vgp + (size_t)n0 * 8192); }
        if (n1 >= 0) { k1 = *(const v4u*)(kgp + (size_t)n1 * 8192); v1 = *(const v4u*)(vgp + (size_t)n1 * 8192); }
        const LAS unsigned char* sb = lds + AT_SLOT + cur * 36864;
#pragma unroll
        for (int u = 0; u < 2; ++u) {
            const int j = u ? j1 : j0;
            if (j >= 0 && ((wmask >> j) & 1ull)) {
                int rr = r, hh = h2; asm volatile("" : "+v"(rr), "+v"(hh));
                const bool on = (mymask >> j) & 1ull;
                const int rel = tpos - 64 * j - 4 * h2;
                float A = -slope2 * (float)rel - smax2;
                if (MODE == 2 && !on) A = -INFINITY;
                const LAS unsigned char* kb = sb + u * 18432; const LAS unsigned char* vb = kb + 9216;
                if (j == iq || (MODE == 3 && j == iq - 8)) attn_tile<MODE, true, true>(kb, vb, 144, 0, qf, rr, hh, slope2, A, (MODE == 3) ? rel - 511 : -100000, rel, mdummy, l, o, 0.f, nullptr);
                else attn_tile<MODE, false, true>(kb, vb, 144, 0, qf, rr, hh, slope2, A, 0, 0, mdummy, l, o, 0.f, nullptr);
            }
        }
        if (n0 >= 0) {
            LAS unsigned char* nb = lds + AT_SLOT + (cur ^ 1) * 36864;
            *(LAS v4u*)(nb + loff) = k0; *(LAS v4u*)(nb + 9216 + loff) = v0;
            if (n1 >= 0) { *(LAS v4u*)(nb + 18432 + loff) = k1; *(LAS v4u*)(nb + 27648 + loff) = v1; }
        }
        __syncthreads();
        if (n0 < 0) break;
        j0 = n0; j1 = n1; cur ^= 1;
    }
}

__device__ __forceinline__ float max_abs64(const float* g) {
    float m = fabsf(g[threadIdx.x & 63]);
#pragma unroll
    for (int o = 1; o < 64; o <<= 1) m = fmaxf(m, __shfl_xor(m, o));
    return m; }

__device__ __forceinline__ void phase5(const Args& a, LAS unsigned char* lds) {
    int tid_ = threadIdx.x; asm volatile("" : "+v"(tid_)); const int tid = tid_, lane = tid & 63, wave = tid >> 6, G = gridDim.x, c = blockIdx.x;
    unsigned char* ws = a.ws;
    const bf16* QN = (const bf16*)(ws + WS_QN);
    const float* gates = (const float*)(ws + WS_GATES);
    bf16* mixed = (bf16*)(ws + WS_MIXED);
    LAS float* PS = (LAS float*)(lds + AT_PS);
    LAS unsigned long long* WU = (LAS unsigned long long*)(lds + AT_WU);
    const float qb = max_abs64(a.in[7]) * (64.0f * 0.125f * LOG2E * 1.02f);
    const float smax_s = qb * max_abs64(a.in[9]), smax_w = qb * max_abs64(a.in[10]);
    for (int rd = 0;; ++rd) {
        const int rank = rd * G + ((rd & 1) ? (G - 1 - c) : c);
        if (rd * G >= 1024) break;
        if (rank >= 1024) continue;
        int ln_ = lane; asm volatile("" : "+v"(ln_));
        const int r = ln_ & 31, h2 = ln_ >> 5, hq = r & 3, tl = r >> 2;
        const int i = 63 - (rank >> 4), bg = rank & 15, b = bg >> 1, g = bg & 1;
        const int T0 = 64 * i, tpos = T0 + 8 * wave + tl;
        const int head = 4 * g + hq;
        const float slope2 = exp2f(-(float)(head + 1)) * LOG2E;
        const size_t mrow = (size_t)b * SEQ + tpos;
        {
            const unsigned char* kc = (const unsigned char*)((const bf16*)(ws + WS_KCN) + (size_t)bg * 256 * 64);
            const unsigned char* vc = (const unsigned char*)((const bf16*)(ws + WS_VCT) + (size_t)bg * 64 * 256);
#pragma unroll
            for (int q = 0; q < 4; ++q) { const int idx = q * 512 + tid;
                const v4u kv_ = *(const v4u*)(kc + (size_t)idx * 16); *(LAS v4u*)(lds + AT_CK + (idx >> 3) * 144 + (idx & 7) * 16) = kv_;
                const v4u vv_ = *(const v4u*)(vc + (size_t)idx * 16); *(LAS v4u*)(lds + AT_CV + (idx >> 5) * 528 + (idx & 31) * 16) = vv_; }
        }
        bf16x8 qf[4];
        { const bf16* qp = QN + ((size_t)(b * 8 + head) * SEQ + tpos) * 64 + 8 * h2;
#pragma unroll
          for (int ks = 0; ks < 4; ++ks) qf[ks] = *(const bf16x8*)(qp + 16 * ks); }
        __syncthreads();
        f32x16 ofin[2];
        const int KT = ((4 * i + 2) >> 6) + 1;
        float g_c, g_s, g_w;
        { const float* gp = gates + mrow * 24 + head * 3; g_c = gp[0]; g_s = gp[1]; g_w = gp[2]; }
#if PROBE_CMP
        for (int rep = 0; rep < 2; ++rep)
#endif
        {
            float m = NEG_BIG, l = 0.f; f32x16 o[2];
#pragma unroll
            for (int dt = 0; dt < 2; ++dt)
#pragma unroll
                for (int e = 0; e < 16; ++e) o[dt][e] = 0.f;
            const float cs = 16.0f * slope2;
            for (int kt = 0; kt < KT; ++kt) {
                const int rel = tpos - 31 - 1024 * kt;
                attn_tile<0, true>(lds + AT_CK + kt * 64 * 144, lds + AT_CV, 528, kt * 128, qf, r, h2, cs, -slope2 * (float)(rel - 64 * h2), -100000, (rel >> 4) - 4 * h2, m, l, o, 0.f, nullptr);
            }
            const float lt = l + __shfl_xor(l, 32);
            const float inv_l = lt > 0.f ? 1.0f / lt : 0.f;
            LAS float* psrow = PS + (8 * wave + tl) * PS_PITCH;
            for (int kt = 0; kt < KT; ++kt) {
                const int rel = tpos - 31 - 1024 * kt;
                attn_tile<1, true>(lds + AT_CK + kt * 64 * 144, lds + AT_CV, 528, kt * 128, qf, r, h2, cs, -slope2 * (float)(rel - 64 * h2), -100000, (rel >> 4) - 4 * h2, m, l, o, inv_l, psrow + 64 * kt);
            }
#pragma unroll
            for (int dt = 0; dt < 2; ++dt)
#pragma unroll
                for (int e = 0; e < 16; ++e) ofin[dt][e] = g_c * o[dt][e];
        }
        LDS_WAIT(); asm volatile("" ::: "memory");
        unsigned long long mymask = 0ull, wunion = 0ull;
#if PROBE_TOPK
        for (int rep = 0; rep < 2; ++rep)
#endif
        {
            const int nmax = (4 * i + 3) < 254 ? (4 * i + 3) : 254;
            const unsigned long long validbits = (i >= 63) ? ~0ull : ((1ull << (i + 1)) - 1ull);
            const bool forced = (lane == 0) || (lane == i) || (lane == i - 1);
            LAS unsigned* KEYS = (LAS unsigned*)(lds + AT_KEYS) + wave * 128;
            if (i < 16) { mymask = validbits; wunion = validbits; }
            else
#pragma unroll 1
            for (int t8 = 0; t8 < 8; t8 += 2) {
                const LAS float* psa = PS + (8 * wave + t8) * PS_PITCH; const LAS float* psb = psa + PS_PITCH;
                float impa = 0.f, impb = 0.f;
#pragma unroll
                for (int dn = -1; dn <= 3; ++dn) { const int n = 4 * lane + dn; if (n >= 0 && n <= nmax) { impa += psa[n]; impb += psb[n]; } }
                unsigned keya = (lane <= i) ? (((__builtin_bit_cast(unsigned, impa) & ~63u) + 64u) | (unsigned)(63 - lane)) : (unsigned)(63 - lane);
                unsigned keyb = (lane <= i) ? (((__builtin_bit_cast(unsigned, impb) & ~63u) + 64u) | (unsigned)(63 - lane)) : (unsigned)(63 - lane);
                keya = forced ? (0xFFFFFFC0u | (unsigned)(63 - lane)) : keya; keyb = forced ? (0xFFFFFFC0u | (unsigned)(63 - lane)) : keyb;
                KEYS[lane] = keya; KEYS[64 + lane] = keyb;
                LDS_WAIT(); asm volatile("" ::: "memory");
                int cnta = 0, cntb = 0;
#pragma unroll
                for (int k4 = 0; k4 < 16; ++k4) { const v4u ka = *(const LAS v4u*)(KEYS + 4 * k4), kb = *(const LAS v4u*)(KEYS + 64 + 4 * k4);
                    cnta += (ka.x > keya) ? 1 : 0; cnta += (ka.y > keya) ? 1 : 0; cnta += (ka.z > keya) ? 1 : 0; cnta += (ka.w > keya) ? 1 : 0;
                    cntb += (kb.x > keyb) ? 1 : 0; cntb += (kb.y > keyb) ? 1 : 0; cntb += (kb.z > keyb) ? 1 : 0; cntb += (kb.w > keyb) ? 1 : 0; }
                LDS_WAIT(); asm volatile("" ::: "memory");
                const unsigned long long mska = __ballot(cnta < 16) & validbits, mskb = __ballot(cntb < 16) & validbits;
                wunion |= mska | mskb;
                if (tl == t8) mymask = mska;
                if (tl == t8 + 1) mymask = mskb;
            }
            if (lane == 0) WU[wave] = wunion;
        }
        __syncthreads();
        unsigned long long uni = 0ull;
#pragma unroll
        for (int w = 0; w < 8; ++w) uni |= WU[w];
        {
            const unsigned lo = __builtin_amdgcn_readfirstlane((unsigned)uni), hi = __builtin_amdgcn_readfirstlane((unsigned)(uni >> 32));
            uni = ((unsigned long long)hi << 32) | lo;
        }
        LAS float* OF = (LAS float*)(lds + AT_OF) + tid;
#pragma unroll
        for (int dt = 0; dt < 2; ++dt)
#pragma unroll
            for (int e = 0; e < 16; ++e) OF[(dt * 16 + e) * 512] = ofin[dt][e];
        {
            float l = 0.f; f32x16 o[2];
#pragma unroll
            for (int dt = 0; dt < 2; ++dt)
#pragma unroll
                for (int e = 0; e < 16; ++e) o[dt][e] = 0.f;
            attn_blocks<2>(lds, uni, wunion, i, (const bf16*)(ws + WS_KSN) + (size_t)bg * SEQ * 64, (const bf16*)(ws + WS_PROJ) + ((size_t)(b * NSEG + 14 + g) * SEQ) * 64, qf, r, h2, slope2, smax_s, tpos, mymask, l, o);
            const float lt = l + __shfl_xor(l, 32);
            const float sc = lt > 0.f ? g_s / lt : 0.f;
#pragma unroll
            for (int dt = 0; dt < 2; ++dt)
#pragma unroll
                for (int e = 0; e < 16; ++e) OF[(dt * 16 + e) * 512] += sc * o[dt][e];
        }
        {
            float l = 0.f; f32x16 o[2];
#pragma unroll
            for (int dt = 0; dt < 2; ++dt)
#pragma unroll
                for (int e = 0; e < 16; ++e) o[dt][e] = 0.f;
            const int jlo = i - 8 < 0 ? 0 : i - 8;
            const unsigned long long upto = (i >= 63) ? ~0ull : ((1ull << (i + 1)) - 1ull);
            const unsigned long long wb = upto & ~((1ull << jlo) - 1ull);
            attn_blocks<3>(lds, wb, ~0ull, i, (const bf16*)(ws + WS_KWN) + (size_t)bg * SEQ * 64, (const bf16*)(ws + WS_PROJ) + ((size_t)(b * NSEG + 18 + g) * SEQ) * 64, qf, r, h2, slope2, smax_w, tpos, ~0ull, l, o);
            const float lt = l + __shfl_xor(l, 32);
            const float sc = lt > 0.f ? g_w / lt : 0.f;
#pragma unroll
            for (int dt = 0; dt < 2; ++dt)
#pragma unroll
                for (int e = 0; e < 16; ++e) ofin[dt][e] = OF[(dt * 16 + e) * 512] + sc * o[dt][e];
        }
        {
            float ss = 0.f;
#pragma unroll
            for (int dt = 0; dt < 2; ++dt)
#pragma unroll
                for (int e = 0; e < 16; ++e) ss += ofin[dt][e] * ofin[dt][e];
            ss += __shfl_xor(ss, 32);
            const float rs = rsqrtf(ss * (1.0f / 64.0f) + EPS);
            const float* og = a.in[18] + head * 64;
            LAS unsigned char* ob = lds + AT_CK + (wave * 32 + r) * 144;
#pragma unroll
            for (int dt = 0; dt < 2; ++dt)
#pragma unroll
                for (int i4 = 0; i4 < 4; ++i4) { const int d0 = 32 * dt + 8 * i4 + 4 * h2; const f32x4 gv = *(const f32x4*)(og + d0);
                    v2u w; w.x = pk2(ofin[dt][4 * i4 + 0] * rs * gv[0], ofin[dt][4 * i4 + 1] * rs * gv[1]); w.y = pk2(ofin[dt][4 * i4 + 2] * rs * gv[2], ofin[dt][4 * i4 + 3] * rs * gv[3]);
                    *(LAS v2u*)(ob + d0 * 2) = w; }
            __syncthreads();
#pragma unroll
            for (int q = 0; q < 4; ++q) { const int idx = q * 512 + tid, row = idx >> 3, chunk = idx & 7;
                const v4u v = *(const LAS v4u*)(lds + AT_CK + row * 144 + chunk * 16);
                *(v4u*)(mixed + ((size_t)b * SEQ + T0 + (row >> 2)) * DM + (4 * g + (row & 3)) * 64 + chunk * 8) = v; }
            __syncthreads();
        }
    }
}

__device__ __forceinline__ void phase8b(const Args& a) {
    unsigned char* ws = a.ws;
    const float* gtail = (const float*)(ws + WS_GTAIL); const float* ghead = (const float*)(ws + WS_GHEAD); const float* uhead = (const float*)(ws + WS_UHEAD);
    const float* cw = a.in[24]; bf16* H = (bf16*)(ws + WS_H);
    for (int e = blockIdx.x * NTHREADS + threadIdx.x; e < 128 * DFF; e += gridDim.x * NTHREADS) {
        const int pm = e / DFF, ch = e % DFF;
        float t0 = 0.f, t1 = 0.f;
        if (pm & 15) { t0 = gtail[((size_t)(pm - 1) * 2 + 0) * DFF + ch]; t1 = gtail[((size_t)(pm - 1) * 2 + 1) * DFF + ch]; }
        const float g0 = ghead[((size_t)pm * 2 + 0) * DFF + ch], g1 = ghead[((size_t)pm * 2 + 1) * DFF + ch];
        const float u0 = uhead[((size_t)pm * 2 + 0) * DFF + ch], u1 = uhead[((size_t)pm * 2 + 1) * DFF + ch];
        const float w0 = cw[ch], w1 = cw[DFF + ch], w2 = cw[2 * DFF + ch];
        H[((size_t)pm * 256 + 0) * DFF + ch] = (bf16)f2bf(silu_f(w0 * t0 + w1 * t1 + w2 * g0) * u0);
        H[((size_t)pm * 256 + 1) * DFF + ch] = (bf16)f2bf(silu_f(w0 * t1 + w1 * g0 + w2 * g1) * u1);
    }
}

__global__ void __launch_bounds__(NTHREADS) nsa_layer_fwd(Args a) {
    extern __shared__ __attribute__((aligned(16))) unsigned char smem[];
    LAS unsigned char* lds = (LAS unsigned char*)smem;
    cg::grid_group grid = cg::this_grid();
    unsigned char* ws = a.ws;
    const int G = gridDim.x, c = blockIdx.x;
    const float* mod = (const float*)(ws + WS_MOD);

    if (threadIdx.x < 2) ((volatile LAS unsigned*)(lds + XB_LDS_OFF))[threadIdx.x] = 0u;
    __syncthreads();
    const XcdBarrier xbar = xcd_barrier_post((unsigned*)(ws + WS_BAR), (volatile LAS unsigned*)(lds + XB_LDS_OFF));
    if (a.ws == nullptr) grid.sync();
    phase0(a, lds);
    xcd_barrier(xbar);
    norm_rows(a.in[0], a.in[4], mod, 0, 1024, (bf16*)(ws + WS_XN));
    weight_copies(a, lds);
    xcd_barrier(xbar);
    {
        pg8::Gemm g{(const bf16*)(ws + WS_XN), (const bf16*)(ws + WS_BT_IN), MTOK, NINP, 1024, 1024};
        pg8::StaticOrder S; S.init(MTOK, NINP, G, c, WGM_P2);
        EpiProj E{(bf16*)(ws + WS_PROJ), (bf16*)(ws + WS_QN), (bf16*)(ws + WS_KSN), (bf16*)(ws + WS_KWN), (float*)(ws + WS_GATES), a.in[7], a.in[9], a.in[10], a.in[6]};
        pg8::gemm_phase<EpiProj, pg8::StaticOrder, true, true>(lds, g, S, E);
    }
    xcd_barrier(xbar);
    if (c < 32) {
        pg8::Gemm g{(const bf16*)(ws + WS_PROJ), (const bf16*)(ws + WS_BT_C1), 4096, 256, 2048, 1024};
        CmpOrder S{c, (const bf16*)(ws + WS_PROJ), (const bf16*)(ws + WS_BT_C1)};
        EpiCmp E{(float*)(ws + WS_HID), (const float*)(ws + WS_BIAS1)};
        pg8::gemm_phase<EpiCmp, CmpOrder, true, true>(lds, g, S, E);
    } else {
        phase3_prep(a, lds, (c - 32) * NWAVES + (int)(threadIdx.x >> 6), (G - 32) * NWAVES);
    }
    xcd_barrier(xbar);
    phase4(a, lds);
    xcd_barrier(xbar);
    phase5(a, lds);
    xcd_barrier(xbar);
    {
        pg8::Gemm g{(const bf16*)(ws + WS_MIXED), (const bf16*)(ws + WS_BT_OUT), MTOK, 1024, 1024, 1024};
        pg8::StaticOrder S; S.init(MTOK, 1024, G, c, WGM_P69);
        EpiResB E{a.in[0], (bf16*)(ws + WS_X1B), mod, 2048};
        pg8::gemm_phase<EpiResB, pg8::StaticOrder, true, true>(lds, g, S, E);
    }
    xcd_barrier(xbar);
    norm_rows_b((const bf16*)(ws + WS_X1B), a.in[21], mod, 3072, 4096, (bf16*)(ws + WS_XN));
    xcd_barrier(xbar);
    {
        pg8::Gemm g{(const bf16*)(ws + WS_XN), (const bf16*)(ws + WS_BT_GU), MTOK, NGU, 1024, 1024};
        pg8::StaticOrder S; S.init(MTOK, NGU, G, c, WGM_P8);
        EpiFfn E{(bf16*)(ws + WS_H), a.in[24], (float*)(ws + WS_GTAIL), (float*)(ws + WS_GHEAD), (float*)(ws + WS_UHEAD), (LAS float*)(lds + HB_OFF)};
        pg8::gemm_phase<EpiFfn, pg8::StaticOrder, true, true>(lds, g, S, E);
    }
    xcd_barrier(xbar);
    phase8b(a);
    xcd_barrier(xbar);
    {
        pg8::Gemm g{(const bf16*)(ws + WS_H), (const bf16*)(ws + WS_BT_DN), MTOK, 1024, DFF, DFF};
        pg8::StaticOrder S; S.init(MTOK, 1024, G, c, WGM_P69);
        EpiResF E{(const bf16*)(ws + WS_X1B), a.out, mod, 5120};
        pg8::gemm_phase<EpiResF, pg8::StaticOrder, true, true>(lds, g, S, E);
    }
}

extern "C" void kernel_launch(void* const* d_in, const int* in_sizes, int n_in, void* d_out, int out_size, void* d_ws, size_t ws_size, hipStream_t stream) {
    static int grid = 0;
    if (grid == 0) {
        if (n_in != 26 || out_size != MTOK * DM || ws_size < WS_END) { fprintf(stderr, "kernel_launch: unexpected problem (n_in %d, out %d, ws %zu)\n", n_in, out_size, ws_size); grid = -1; return; }
        int dev = 0, cus = 0, per_cu = 0;
        (void)hipGetDevice(&dev);
        (void)hipDeviceGetAttribute(&cus, hipDeviceAttributeMultiprocessorCount, dev);
        if (hipFuncSetAttribute((const void*)nsa_layer_fwd, hipFuncAttributeMaxDynamicSharedMemorySize, LDS_BYTES) != hipSuccess) { fprintf(stderr, "kernel_launch: hipFuncSetAttribute failed\n"); grid = -1; return; }
        if (hipOccupancyMaxActiveBlocksPerMultiprocessor(&per_cu, (const void*)nsa_layer_fwd, NTHREADS, LDS_BYTES) != hipSuccess || per_cu < 1) { fprintf(stderr, "kernel_launch: occupancy query says %d\n", per_cu); per_cu = 1; }
        (void)hipGetLastError();
        grid = cus * per_cu;
        if (grid > 1024) grid = 1024;
    }
    if (grid < 0) return;
    if (hipMemsetAsync((char*)d_ws + WS_BAR, 0, BAR_BYTES, stream) != hipSuccess) { fprintf(stderr, "kernel_launch: memset of the barrier words failed\n"); return; }
    Args a{};
    for (int i = 0; i < 26; ++i) a.in[i] = (const float*)d_in[i];
    a.out = (float*)d_out; a.ws = (unsigned char*)d_ws;
    void* args[] = {&a};
    hipError_t e = hipLaunchCooperativeKernel((const void*)nsa_layer_fwd, dim3(grid), dim3(NTHREADS), args, LDS_BYTES, stream);
    if (e != hipSuccess) fprintf(stderr, "cooperative launch failed: %s (grid %d)\n", hipGetErrorString(e), grid);
}
```
